# Optimizing an MI355X kernel written in HIP

```python
import jax, jax.numpy as jnp
from jax import lax
import numpy as np

D_MODEL = 1024
BATCH = 8
SEQ = 2048
DEPTH = 4

ATT_HEAD_DIM = 64
ATT_HEADS_PER_GROUP = D_MODEL // 256
DILATED_GROUPS = ((128, 1), (512, 4), (2048, 16))
N_GROUPS = len(DILATED_GROUPS)
ATT_WIDTH = N_GROUPS * ATT_HEADS_PER_GROUP * ATT_HEAD_DIM
ATT_OUT_WIDTH = ATT_HEADS_PER_GROUP * ATT_HEAD_DIM
ATT_BLOCK = 128

DN_HEAD_DIM = 128
DN_HEADS = D_MODEL // DN_HEAD_DIM
DN_WIDTH = DN_HEADS * DN_HEAD_DIM
CONV_WIDTH = 4
DN_CHUNK = 64

D_FF = 2816
EPS = 1e-6
N_ADA = 9

OFF_DN_QKV = 3 * ATT_WIDTH
OFF_DN_GATE = OFF_DN_QKV + 3 * DN_WIDTH
OFF_DN_A = OFF_DN_GATE + DN_WIDTH
OFF_DN_B = OFF_DN_A + DN_HEADS
OFF_MERGE = OFF_DN_B + DN_HEADS
N_IN = OFF_MERGE + 2 * D_MODEL

kernel_name = "hybrid_dilated_attn_gated_deltanet_macaron_adaln"


def rms_norm(x, g):
    xf = x.astype(jnp.float32)
    y = xf * lax.rsqrt(jnp.mean(xf * xf, axis=-1, keepdims=True) + EPS)
    return (y * g.astype(jnp.float32)).astype(x.dtype)


def l2_norm(x):
    xf = x.astype(jnp.float32)
    return xf * lax.rsqrt(jnp.sum(xf * xf, axis=-1, keepdims=True) + EPS)


def modulate(h, shift, scale):
    return h * (1.0 + scale[:, None, :]) + shift[:, None, :]


def swiglu(h, w_up, w_down):
    gate, up = jnp.split(h @ w_up, 2, axis=-1)
    return (jax.nn.silu(gate) * up) @ w_down


def dilated_group_attention(q, k, v, window, dilation):
    B, T, H, hd = q.shape
    L = T // dilation
    w_sub = window // dilation
    Lp = -(-L // ATT_BLOCK) * ATT_BLOCK
    nb = Lp // ATT_BLOCK

    def to_blocks(t):
        t = t.reshape(B, L, dilation, H, hd).transpose(0, 2, 1, 3, 4)
        t = jnp.pad(t, ((0, 0), (0, 0), (0, Lp - L), (0, 0), (0, 0)))
        return t.reshape(B, dilation, nb, ATT_BLOCK, H, hd)

    qb, kb, vb = to_blocks(q), to_blocks(k), to_blocks(v)

    def with_prev(t):
        prev = jnp.pad(t, ((0, 0), (0, 0), (1, 0), (0, 0), (0, 0), (0, 0)))[:, :, :-1]
        return jnp.concatenate([prev, t], axis=3)

    kk, vv = with_prev(kb), with_prev(vb)
    s = jnp.einsum('bgnqhd,bgnkhd->bgnhqk', qb, kk,
                   preferred_element_type=jnp.float32) * (ATT_HEAD_DIM ** -0.5)
    qi = jnp.arange(ATT_BLOCK)[:, None]
    kj = jnp.arange(2 * ATT_BLOCK)[None, :]
    dist = ATT_BLOCK + qi - kj
    blk = jnp.arange(nb)[:, None, None]
    valid = (dist >= 0) & (dist <= w_sub) & ((blk > 0) | (kj >= ATT_BLOCK))
    s = jnp.where(valid[None, None, :, None], s, -jnp.inf)
    m = jnp.max(s, axis=-1, keepdims=True)
    p = jnp.exp(s - m)
    denom = jnp.sum(p, axis=-1, keepdims=True)
    o = jnp.einsum('bgnhqk,bgnkhd->bgnqhd', p / denom, vv.astype(jnp.float32))
    lse = (m + jnp.log(denom))[..., 0].transpose(0, 1, 2, 4, 3)
    o = o.reshape(B, dilation, Lp, H, hd)[:, :, :L].transpose(0, 2, 1, 3, 4).reshape(B, T, H, hd)
    lse = lse.reshape(B, dilation, Lp, H)[:, :, :L].transpose(0, 2, 1, 3).reshape(B, T, H)
    return o, lse


def causal_depthwise_conv(x, w):
    T = x.shape[1]
    xp = jnp.pad(x, ((0, 0), (CONV_WIDTH - 1, 0), (0, 0)))
    return sum(xp[:, i:i + T] * w[i] for i in range(CONV_WIDTH))


def chunk_gated_delta_rule(q, k, v, g, beta):
    B, T, H, dk = q.shape
    dv = v.shape[-1]
    C = DN_CHUNK
    N = T // C

    def chunks(t):
        t = t.reshape(B, N, C, H, *t.shape[3:])
        return jnp.moveaxis(t, 3, 2)

    q, k, v, g, beta = chunks(q), chunks(k), chunks(v), chunks(g), chunks(beta)
    gc = jnp.cumsum(g, axis=-1)
    tril = jnp.tril(jnp.ones((C, C), dtype=bool))
    strict = tril & ~jnp.eye(C, dtype=bool)
    diff = gc[..., :, None] - gc[..., None, :]
    ldec = jnp.where(tril, jnp.exp(jnp.where(tril, diff, 0.0)), 0.0)
    kb = k * beta[..., None]
    vb = v * beta[..., None]
    a_mat = jnp.where(strict, jnp.einsum('bnhid,bnhjd->bnhij', kb, k) * ldec, 0.0)
    eye = jnp.broadcast_to(jnp.eye(C, dtype=jnp.float32), a_mat.shape)
    t_inv = lax.linalg.triangular_solve(eye + a_mat, eye, left_side=True, lower=True)
    u = jnp.einsum('bnhij,bnhjd->bnhid', t_inv, vb)
    w = jnp.einsum('bnhij,bnhjd->bnhid', t_inv, kb * jnp.exp(gc)[..., None])
    attn_intra = jnp.where(tril, jnp.einsum('bnhid,bnhjd->bnhij', q, k) * ldec, 0.0)
    q_dec = q * jnp.exp(gc)[..., None]
    k_dec = k * jnp.exp(gc[..., -1:] - gc)[..., None]
    g_last = jnp.exp(gc[..., -1])

    def step(S, inp):
        w_c, u_c, qd_c, kd_c, a_c, gl_c = inp
        v_new = u_c - jnp.einsum('bhcd,bhde->bhce', w_c, S)
        o = jnp.einsum('bhcd,bhde->bhce', qd_c, S) + jnp.einsum('bhij,bhje->bhie', a_c, v_new)
        S = S * gl_c[..., None, None] + jnp.einsum('bhcd,bhce->bhde', kd_c, v_new)
        return S, o

    xs = tuple(jnp.moveaxis(t, 1, 0) for t in (w, u, q_dec, k_dec, attn_intra, g_last))
    S0 = jnp.zeros((B, H, dk, dv), jnp.float32)
    _, o = lax.scan(step, S0, xs)
    return o.transpose(1, 0, 3, 2, 4).reshape(B, T, H, dv)


def hybrid_mixer(h, w_in, q_norm, k_norm, conv_w, a_log, dt_bias, dn_norm,
                 w_proj_att, w_proj_dn, w_out):
    B, T, _ = h.shape
    z = h @ w_in
    qkv = z[..., :OFF_DN_QKV].reshape(B, T, 3, N_GROUPS, ATT_HEADS_PER_GROUP, ATT_HEAD_DIM)
    q = rms_norm(qkv[:, :, 0], q_norm)
    k = rms_norm(qkv[:, :, 1], k_norm)
    v = qkv[:, :, 2]
    outs, lses = [], []
    for gi, (window, dilation) in enumerate(DILATED_GROUPS):
        o, lse = dilated_group_attention(q[:, :, gi], k[:, :, gi], v[:, :, gi], window, dilation)
        outs.append(o)
        lses.append(lse)
    wts = jax.nn.softmax(jnp.stack(lses), axis=0)
    y_att = jnp.sum(wts[..., None] * jnp.stack(outs), axis=0)
    y_att = y_att.reshape(B, T, ATT_OUT_WIDTH).astype(h.dtype) @ w_proj_att
    dn_qkv = jax.nn.silu(causal_depthwise_conv(z[..., OFF_DN_QKV:OFF_DN_GATE], conv_w))
    dq, dk, dv = jnp.split(dn_qkv, 3, axis=-1)
    dq = l2_norm(dq.reshape(B, T, DN_HEADS, DN_HEAD_DIM)) * (DN_HEAD_DIM ** -0.5)
    dk = l2_norm(dk.reshape(B, T, DN_HEADS, DN_HEAD_DIM))
    dv = dv.reshape(B, T, DN_HEADS, DN_HEAD_DIM).astype(jnp.float32)
    a_in = z[..., OFF_DN_A:OFF_DN_B].astype(jnp.float32)
    b_in = z[..., OFF_DN_B:OFF_MERGE].astype(jnp.float32)
    g_log = -jnp.exp(a_log.astype(jnp.float32)) * jax.nn.softplus(a_in + dt_bias.astype(jnp.float32))
    beta = jax.nn.sigmoid(b_in)
    o_dn = chunk_gated_delta_rule(dq, dk, dv, g_log, beta)
    out_gate = z[..., OFF_DN_GATE:OFF_DN_A].reshape(B, T, DN_HEADS, DN_HEAD_DIM).astype(jnp.float32)
    o_dn = rms_norm(o_dn, dn_norm) * jax.nn.silu(out_gate)
    y_dn = o_dn.reshape(B, T, DN_WIDTH).astype(h.dtype) @ w_proj_dn
    g_att, g_dn = jnp.split(jax.nn.sigmoid(z[..., OFF_MERGE:]), 2, axis=-1)
    return (g_att * y_att + g_dn * y_dn) @ w_out


def setup_inputs(seed: int = 0) -> dict:
    key = jax.random.key(seed)
    ks = iter(jax.random.split(key, 32))

    def nrm(shape, scale):
        return jax.random.normal(next(ks), shape, jnp.float32) * scale

    def gain(shape):
        return 1.0 + nrm(shape, 0.05)

    L, D = DEPTH, D_MODEL
    x = nrm((BATCH, SEQ, D), 1.0)
    c = nrm((BATCH, D), 1.0)
    ada_w = nrm((L, D, N_ADA * D), 0.02)
    ada_b = nrm((L, N_ADA * D), 0.1)
    norm_ff1 = gain((L, D))
    ffn1_w_up = nrm((L, D, 2 * D_FF), D ** -0.5)
    ffn1_w_down = nrm((L, D_FF, D), D_FF ** -0.5)
    norm_mix = gain((L, D))
    w_in = nrm((L, D, N_IN), D ** -0.5)
    q_norm = gain((L, ATT_HEAD_DIM))
    k_norm = gain((L, ATT_HEAD_DIM))
    conv_w = nrm((L, CONV_WIDTH, 3 * DN_WIDTH), CONV_WIDTH ** -0.5)
    a_log = jnp.log(jax.random.uniform(next(ks), (L, DN_HEADS), jnp.float32, 1.0, 16.0))
    dt = jnp.exp(jax.random.uniform(next(ks), (L, DN_HEADS), jnp.float32,
                                    float(np.log(1e-3)), float(np.log(1e-1))))
    dt_bias = jnp.log(jnp.expm1(dt))
    dn_norm = gain((L, DN_HEAD_DIM))
    w_proj_att = nrm((L, ATT_OUT_WIDTH, D), ATT_OUT_WIDTH ** -0.5)
    w_proj_dn = nrm((L, DN_WIDTH, D), DN_WIDTH ** -0.5)
    w_out = nrm((L, D, D), D ** -0.5)
    norm_ff2 = gain((L, D))
    ffn2_w_up = nrm((L, D, 2 * D_FF), D ** -0.5)
    ffn2_w_down = nrm((L, D_FF, D), D_FF ** -0.5)
    return {"x": x, "c": c, "ada_w": ada_w, "ada_b": ada_b,
            "norm_ff1": norm_ff1, "ffn1_w_up": ffn1_w_up, "ffn1_w_down": ffn1_w_down,
            "norm_mix": norm_mix, "w_in": w_in, "q_norm": q_norm, "k_norm": k_norm,
            "conv_w": conv_w, "a_log": a_log, "dt_bias": dt_bias, "dn_norm": dn_norm,
            "w_proj_att": w_proj_att, "w_proj_dn": w_proj_dn, "w_out": w_out,
            "norm_ff2": norm_ff2, "ffn2_w_up": ffn2_w_up, "ffn2_w_down": ffn2_w_down}


def reference(x, c, ada_w, ada_b, norm_ff1, ffn1_w_up, ffn1_w_down, norm_mix, w_in,
              q_norm, k_norm, conv_w, a_log, dt_bias, dn_norm, w_proj_att, w_proj_dn,
              w_out, norm_ff2, ffn2_w_up, ffn2_w_down):
    c_act = jax.nn.silu(c)
    for l in range(DEPTH):
        mod = c_act @ ada_w[l] + ada_b[l]
        (sh1, sc1, gt1, sh2, sc2, gt2, sh3, sc3, gt3) = jnp.split(mod, N_ADA, axis=-1)
        h = modulate(rms_norm(x, norm_ff1[l]), sh1, sc1)
        x = x + 0.5 * gt1[:, None, :] * swiglu(h, ffn1_w_up[l], ffn1_w_down[l])
        h = modulate(rms_norm(x, norm_mix[l]), sh2, sc2)
        x = x + gt2[:, None, :] * hybrid_mixer(h, w_in[l], q_norm[l], k_norm[l], conv_w[l],
                                                a_log[l], dt_bias[l], dn_norm[l],
                                                w_proj_att[l], w_proj_dn[l], w_out[l])
        h = modulate(rms_norm(x, norm_ff2[l]), sh3, sc3)
        x = x + 0.5 * gt3[:, None, :] * swiglu(h, ffn2_w_up[l], ffn2_w_down[l])
    return x
```

```cpp
#include <hip/hip_runtime.h>
#include <hip/hip_cooperative_groups.h>
#include <cstdio>
#include <cstdint>
namespace cg = cooperative_groups;

typedef unsigned short bf16_t;
typedef short bf16x8 __attribute__((ext_vector_type(8)));
typedef short s16x4 __attribute__((ext_vector_type(4)));
typedef float f32x4 __attribute__((ext_vector_type(4)));
typedef float f32x16 __attribute__((ext_vector_type(16)));
typedef unsigned u32x4 __attribute__((ext_vector_type(4)));
typedef unsigned u32x2 __attribute__((ext_vector_type(2)));

#define DI __device__ __forceinline__
#define MFMA16(a, b, c) __builtin_amdgcn_mfma_f32_16x16x32_bf16((a), (b), (c), 0, 0, 0)
#define MFMA32(a, b, c) __builtin_amdgcn_mfma_f32_32x32x16_bf16((a), (b), (c), 0, 0, 0)

constexpr int DM = 1024, NB = 8, SEQ = 2048, MTOK = NB * SEQ, DFF = 2816, DEPTH = 4;
constexpr int ZLD = 3072;
constexpr int NINP = 8704;
constexpr int Z_DNGATE = 0, Z_MERGE = 1024;
constexpr int LDS_BYTES = 147456;
constexpr int VLDS = 73728;
constexpr int LROW = 144;
constexpr int TILE_BYTES = 256 * LROW;
constexpr int STAGE_BYTES = 2 * TILE_BYTES;
constexpr float EPS = 1e-6f;

struct Params {
  const float *x, *c, *ada_w, *ada_b, *norm_ff1, *w_up1, *w_down1, *norm_mix, *w_in, *q_norm, *k_norm, *conv_w, *a_log, *dt_bias,
      *dn_norm, *w_pa, *w_pd, *w_out, *norm_ff2, *w_up2, *w_down2;
  float* out;
  char* ws;
};
constexpr size_t al256(size_t b) { return (b + 255) & ~(size_t)255; }
constexpr size_t O_W_up1 = 0;
constexpr size_t O_W_down1 = O_W_up1 + al256((size_t)2 * DFF * DM * 2);
constexpr size_t O_W_in = O_W_down1 + al256((size_t)DM * DFF * 2);
constexpr size_t O_W_pa = O_W_in + al256((size_t)NINP * DM * 2);
constexpr size_t O_W_pd = O_W_pa + al256((size_t)DM * 256 * 2);
constexpr size_t O_W_out = O_W_pd + al256((size_t)DM * DM * 2);
constexpr size_t O_W_up2 = O_W_out + al256((size_t)DM * DM * 2);
constexpr size_t O_W_down2 = O_W_up2 + al256((size_t)2 * DFF * DM * 2);
constexpr size_t WSET_BYTES = O_W_down2 + al256((size_t)DM * DFF * 2);
constexpr size_t O_h = 2 * WSET_BYTES;
constexpr size_t O_z = O_h + al256((size_t)MTOK * DM * 2);
constexpr size_t O_zatt = O_z + al256((size_t)MTOK * ZLD * 2);
constexpr size_t O_zdn = O_zatt + al256((size_t)MTOK * 2304 * 2);
constexpr size_t O_hidden = O_zatt;
constexpr size_t O_og = O_zdn + al256((size_t)MTOK * 3072 * 2);
constexpr size_t O_yatt = O_og + al256((size_t)MTOK * 768 * 2);
constexpr size_t O_dW = O_yatt + al256((size_t)MTOK * 256 * 2);
constexpr size_t O_dUT = O_dW + al256((size_t)MTOK * DM * 2);
constexpr size_t O_mrg = O_dUT;
constexpr size_t O_dQD = O_dUT + al256((size_t)MTOK * DM * 2);
constexpr size_t O_dKDT = O_dQD + al256((size_t)MTOK * DM * 2);
constexpr size_t O_dAI = O_dKDT + al256((size_t)MTOK * DM * 2);
constexpr size_t O_oraw = O_dAI + al256((size_t)2048 * 4096 * 2);
constexpr size_t O_odn = O_dW;
constexpr size_t O_ab = O_oraw + al256((size_t)MTOK * DM * 2);
constexpr size_t O_mod = O_ab + al256((size_t)MTOK * 16 * 4);
constexpr size_t O_lse = O_mod + al256((size_t)DEPTH * 8 * 9216 * 4);
constexpr size_t O_dGL = O_lse + al256((size_t)MTOK * 12 * 4);
constexpr size_t O_bar = O_dGL + al256((size_t)2048 * 4);
constexpr size_t WS_TOTAL = O_bar + al256((size_t)3456 * 4);
#define WSB(p, name) ((bf16_t*)((p).ws + O_##name))
#define WSW(p, name, l_) ((bf16_t*)((p).ws + O_##name + (size_t)((l_) & 1) * WSET_BYTES))
#define WSF(p, name) ((float*)((p).ws + O_##name))

DI int opaque_tid() { int t = threadIdx.x; asm volatile("" : "+v"(t)); return t & 255; }
DI int real_tid() { int t = threadIdx.x; asm volatile("" : "+v"(t)); return t; }
DI int opaque_bid() { int h = threadIdx.x; asm volatile("" : "+v"(h)); int t = blockIdx.x; asm volatile("" : "+s"(t)); return t * 2 + __builtin_amdgcn_readfirstlane(h >> 8); }
DI int real_bid() { int t = blockIdx.x; asm volatile("" : "+s"(t)); return t; }
#define VGRID ((int)gridDim.x * 2)
DI char* vlds(char* lds) { unsigned t = threadIdx.x; asm volatile("" : "+v"(t)); unsigned off = (t >> 8) * VLDS; asm volatile("" : "+v"(off)); return lds + off; }
typedef float f32x2 __attribute__((ext_vector_type(2)));
typedef __bf16 hwbf16x2 __attribute__((ext_vector_type(2)));
DI unsigned pk2(float lo, float hi) { const f32x2 v = {lo, hi}; return __builtin_bit_cast(unsigned, __builtin_convertvector(v, hwbf16x2)); }
DI unsigned short f2bf(float x) { return (unsigned short)(pk2(x, 0.f) & 0xffffu); }
DI float bf2f(unsigned short v) { return __uint_as_float(((unsigned)v) << 16); }
DI float bflo(unsigned u) { return __uint_as_float(u << 16); }
DI float bfhi(unsigned u) { return __uint_as_float(u & 0xffff0000u); }
DI float shx(float v, int mask, int lane) { return __int_as_float(__builtin_amdgcn_ds_bpermute((lane ^ mask) << 2, __float_as_int(v))); }
DI float shup(float v, int off, int lane) { return __int_as_float(__builtin_amdgcn_ds_bpermute((lane - off) << 2, __float_as_int(v))); }
DI float sigmoidf_(float x) { return 1.f / (1.f + __expf(-x)); }
DI float siluf_(float x) { return x / (1.f + __expf(-x)); }
DI void unpack8(const u32x4& r, float (&v)[8]) {
  v[0] = bflo(r[0]); v[1] = bfhi(r[0]); v[2] = bflo(r[1]); v[3] = bfhi(r[1]);
  v[4] = bflo(r[2]); v[5] = bfhi(r[2]); v[6] = bflo(r[3]); v[7] = bfhi(r[3]);
}
DI u32x4 pack8(const float (&v)[8]) { u32x4 r; r[0] = pk2(v[0], v[1]); r[1] = pk2(v[2], v[3]); r[2] = pk2(v[4], v[5]); r[3] = pk2(v[6], v[7]); return r; }

template <int MH> DI void gemm_core_simple(const bf16_t* __restrict__ A, int lda, const bf16_t* __restrict__ Bt, int ldb, int K, f32x4 (&acc)[MH][4], char* lds) {
  const int tid = real_tid(), lane = tid & 63, wid = tid >> 6, wr = wid >> 2, wc = wid & 3, fr = lane & 15, fq = lane >> 4;
  const int sl = lane ^ ((lane >> 5) << 1);
  const int R0 = (wid >> 1) * 16 + (sl >> 2), C0 = (wid & 1) * 32 + (sl & 3) * 8;
  const bf16_t* gA = A + (size_t)R0 * lda + C0;
  const bf16_t* gB = Bt + (size_t)R0 * ldb + C0;
  const size_t sA = (size_t)64 * lda, sB = (size_t)64 * ldb;
  unsigned st_off = (unsigned)tid * 16u;
  const unsigned rd_off = (unsigned)((fr * 64 + fq * 16) ^ ((fr >> 3) << 5));
  unsigned rd_a = (unsigned)(wr * (MH * 2048)) + rd_off;
  unsigned rd_b = 32768u + (unsigned)(wc * 4096) + rd_off;
  asm volatile("" : "+v"(st_off), "+v"(rd_a), "+v"(rd_b));
  const int nk = K >> 6;
#define GSTAGE(sbase_, k0_)                                                                                                        \
  {                                                                                                                                \
    _Pragma("unroll") for (int j = 0; j < 4; ++j) {                                                                                \
      if (j < MH / 2) __builtin_amdgcn_global_load_lds((const unsigned*)(gA + j * sA + (k0_)), (unsigned*)(lds + ((sbase_) + j * 8192 + st_off)), 16, 0, 0);          \
      __builtin_amdgcn_global_load_lds((const unsigned*)(gB + j * sB + (k0_)), (unsigned*)(lds + ((sbase_) + 32768 + j * 8192 + st_off)), 16, 0, 0);  \
    }                                                                                                                              \
  }
  GSTAGE(0u, 0);
  asm volatile("s_waitcnt vmcnt(0)" ::: "memory");
  __syncthreads();
#pragma unroll 1
  for (int kt = 0; kt < nk; ++kt) {
    const unsigned sbase = (unsigned)(kt & 1) << 16;
    if (kt + 1 < nk) GSTAGE(65536u - sbase, (kt + 1) * 64);
    const char* pa = lds + (rd_a + sbase);
    const char* pb = lds + (rd_b + sbase);
    bf16x8 af[2 * MH], b0[4], b1[4];
    constexpr int B1S = MH >= 5 ? MH - 5 : 0;
#define RDA(g_) af[g_] = *(const bf16x8*)(pa + ((g_) % MH) * 2048 + ((g_) / MH) * 1024)
#define RDB(ks_, n_) *(const bf16x8*)(pb + ((n_) >> 1) * 16384 + ((n_) & 1) * 2048 + (ks_) * 1024)
    b0[0] = RDB(0, 0); b0[1] = RDB(0, 1); b0[2] = RDB(0, 2); b0[3] = RDB(0, 3);
    RDA(0); RDA(1); RDA(2);
    __builtin_amdgcn_sched_barrier(0);
#pragma unroll
    for (int g = 0; g < 2 * MH; ++g) {
      if (g + 3 < 2 * MH) RDA(g + 3);
      if (g >= B1S && g < B1S + 4) b1[g - B1S] = RDB(1, g - B1S);
      __builtin_amdgcn_sched_barrier(0);
      if (g < MH) {
#pragma unroll
        for (int n = 0; n < 4; ++n) acc[g % MH][n] = MFMA16(b0[n], af[g], acc[g % MH][n]);
      } else {
#pragma unroll
        for (int n = 0; n < 4; ++n) acc[g % MH][n] = MFMA16(b1[n], af[g], acc[g % MH][n]);
      }
      __builtin_amdgcn_sched_barrier(0);
    }
#undef RDA
#undef RDB
    asm volatile("s_waitcnt vmcnt(0)" ::: "memory");
    __syncthreads();
  }
#undef GSTAGE
}

DI void gemm_core(const bf16_t* __restrict__ A, int lda, const bf16_t* __restrict__ Bt, int ldb, int K, f32x4 (&acc)[8][4], char* lds) {
  const int tid = real_tid(), lane = tid & 63, wid = tid >> 6, wr = wid >> 2, wc = wid & 3, fr = lane & 15, fq = lane >> 4;
  const int sl = lane ^ ((lane >> 5) << 1);
  const int R0 = (wid >> 1) * 16 + (sl >> 2), C0 = (wid & 1) * 32 + (sl & 3) * 8;
  const bf16_t* gA = A + (size_t)R0 * lda + C0;
  const bf16_t* gB = Bt + (size_t)R0 * ldb + C0;
  const size_t sA = (size_t)64 * lda, sB = (size_t)64 * ldb;
  const unsigned rd_off = (unsigned)((fr * 64 + fq * 16) ^ ((fr >> 3) << 5));
  unsigned st0 = (unsigned)tid * 16u, st1 = st0 + 65536u;
  unsigned ra0 = (unsigned)(wr * 8192) + rd_off, ra1 = ra0 + 65536u;
  unsigned rb0 = 32768u + (unsigned)(wc * 4096) + rd_off, rb1 = rb0 + 65536u;
  asm volatile("" : "+v"(st0), "+v"(st1), "+v"(ra0), "+v"(ra1), "+v"(rb0), "+v"(rb1));
  const int nt = K >> 6;
  bf16x8 At[4][2], B0[2][2], B1[2][2];
#define STG_A(b_, h_, kt_) { const bf16_t* g_ = gA + (size_t)((h_) * 128) * lda + (size_t)(kt_) * 64; char* d_ = lds + (((b_) ? st1 : st0) + (h_) * 16384); \
    __builtin_amdgcn_global_load_lds((const unsigned*)g_, (unsigned*)d_, 16, 0, 0); __builtin_amdgcn_global_load_lds((const unsigned*)(g_ + sA), (unsigned*)(d_ + 8192), 16, 0, 0); }
#define STG_B(b_, h_, kt_) { const bf16_t* g_ = gB + (size_t)((h_) * 128) * ldb + (size_t)(kt_) * 64; char* d_ = lds + (((b_) ? st1 : st0) + 32768 + (h_) * 16384); \
    __builtin_amdgcn_global_load_lds((const unsigned*)g_, (unsigned*)d_, 16, 0, 0); __builtin_amdgcn_global_load_lds((const unsigned*)(g_ + sB), (unsigned*)(d_ + 8192), 16, 0, 0); }
#define LDA(b_, h_) { const char* s_ = lds + (((b_) ? ra1 : ra0) + (h_) * 16384); \
    _Pragma("unroll") for (int m = 0; m < 4; ++m) _Pragma("unroll") for (int k = 0; k < 2; ++k) At[m][k] = *(const bf16x8*)(s_ + m * 2048 + k * 1024); }
#define LDB(dst_, b_, h_) { const char* s_ = lds + (((b_) ? rb1 : rb0) + (h_) * 16384); \
    _Pragma("unroll") for (int n = 0; n < 2; ++n) _Pragma("unroll") for (int k = 0; k < 2; ++k) dst_[n][k] = *(const bf16x8*)(s_ + n * 2048 + k * 1024); }
#define MMA(ai_, bj_, Bx_) { __builtin_amdgcn_s_setprio(1); \
    _Pragma("unroll") for (int m = 0; m < 4; ++m) _Pragma("unroll") for (int n = 0; n < 2; ++n) _Pragma("unroll") for (int k = 0; k < 2; ++k) \
      acc[(ai_) * 4 + m][(bj_) * 2 + n] = MFMA16(Bx_[n][k], At[m][k], acc[(ai_) * 4 + m][(bj_) * 2 + n]); \
    __builtin_amdgcn_s_setprio(0); }
#define WAIT_V(n_) asm volatile("s_waitcnt vmcnt(" #n_ ")" ::: "memory")
#define WAIT_L(n_) asm volatile("s_waitcnt lgkmcnt(" #n_ ")" ::: "memory")
#define BAR __builtin_amdgcn_s_barrier()
#define SCHED __builtin_amdgcn_sched_barrier(0)
  WAIT_V(0);
  STG_B(0, 0, 0); STG_A(0, 0, 0); STG_B(0, 1, 0); STG_A(0, 1, 0);
  if (wr == 1) BAR;
  WAIT_V(4); BAR;
  STG_B(1, 0, 1); STG_A(1, 0, 1); STG_B(1, 1, 1);
  WAIT_V(6); BAR;
#pragma unroll 1
  for (int t = 0; t < nt - 2; t += 2) {
    LDB(B0, 0, 0); SCHED; LDA(0, 0); STG_A(1, 1, t + 1);
    WAIT_L(8); BAR; WAIT_L(0); MMA(0, 0, B0); BAR; SCHED;
    LDB(B1, 0, 1); STG_B(0, 0, t + 2);
    BAR; WAIT_L(0); MMA(0, 1, B1); BAR;
    LDA(0, 1); STG_A(0, 0, t + 2);
    BAR; WAIT_L(0); MMA(1, 0, B0); BAR; SCHED;
    STG_B(0, 1, t + 2);
    WAIT_V(6); BAR; MMA(1, 1, B1); BAR;
    LDB(B0, 1, 0); SCHED; LDA(1, 0); STG_A(0, 1, t + 2);
    WAIT_L(8); BAR; WAIT_L(0); MMA(0, 0, B0); BAR; SCHED;
    LDB(B1, 1, 1); STG_B(1, 0, t + 3);
    BAR; WAIT_L(0); MMA(0, 1, B1); BAR;
    LDA(1, 1); STG_A(1, 0, t + 3);
    BAR; WAIT_L(0); MMA(1, 0, B0); BAR; SCHED;
    STG_B(1, 1, t + 3);
    WAIT_V(6); BAR; MMA(1, 1, B1); BAR;
  }
  { LDB(B0, 0, 0); LDA(0, 0); STG_A(1, 1, nt - 1);
    BAR; WAIT_L(0); MMA(0, 0, B0); BAR;
    LDB(B1, 0, 1); BAR; WAIT_L(0); MMA(0, 1, B1); BAR;
    LDA(0, 1); WAIT_V(4); BAR; WAIT_L(0); MMA(1, 0, B0); MMA(1, 1, B1); BAR; }
  { LDB(B0, 1, 0); LDA(1, 0); WAIT_V(2); BAR; WAIT_L(0); MMA(0, 0, B0); BAR;
    LDB(B1, 1, 1); WAIT_V(0); BAR; WAIT_L(0); MMA(0, 1, B1); BAR;
    LDA(1, 1); BAR; WAIT_L(0); MMA(1, 0, B0); MMA(1, 1, B1); BAR; }
  if (wr == 0) BAR;
#undef STG_A
#undef STG_B
#undef LDA
#undef LDB
#undef MMA
#undef WAIT_V
#undef WAIT_L
#undef BAR
#undef SCHED
}

DI void tile_decode(int t, int& mt, int& nt) {
  const int xcd = t & 7, local = t >> 3;
  mt = 8 * xcd + (local & 7); nt = local >> 3;
}
template <int MH> DI void zero_acc(f32x4 (&acc)[MH][4]) {
#pragma unroll
  for (int m = 0; m < MH; ++m)
#pragma unroll
    for (int n = 0; n < 4; ++n) acc[m][n] = (f32x4){0.f, 0.f, 0.f, 0.f};
}
#define GEMM_IDS const int tid = real_tid(), lane = tid & 63, wid = tid >> 6, wr = wid >> 2, wc = wid & 3, fr = lane & 15, fq = lane >> 4
#define GEMM_IDS_AGAIN const int tid = real_tid(), lane = tid & 63, wid = tid >> 6, wr = wid >> 2, wc = wid & 3, fr = lane & 15, fq = lane >> 4; (void)lane; (void)wr; (void)wc
#define EROW(m) ((size_t)mt * 256 + ((m) >> 2) * 128 + wr * 64 + ((m) & 3) * 16 + fr)
#define ECOL(n) (nt * 256 + wc * 32 + ((n) & 1) * 16 + ((n) >> 1) * 128 + fq * 4)

template <int MH> DI void up_epilogue(const Params& p, const f32x4 (&acc)[MH][4], int mt, int half, int nt, int wr, int wc, int fr, int fq) {
#pragma unroll
  for (int m = 0; m < MH; ++m) {
    const size_t row = (size_t)mt * 256 + (MH == 8 ? (m >> 2) : half) * 128 + wr * 64 + (m & 3) * 16 + fr;
#pragma unroll
    for (int n = 0; n < 2; ++n) {
      const int hc = nt * 128 + wc * 32 + n * 16 + fq * 4;
      float o[4];
#pragma unroll
      for (int j = 0; j < 4; ++j) { const float g = acc[m][n][j], u = acc[m][n + 2][j]; o[j] = siluf_(g) * u; }
      u32x2 w; w[0] = pk2(o[0], o[1]); w[1] = pk2(o[2], o[3]);
      *(u32x2*)(WSB(p, hidden) + row * DFF + hc) = w;
    }
  }
}
DI void tail_decode(int bid, int nfull, int& mt, int& nt, int& half) { tile_decode(nfull + ((bid >> 4) << 3) + (bid & 7), mt, nt); half = (bid >> 3) & 1; }

DI void gemm_up_phase(const Params& p, const bf16_t* Bt, char* lds) {
  GEMM_IDS; (void)lane;
  constexpr int NT = 22, NFULL = (64 * NT / 256) * 256;
  for (int t = real_bid(); t < 64 * NT; t += gridDim.x) {
    int mt, nt; tile_decode(t, mt, nt);
    f32x4 acc[8][4]; zero_acc(acc);
    gemm_core(WSB(p, h) + (size_t)mt * 256 * DM, DM, Bt + (size_t)nt * 256 * DM, DM, DM, acc, lds);
    GEMM_IDS_AGAIN;
    up_epilogue<8>(p, acc, mt, 0, nt, wr, wc, fr, fq);
  }
}

DI void gemm_res_phase(const Params& p, const bf16_t* A, int K, const bf16_t* Bt, const float* gate, float coef, char* lds) {
  GEMM_IDS; (void)lane;
  constexpr int NT = 4;
  for (int t = real_bid(); t < 64 * NT; t += gridDim.x) {
    int mt, nt; tile_decode(t, mt, nt);
    f32x4 acc[8][4]; zero_acc(acc);
    gemm_core(A + (size_t)mt * 256 * K, K, Bt + (size_t)nt * 256 * K, K, K, acc, lds);
    GEMM_IDS_AGAIN;
    const int b = mt >> 3;
#pragma unroll
    for (int n = 0; n < 4; ++n) {
      const int col = ECOL(n);
      const f32x4 gv = *(const f32x4*)(gate + (size_t)b * 9216 + col);
#pragma unroll
      for (int m = 0; m < 8; ++m) {
        float* xp = p.out + EROW(m) * DM + col;
        f32x4 xv = *(const f32x4*)xp;
        xv = xv + (gv * acc[m][n]) * coef;
        *(f32x4*)xp = xv;
        if (m & 1) __builtin_amdgcn_sched_barrier(0);
      }
    }
  }
}

template <int MH> DI void in_epilogue(const Params& p, const f32x4 (&acc)[MH][4], int mt, int half, int nt, int wr, int wc, int fr, int fq) {
  if (nt < 9) {
#pragma unroll
    for (int n = 0; n < 4; ++n) {
      const int col = ECOL(n), sq = col / 768, rem = col - sq * 768, g = rem >> 8, hh = (rem >> 6) & 3, dd = rem & 63;
      const int sh = (g == 0) ? 0 : (g == 1 ? 2 : 4);
#pragma unroll
      for (int m = 0; m < MH; ++m) {
        const size_t row = (size_t)mt * 256 + (MH == 8 ? (m >> 2) : half) * 128 + wr * 64 + (m & 3) * 16 + fr;
        const int b = (int)(row >> 11), t = (int)(row & 2047);
        const int ridx = ((t & ((1 << sh) - 1)) << (11 - sh)) + (t >> sh);
        u32x2 w; w[0] = pk2(acc[m][n][0], acc[m][n][1]); w[1] = pk2(acc[m][n][2], acc[m][n][3]);
        *(u32x2*)(WSB(p, zatt) + ((size_t)((((b * 3 + sq) * 3 + g) * 4 + hh) * 2048 + ridx)) * 64 + dd) = w;
      }
    }
  } else if (nt < 21) {
#pragma unroll
    for (int n = 0; n < 4; ++n) {
      const int c = ECOL(n) - 2304, seg = c >> 10, hd = (c >> 7) & 7, cc = c & 127;
#pragma unroll
      for (int m = 0; m < MH; ++m) {
        const size_t row = (size_t)mt * 256 + (MH == 8 ? (m >> 2) : half) * 128 + wr * 64 + (m & 3) * 16 + fr;
        const int b = (int)(row >> 11), t = (int)(row & 2047);
        u32x2 w; w[0] = pk2(acc[m][n][0], acc[m][n][1]); w[1] = pk2(acc[m][n][2], acc[m][n][3]);
        *(u32x2*)(WSB(p, zdn) + ((size_t)(((b * 8 + hd) * 3 + seg) * 2048 + t)) * 128 + cc) = w;
      }
    }
  } else if (nt < 33) {
#pragma unroll
    for (int m = 0; m < MH; ++m) {
      const size_t row = (size_t)mt * 256 + (MH == 8 ? (m >> 2) : half) * 128 + wr * 64 + (m & 3) * 16 + fr;
#pragma unroll
      for (int n = 0; n < 4; ++n) {
        u32x2 w; w[0] = pk2(acc[m][n][0], acc[m][n][1]); w[1] = pk2(acc[m][n][2], acc[m][n][3]);
        *(u32x2*)(WSB(p, z) + row * ZLD + (ECOL(n) - 5376)) = w;
      }
    }
  } else if (wc == 0) {
#pragma unroll
    for (int m = 0; m < MH; ++m) *(f32x4*)(WSF(p, ab) + ((size_t)mt * 256 + (MH == 8 ? (m >> 2) : half) * 128 + wr * 64 + (m & 3) * 16 + fr) * 16 + fq * 4) = acc[m][0];
  }
}
DI void gemm_in_phase(const Params& p, const bf16_t* Win, char* lds) {
  GEMM_IDS; (void)lane;
  constexpr int NT = 34, NFULL = (64 * NT / 256) * 256;
  for (int t = real_bid(); t < 64 * NT; t += gridDim.x) {
    int mt, nt; tile_decode(t, mt, nt);
    f32x4 acc[8][4]; zero_acc(acc);
    gemm_core(WSB(p, h) + (size_t)mt * 256 * DM, DM, Win + (size_t)nt * 256 * DM, DM, DM, acc, lds);
    GEMM_IDS_AGAIN;
    in_epilogue<8>(p, acc, mt, 0, nt, wr, wc, fr, fq);
  }
}

DI void gemm_proj_phase(const Params& p, const bf16_t* Wpa, const bf16_t* Wpd, char* lds) {
  GEMM_IDS; (void)lane;
  constexpr int NT = 4;
  for (int t = real_bid(); t < 64 * NT; t += gridDim.x) {
    int mt, nt; tile_decode(t, mt, nt);
    f32x4 acc[8][4]; zero_acc(acc);
    gemm_core(WSB(p, yatt) + (size_t)mt * 256 * 256, 256, Wpa + (size_t)nt * 256 * 256, 256, 256, acc, lds);
    GEMM_IDS_AGAIN;
#pragma unroll
    for (int m = 0; m < 8; ++m) {
      const size_t row = EROW(m);
#pragma unroll
      for (int n = 0; n < 4; ++n) {
        const int col = ECOL(n);
        const u32x2 gz = *(const u32x2*)(WSB(p, z) + row * ZLD + Z_MERGE + col);
        const float o0 = sigmoidf_(bflo(gz[0])) * acc[m][n][0], o1 = sigmoidf_(bfhi(gz[0])) * acc[m][n][1];
        const float o2 = sigmoidf_(bflo(gz[1])) * acc[m][n][2], o3 = sigmoidf_(bfhi(gz[1])) * acc[m][n][3];
        u32x2 w; w[0] = pk2(o0, o1); w[1] = pk2(o2, o3);
        *(u32x2*)(WSB(p, mrg) + row * DM + col) = w;
      }
      __builtin_amdgcn_sched_barrier(0);
    }
  }
  for (int t = real_bid(); t < 64 * NT; t += gridDim.x) {
    int mt, nt; tile_decode(t, mt, nt);
    f32x4 acc[8][4]; zero_acc(acc);
    gemm_core(WSB(p, odn) + (size_t)mt * 256 * DM, DM, Wpd + (size_t)nt * 256 * DM, DM, DM, acc, lds);
    GEMM_IDS_AGAIN;
#pragma unroll
    for (int m = 0; m < 8; ++m) {
      const size_t row = EROW(m);
#pragma unroll
      for (int n = 0; n < 4; ++n) {
        const int col = ECOL(n);
        const u32x2 gz = *(const u32x2*)(WSB(p, z) + row * ZLD + Z_MERGE + DM + col);
        const u32x2 pv = *(const u32x2*)(WSB(p, mrg) + row * DM + col);
        const float o0 = bflo(pv[0]) + sigmoidf_(bflo(gz[0])) * acc[m][n][0], o1 = bfhi(pv[0]) + sigmoidf_(bfhi(gz[0])) * acc[m][n][1];
        const float o2 = bflo(pv[1]) + sigmoidf_(bflo(gz[1])) * acc[m][n][2], o3 = bfhi(pv[1]) + sigmoidf_(bfhi(gz[1])) * acc[m][n][3];
        u32x2 w; w[0] = pk2(o0, o1); w[1] = pk2(o2, o3);
        *(u32x2*)(WSB(p, mrg) + row * DM + col) = w;
      }
      __builtin_amdgcn_sched_barrier(0);
    }
  }
}

DI void convert_matrix(const float* __restrict__ src, int ldsrc, bf16_t* __restrict__ dst, int K, int ncoltiles, int kind, char* lds, int start, int stride) {
  float* tl = (float*)lds;
  const int tid = opaque_tid();
  const int nkt = K >> 6;
  const int nitems = ncoltiles * nkt;
  for (int it = start; it < nitems; it += stride) {
    const int ct = it / nkt, kt = it - ct * nkt;
    int srccol0 = ct * 64, nvalid = 64;
    if (kind == 1) { const int T = ct >> 2, q = ct & 3; srccol0 = (q >> 1) * DFF + T * 128 + (q & 1) * 64; }
    else if (kind == 2) {
      if (ct < 100) srccol0 = ct * 64;
      else if (ct < 132) srccol0 = 6416 + (ct - 100) * 64;
      else if (ct == 132) { srccol0 = 6400; nvalid = 16; }
      else { srccol0 = 0; nvalid = 0; }
    }
    const int r = tid >> 4, c4 = (tid & 15) * 4;
#pragma unroll
    for (int ps = 0; ps < 4; ++ps) {
      const int kk = r + 16 * ps;
      f32x4 v = (f32x4){0.f, 0.f, 0.f, 0.f};
      if (c4 < nvalid) v = *(const f32x4*)(src + (size_t)(kt * 64 + kk) * ldsrc + srccol0 + c4);
      tl[kk * 65 + c4 + 0] = v[0]; tl[kk * 65 + c4 + 1] = v[1]; tl[kk * 65 + c4 + 2] = v[2]; tl[kk * 65 + c4 + 3] = v[3];
    }
    __syncthreads();
#pragma unroll
    for (int ps = 0; ps < 2; ++ps) {
      const int n = (tid >> 3) + 32 * ps, k8 = (tid & 7) * 8;
      float v[8];
#pragma unroll
      for (int e = 0; e < 8; ++e) v[e] = tl[(k8 + e) * 65 + n];
      *(u32x4*)(dst + (size_t)(ct * 64 + n) * K + kt * 64 + k8) = pack8(v);
    }
    __syncthreads();
  }
}

DI void convert_layer(const Params& p, int l, char* lds, int start, int stride) {
  convert_matrix(p.w_up1 + (size_t)l * DM * 2 * DFF, 2 * DFF, WSW(p, W_up1, l), DM, 88, 1, lds, start, stride);
  convert_matrix(p.w_down1 + (size_t)l * DFF * DM, DM, WSW(p, W_down1, l), DFF, 16, 0, lds, start, stride);
  convert_matrix(p.w_in + (size_t)l * DM * 8464, 8464, WSW(p, W_in, l), DM, 136, 2, lds, start, stride);
  convert_matrix(p.w_pa + (size_t)l * 256 * DM, DM, WSW(p, W_pa, l), 256, 16, 0, lds, start, stride);
  convert_matrix(p.w_pd + (size_t)l * DM * DM, DM, WSW(p, W_pd, l), DM, 16, 0, lds, start, stride);
  convert_matrix(p.w_out + (size_t)l * DM * DM, DM, WSW(p, W_out, l), DM, 16, 0, lds, start, stride);
  convert_matrix(p.w_up2 + (size_t)l * DM * 2 * DFF, 2 * DFF, WSW(p, W_up2, l), DM, 88, 1, lds, start, stride);
  convert_matrix(p.w_down2 + (size_t)l * DFF * DM, DM, WSW(p, W_down2, l), DFF, 16, 0, lds, start, stride);
}

DI void norm_phase(const Params& p, const float* g, const float* shift, const float* scale  ) {
  const int tid = opaque_tid(), lane = tid & 63, wid = tid >> 6;
  const int nw = VGRID * 4;
  for (int row = opaque_bid() * 4 + wid; row < MTOK; row += nw) {
    const int b = row >> 11;
    const float* xp = p.out + (size_t)row * DM;
    f32x4 v[4]; float ss = 0.f;
#pragma unroll
    for (int i = 0; i < 4; ++i) { v[i] = *(const f32x4*)(xp + i * 256 + lane * 4); ss += v[i][0] * v[i][0] + v[i][1] * v[i][1] + v[i][2] * v[i][2] + v[i][3] * v[i][3]; }
#pragma unroll
    for (int o = 1; o < 64; o <<= 1) ss += shx(ss, o, lane);
    const float rstd = rsqrtf(ss * (1.f / DM) + EPS);
#pragma unroll
    for (int i = 0; i < 4; ++i) {
      const int col = i * 256 + lane * 4;
      const f32x4 gv = *(const f32x4*)(g + col), sc = *(const f32x4*)(scale + (size_t)b * 9216 + col), sh = *(const f32x4*)(shift + (size_t)b * 9216 + col);
      float o[4];
#pragma unroll
      for (int j = 0; j < 4; ++j) o[j] = v[i][j] * rstd * gv[j] * (1.f + sc[j]) + sh[j];
      u32x2 w; w[0] = pk2(o[0], o[1]); w[1] = pk2(o[2], o[3]);
      *(u32x2*)(WSB(p, h) + (size_t)row * DM + col) = w;
    }
  }
}

DI void phase0(const Params& p, char* lds) {
  float* cact = (float*)lds;
  float* red = (float*)(lds + 32768);
  const int tid = opaque_tid(), lane = tid & 63, wid = tid >> 6;
  for (int it = opaque_bid(); it < 144; it += VGRID) {
    const int l = it / 36, cb = it - l * 36;
    for (int i = tid; i < NB * DM; i += 256) cact[i] = siluf_(p.c[i]);
    __syncthreads();
    float acc[8][4];
#pragma unroll
    for (int b = 0; b < 8; ++b)
#pragma unroll
      for (int e = 0; e < 4; ++e) acc[b][e] = 0.f;
    const float* wp = p.ada_w + (size_t)l * DM * 9216 + cb * 256 + lane * 4;
    const int kbeg = wid * 256;
    for (int k = kbeg; k < kbeg + 256; k += 4) {
      const f32x4 w0 = *(const f32x4*)(wp + (size_t)(k + 0) * 9216), w1 = *(const f32x4*)(wp + (size_t)(k + 1) * 9216);
      const f32x4 w2 = *(const f32x4*)(wp + (size_t)(k + 2) * 9216), w3 = *(const f32x4*)(wp + (size_t)(k + 3) * 9216);
#pragma unroll
      for (int b = 0; b < 8; ++b) {
        const f32x4 cv = *(const f32x4*)(cact + b * DM + k);
#pragma unroll
        for (int e = 0; e < 4; ++e) acc[b][e] += cv[0] * w0[e] + cv[1] * w1[e] + cv[2] * w2[e] + cv[3] * w3[e];
      }
    }
#pragma unroll
    for (int b = 0; b < 8; ++b)
#pragma unroll
      for (int e = 0; e < 4; ++e) red[(wid * 8 + b) * 256 + lane * 4 + e] = acc[b][e];
    __syncthreads();
#pragma unroll
    for (int b = 0; b < 8; ++b) {
      const float s = red[(0 * 8 + b) * 256 + tid] + red[(1 * 8 + b) * 256 + tid] + red[(2 * 8 + b) * 256 + tid] + red[(3 * 8 + b) * 256 + tid];
      WSF(p, mod)[((size_t)l * 8 + b) * 9216 + cb * 256 + tid] = s + p.ada_b[(size_t)l * 9216 + cb * 256 + tid];
    }
    __syncthreads();
  }
  const size_t n4 = (size_t)MTOK * DM / 4;
  for (size_t i = (size_t)opaque_bid() * 256 + tid; i < n4; i += (size_t)VGRID * 256) ((f32x4*)p.out)[i] = ((const f32x4*)p.x)[i];
}

DI void attn_item(const Params& p, int l, int item, char* lds) {
  const int tid = opaque_tid(), lane = tid & 63, w = tid >> 6, r = lane & 31, hf = lane >> 5;
  const int blk16 = item & 15, hh = (item >> 4) & 3, rest = item >> 6, g = rest % 3, b = rest / 3;
  const int d = (g == 0) ? 1 : (g == 1 ? 4 : 16);
  const int nbk = 16 / d, res = blk16 / nbk, nb = blk16 - res * nbk;
  const int qcol = g * 256 + hh * 64;
  const int Lsub = 2048 / d;
  const bf16_t* zq = WSB(p, zatt) + ((size_t)((((b * 3 + 0) * 3 + g) * 4 + hh) * 2048 + res * Lsub)) * 64;
  const bf16_t* zk = WSB(p, zatt) + ((size_t)((((b * 3 + 1) * 3 + g) * 4 + hh) * 2048 + res * Lsub)) * 64;
  const bf16_t* zv = WSB(p, zatt) + ((size_t)((((b * 3 + 2) * 3 + g) * 4 + hh) * 2048 + res * Lsub)) * 64;
  bf16_t* VT = (bf16_t*)lds;
  float* nrm = (float*)(lds + 64 * 528);
  if (tid < 128) nrm[tid] = (tid < 64) ? p.q_norm[l * 64 + tid] : p.k_norm[l * 64 + tid - 64];
  const int qi = 32 * w + r;
  const int tq = (128 * nb + qi) * d + res;
  u32x4 vraw[8], qraw[4], kraw[5][4];
  {
    const int lk = 128 * (nb - 1) + tid, lkc = lk < 0 ? 0 : lk;
    const u32x4* src = (const u32x4*)(zv + (size_t)lkc * 64);
#pragma unroll
    for (int i = 0; i < 8; ++i) vraw[i] = src[i];
    const bf16_t* qp = zq + (size_t)(128 * nb + qi) * 64 + 8 * hf;
#pragma unroll
    for (int s = 0; s < 4; ++s) qraw[s] = *(const u32x4*)(qp + 16 * s);
#pragma unroll
    for (int i = 0; i < 2; ++i) {
      const int lkk = 128 * (nb - 1) + 32 * (w + i) + r, lkkc = lkk < 0 ? 0 : lkk;
      const bf16_t* kp = zk + (size_t)lkkc * 64 + 8 * hf;
#pragma unroll
      for (int s = 0; s < 4; ++s) kraw[i][s] = *(const u32x4*)(kp + 16 * s);
    }
  }
  __builtin_amdgcn_sched_barrier(0);
  {
    const int key = tid;
#pragma unroll
    for (int i = 0; i < 8; ++i)
#pragma unroll
      for (int e = 0; e < 4; ++e) {
        VT[(8 * i + 2 * e) * 264 + key] = (bf16_t)(vraw[i][e] & 0xffffu);
        VT[(8 * i + 2 * e + 1) * 264 + key] = (bf16_t)(vraw[i][e] >> 16);
      }
  }
  __syncthreads();
  bf16x8 qf[4];
  {
    float qv[4][8]; float ss = 0.f;
#pragma unroll
    for (int s = 0; s < 4; ++s) {
      unpack8(qraw[s], qv[s]);
#pragma unroll
      for (int j = 0; j < 8; ++j) ss += qv[s][j] * qv[s][j];
    }
    ss += shx(ss, 32, lane);
    const float rstd = rsqrtf(ss * (1.f / 64.f) + EPS) * 0.125f;
#pragma unroll
    for (int s = 0; s < 4; ++s) {
      const float* gn = nrm + 16 * s + 8 * hf;
      float o[8];
#pragma unroll
      for (int j = 0; j < 8; ++j) o[j] = qv[s][j] * rstd * gn[j];
      qf[s] = __builtin_bit_cast(bf16x8, pack8(o));
    }
  }
  f32x16 st[5];
#pragma unroll
  for (int i = 0; i < 5; ++i) {
    if (i + 2 < 5 && (nb > 0 || w + i + 2 >= 4)) {
      const int lkk = 128 * (nb - 1) + 32 * (w + i + 2) + r, lkkc = lkk < 0 ? 0 : lkk;
      const bf16_t* kp = zk + (size_t)lkkc * 64 + 8 * hf;
#pragma unroll
      for (int s = 0; s < 4; ++s) kraw[i + 2][s] = *(const u32x4*)(kp + 16 * s);
    }
    __builtin_amdgcn_sched_barrier(0);
#pragma unroll
    for (int e = 0; e < 16; ++e) st[i][e] = 0.f;
    if (nb > 0 || w + i >= 4) {
      float kv[4][8]; float ss = 0.f;
#pragma unroll
      for (int s = 0; s < 4; ++s) {
        unpack8(kraw[i][s], kv[s]);
#pragma unroll
        for (int j = 0; j < 8; ++j) ss += kv[s][j] * kv[s][j];
      }
      ss += shx(ss, 32, lane);
      const float rstd = rsqrtf(ss * (1.f / 64.f) + EPS);
#pragma unroll
      for (int s = 0; s < 4; ++s) {
        const float* gn = nrm + 64 + 16 * s + 8 * hf;
        float o[8];
#pragma unroll
        for (int j = 0; j < 8; ++j) o[j] = kv[s][j] * rstd * gn[j];
        const bf16x8 kf = __builtin_bit_cast(bf16x8, pack8(o));
        st[i] = MFMA32(kf, qf[s], st[i]);
      }
    }
  }
  float mx = -3.0e38f;
#pragma unroll
  for (int i = 0; i < 5; ++i)
#pragma unroll
    for (int e = 0; e < 16; ++e) {
      const int c = (e & 3) + 8 * (e >> 2) + 4 * hf;
      const bool valid = (nb > 0 || w + i >= 4) && (i == 0 ? c >= r : (i == 4 ? c <= r : true));
      st[i][e] = valid ? st[i][e] : -3.0e38f;
      mx = fmaxf(mx, st[i][e]);
    }
  mx = fmaxf(mx, shx(mx, 32, lane));
  float den = 0.f;
#pragma unroll
  for (int i = 0; i < 5; ++i)
#pragma unroll
    for (int e = 0; e < 16; ++e) {
      const float pe = (st[i][e] > -1.0e38f) ? __expf(st[i][e] - mx) : 0.f;
      st[i][e] = pe; den += pe;
    }
  den += shx(den, 32, lane);
  f32x16 ot[2];
#pragma unroll
  for (int dt = 0; dt < 2; ++dt)
#pragma unroll
    for (int e = 0; e < 16; ++e) ot[dt][e] = 0.f;
#pragma unroll
  for (int i = 0; i < 5; ++i)
#pragma unroll
    for (int s2 = 0; s2 < 2; ++s2) if (nb > 0 || w + i >= 4) {
      u32x4 pp;
      pp[0] = pk2(st[i][8 * s2 + 0], st[i][8 * s2 + 1]); pp[1] = pk2(st[i][8 * s2 + 2], st[i][8 * s2 + 3]);
      pp[2] = pk2(st[i][8 * s2 + 4], st[i][8 * s2 + 5]); pp[3] = pk2(st[i][8 * s2 + 6], st[i][8 * s2 + 7]);
      const bf16x8 pf = __builtin_bit_cast(bf16x8, pp);
#pragma unroll
      for (int dt = 0; dt < 2; ++dt) {
        const bf16_t* vp = VT + (32 * dt + r) * 264 + 32 * (w + i) + 16 * s2 + 4 * hf;
        const u32x2 lo = *(const u32x2*)vp, hi = *(const u32x2*)(vp + 8);
        u32x4 vv; vv[0] = lo[0]; vv[1] = lo[1]; vv[2] = hi[0]; vv[3] = hi[1];
        ot[dt] = MFMA32(__builtin_bit_cast(bf16x8, vv), pf, ot[dt]);
      }
    }
  const float inv = 1.f / den;
  const size_t tok = (size_t)b * SEQ + tq;
#pragma unroll
  for (int dt = 0; dt < 2; ++dt)
#pragma unroll
    for (int r4 = 0; r4 < 4; ++r4) {
      u32x2 wv; wv[0] = pk2(ot[dt][4 * r4 + 0] * inv, ot[dt][4 * r4 + 1] * inv); wv[1] = pk2(ot[dt][4 * r4 + 2] * inv, ot[dt][4 * r4 + 3] * inv);
      *(u32x2*)(WSB(p, og) + tok * 768 + qcol + 32 * dt + 8 * r4 + 4 * hf) = wv;
    }
  if (hf == 0) WSF(p, lse)[tok * 12 + g * 4 + hh] = mx + __logf(den);
  __syncthreads();
}

DI int lnd(int v) { asm volatile("" : "+s"(v)); return v; }
DI void dn_f1_item(const Params& p, int l, int chunk, char* lds) {
  const int tid = opaque_tid(), lane = tid & 63, w = tid >> 6, fr = lane & 15, fq = lane >> 4;
  const int n = chunk & 31, bh = chunk >> 5, h = bh & 7, b = bh >> 3;
  const int t0 = n * 64;
  const size_t rowbase = (size_t)b * SEQ;
  bf16_t* Qn = (bf16_t*)lds;
  bf16_t* Kn = (bf16_t*)(lds + 17408);
  bf16_t* KB = (bf16_t*)(lds + 2 * 17408);
  bf16_t* Vs = (bf16_t*)(lds + 3 * 17408);
  float* gcs = (float*)(lds + 4 * 17408);
  float* betas = gcs + 64;
  float* egc = gcs + 128;
  float* Am = (float*)lds;
  if (w == 0) {
    const size_t row = rowbase + t0 + lane;
    const float a = WSF(p, ab)[row * 16 + h], bb = WSF(p, ab)[row * 16 + 8 + h];
    const float xx = a + p.dt_bias[l * 8 + h];
    const float sp = xx > 20.f ? xx : log1pf(__expf(xx));
    float s = -__expf(p.a_log[l * 8 + h]) * sp;
#pragma unroll
    for (int off = 1; off < 64; off <<= 1) { const float t = shup(s, off, lane); if (lane >= off) s += t; }
    gcs[lane] = s; betas[lane] = sigmoidf_(bb); egc[lane] = __expf(s);
    if (lane == 63) WSF(p, dGL)[chunk] = __expf(s);
  }
  __syncthreads();
  const float gclast = gcs[63];
  const int cg8 = (tid & 15) * 8, rg = tid >> 4;
#pragma unroll 1
  for (int seg = 0; seg < 3; ++seg) {
    u32x4 rows[7];
#pragma unroll
    for (int r = 0; r < 7; ++r) {
      const int tt = t0 + 4 * rg - 3 + r;
      rows[r] = (u32x4){0u, 0u, 0u, 0u};
      if (tt >= 0) rows[r] = *(const u32x4*)(WSB(p, zdn) + ((size_t)(((b * 8 + h) * 3 + seg) * 2048 + tt)) * 128 + cg8);
    }
    float cw[4][8];
#pragma unroll
    for (int tap = 0; tap < 4; ++tap) {
      const float* cp = p.conv_w + ((size_t)l * 4 + tap) * 3072 + seg * 1024 + h * 128 + cg8;
      const f32x4 c0 = *(const f32x4*)cp, c1 = *(const f32x4*)(cp + 4);
      cw[tap][0] = c0[0]; cw[tap][1] = c0[1]; cw[tap][2] = c0[2]; cw[tap][3] = c0[3];
      cw[tap][4] = c1[0]; cw[tap][5] = c1[1]; cw[tap][6] = c1[2]; cw[tap][7] = c1[3];
    }
#pragma unroll
    for (int jt = 0; jt < 4; ++jt) {
      const int i = 4 * rg + jt;
      float val[8];
#pragma unroll
      for (int e = 0; e < 8; ++e) val[e] = 0.f;
#pragma unroll
      for (int tap = 0; tap < 4; ++tap) {
        float xv[8]; unpack8(rows[jt + tap], xv);
#pragma unroll
        for (int e = 0; e < 8; ++e) val[e] += cw[tap][e] * xv[e];
      }
      float ss = 0.f;
#pragma unroll
      for (int e = 0; e < 8; ++e) { val[e] = siluf_(val[e]); ss += val[e] * val[e]; }
      ss += shx(ss, 1, lane); ss += shx(ss, 2, lane); ss += shx(ss, 4, lane); ss += shx(ss, 8, lane);
      const float rn = rsqrtf(ss + EPS);
      if (seg == 0) {
        const float eg = egc[i];
        float qv[8], qd[8];
#pragma unroll
        for (int e = 0; e < 8; ++e) { qv[e] = val[e] * rn * 0.08838834764831845f; qd[e] = qv[e] * eg; }
        *(u32x4*)(Qn + i * 136 + cg8) = pack8(qv);
        *(u32x4*)(WSB(p, dQD) + ((size_t)lnd(chunk) * 64 + i) * 128 + cg8) = pack8(qd);
      } else if (seg == 1) {
        const float bt = betas[i];
        float kv[8], kb[8];
#pragma unroll
        for (int e = 0; e < 8; ++e) { kv[e] = val[e] * rn; kb[e] = kv[e] * bt; }
        *(u32x4*)(Kn + i * 136 + cg8) = pack8(kv);
        *(u32x4*)(KB + i * 136 + cg8) = pack8(kb);
      } else {
        *(u32x4*)(Vs + i * 136 + cg8) = pack8(val);
      }
    }
  }
  __syncthreads();
  {
    const int dcol = tid >> 1, half = tid & 1;
    u32x4 o4[4];
#pragma unroll
    for (int q = 0; q < 4; ++q)
#pragma unroll
      for (int e = 0; e < 4; ++e) {
        const int i0 = 32 * half + 8 * q + 2 * e;
        const float k0 = bf2f(Kn[i0 * 136 + dcol]) * __expf(gclast - gcs[i0]);
        const float k1 = bf2f(Kn[(i0 + 1) * 136 + dcol]) * __expf(gclast - gcs[i0 + 1]);
        o4[q][e] = pk2(k0, k1);
      }
    u32x4* dst = (u32x4*)(WSB(p, dKDT) + ((size_t)lnd(chunk) * 128 + dcol) * 64 + 32 * half);
#pragma unroll
    for (int q = 0; q < 4; ++q) dst[q] = o4[q];
  }
  f32x4 kk[4], qk[4];
#pragma unroll
  for (int nn = 0; nn < 4; ++nn) { kk[nn] = (f32x4){0.f, 0.f, 0.f, 0.f}; qk[nn] = (f32x4){0.f, 0.f, 0.f, 0.f}; }
#pragma unroll
  for (int s = 0; s < 4; ++s) {
    const bf16x8 akb = *(const bf16x8*)(KB + (16 * w + fr) * 136 + 32 * s + 8 * fq);
    const bf16x8 aq = *(const bf16x8*)(Qn + (16 * w + fr) * 136 + 32 * s + 8 * fq);
#pragma unroll
    for (int nn = 0; nn < 4; ++nn) {
      const bf16x8 bk = *(const bf16x8*)(Kn + (16 * nn + fr) * 136 + 32 * s + 8 * fq);
      kk[nn] = MFMA16(akb, bk, kk[nn]);
      qk[nn] = MFMA16(aq, bk, qk[nn]);
    }
  }
  __syncthreads();
#pragma unroll
  for (int nn = 0; nn < 4; ++nn)
#pragma unroll
    for (int j = 0; j < 4; ++j) {
      const int i = 16 * w + 4 * fq + j, jj = 16 * nn + fr;
      const float dec = __expf(fminf(gcs[i] - gcs[jj], 0.f));
      Am[i * 64 + jj] = (jj < i) ? kk[nn][j] * dec : 0.f;
      Kn[i * 72 + jj] = f2bf((jj <= i) ? qk[nn][j] * dec : 0.f);
    }
  __syncthreads();
#pragma unroll
  for (int ps = 0; ps < 2; ++ps) {
    const int id = tid + 256 * ps, i = id >> 3, c8 = (id & 7) * 8;
    *(u32x4*)(WSB(p, dAI) + ((size_t)lnd(chunk) * 64 + i) * 64 + c8) = *(const u32x4*)(Kn + i * 72 + c8);
  }
  {
    const int c = tid & 127; const bool isW = tid >= 128;
    const bf16_t* rsrc = isW ? KB : Vs;
    const float* msrc = isW ? egc : betas;
    float x[64];
#pragma unroll
    for (int i = 0; i < 64; ++i) x[i] = 0.f;
#pragma unroll
    for (int i = 0; i < 64; ++i) {
      const float rhs = bf2f(rsrc[i * 136 + c]) * msrc[i];
      float s0 = 0.f, s1 = 0.f, s2 = 0.f, s3 = 0.f;
#pragma unroll
      for (int j4 = 0; j4 < (i + 3) / 4; ++j4) {
        const f32x4 a = *(const f32x4*)(Am + i * 64 + 4 * j4);
        s0 += a[0] * x[4 * j4]; s1 += a[1] * x[4 * j4 + 1]; s2 += a[2] * x[4 * j4 + 2]; s3 += a[3] * x[4 * j4 + 3];
      }
      x[i] = rhs - ((s0 + s1) + (s2 + s3));
    }
    if (!isW) {
      u32x4* dst = (u32x4*)(WSB(p, dUT) + ((size_t)lnd(chunk) * 128 + c) * 64);
#pragma unroll
      for (int q = 0; q < 8; ++q) {
        u32x4 o; o[0] = pk2(x[8 * q], x[8 * q + 1]); o[1] = pk2(x[8 * q + 2], x[8 * q + 3]); o[2] = pk2(x[8 * q + 4], x[8 * q + 5]); o[3] = pk2(x[8 * q + 6], x[8 * q + 7]);
        dst[q] = o;
      }
    }
    __syncthreads();
    if (isW) {
#pragma unroll
      for (int i = 0; i < 64; ++i) Kn[i * 136 + c] = f2bf(x[i]);
    }
  }
  __syncthreads();
#pragma unroll
  for (int ps = 0; ps < 4; ++ps) {
    const int id = tid + 256 * ps, i = id >> 4, c8 = (id & 15) * 8;
    *(u32x4*)(WSB(p, dW) + ((size_t)lnd(chunk) * 64 + i) * 128 + c8) = *(const u32x4*)(Kn + i * 136 + c8);
  }
  __syncthreads();
}

#define LDS_BARRIER() do { asm volatile("s_waitcnt lgkmcnt(0)" ::: "memory"); __builtin_amdgcn_s_barrier(); asm volatile("" ::: "memory"); } while (0)
DI void dn_f2_item(const Params& p, int item, char* lds) {
  const int tid = opaque_tid(), lane = tid & 63, w = tid >> 6, fr = lane & 15, fq = lane >> 4;
  const int vs = item & 3, bh = item >> 2, h = bh & 7, b = bh >> 3;
  bf16_t* ST = (bf16_t*)lds;
  bf16_t* VT = (bf16_t*)(lds + 32 * 272);
  bf16_t* OT = (bf16_t*)(lds + 32 * 272 + 32 * 144);
  for (int i = tid; i < 32 * 136; i += 256) ST[i] = 0;
  f32x4 accS[2][2];
#pragma unroll
  for (int nn = 0; nn < 2; ++nn)
#pragma unroll
    for (int m = 0; m < 2; ++m) accS[nn][m] = (f32x4){0.f, 0.f, 0.f, 0.f};
  __syncthreads();
  bf16x8 naw[4], naq[4], naa[2], nak[2][2]; u32x2 nuu[2]; float ngl;
#define F2_LOAD(n_)                                                                                                     \
  {                                                                                                                     \
    const size_t chunk_ = (size_t)bh * 32 + (n_);                                                                       \
    const bf16_t* Wc = WSB(p, dW) + chunk_ * 8192; const bf16_t* QDc = WSB(p, dQD) + chunk_ * 8192;                     \
    const bf16_t* AIc = WSB(p, dAI) + chunk_ * 4096; const bf16_t* KDTc = WSB(p, dKDT) + chunk_ * 8192;                 \
    const bf16_t* UTc = WSB(p, dUT) + chunk_ * 8192;                                                                    \
    _Pragma("unroll") for (int s = 0; s < 4; ++s) {                                                                     \
      naw[s] = *(const bf16x8*)(Wc + (16 * w + fr) * 128 + 32 * s + 8 * fq);                                            \
      naq[s] = *(const bf16x8*)(QDc + (16 * w + fr) * 128 + 32 * s + 8 * fq);                                           \
    }                                                                                                                   \
    _Pragma("unroll") for (int s = 0; s < 2; ++s) {                                                                     \
      naa[s] = *(const bf16x8*)(AIc + (16 * w + fr) * 64 + 32 * s + 8 * fq);                                            \
      _Pragma("unroll") for (int nn = 0; nn < 2; ++nn) nak[s][nn] = *(const bf16x8*)(KDTc + (32 * w + 16 * nn + fr) * 64 + 32 * s + 8 * fq); \
    }                                                                                                                   \
    _Pragma("unroll") for (int m = 0; m < 2; ++m) nuu[m] = *(const u32x2*)(UTc + (vs * 32 + 16 * m + fr) * 64 + 16 * w + 4 * fq); \
    ngl = WSF(p, dGL)[chunk_];                                                                                          \
  }
  F2_LOAD(0);
  for (int n = 0; n < 32; ++n) {
    bf16x8 aw[4], aq[4], aa[2], ak[2][2]; u32x2 uu[2];
#pragma unroll
    for (int s = 0; s < 4; ++s) { aw[s] = naw[s]; aq[s] = naq[s]; }
#pragma unroll
    for (int s = 0; s < 2; ++s) { aa[s] = naa[s]; ak[s][0] = nak[s][0]; ak[s][1] = nak[s][1]; uu[s] = nuu[s]; }
    const float gl = ngl;
    if (n + 1 < 32) F2_LOAD(n + 1);
    f32x4 ws[2], qs[2];
#pragma unroll
    for (int m = 0; m < 2; ++m) { ws[m] = (f32x4){0.f, 0.f, 0.f, 0.f}; qs[m] = (f32x4){0.f, 0.f, 0.f, 0.f}; }
#pragma unroll
    for (int s = 0; s < 4; ++s) {
#pragma unroll
      for (int m = 0; m < 2; ++m) {
        const bf16x8 bs = *(const bf16x8*)(ST + (16 * m + fr) * 136 + 32 * s + 8 * fq);
        ws[m] = MFMA16(aw[s], bs, ws[m]);
        qs[m] = MFMA16(aq[s], bs, qs[m]);
      }
    }
#pragma unroll
    for (int m = 0; m < 2; ++m) {
      const float v0 = bflo(uu[m][0]) - ws[m][0], v1 = bfhi(uu[m][0]) - ws[m][1], v2 = bflo(uu[m][1]) - ws[m][2], v3 = bfhi(uu[m][1]) - ws[m][3];
      u32x2 o; o[0] = pk2(v0, v1); o[1] = pk2(v2, v3);
      *(u32x2*)(VT + (16 * m + fr) * 72 + 16 * w + 4 * fq) = o;
    }
    LDS_BARRIER();
    bf16x8 bv[2][2];
#pragma unroll
    for (int s = 0; s < 2; ++s)
#pragma unroll
      for (int m = 0; m < 2; ++m) bv[s][m] = *(const bf16x8*)(VT + (16 * m + fr) * 72 + 32 * s + 8 * fq);
#pragma unroll
    for (int s = 0; s < 2; ++s)
#pragma unroll
      for (int m = 0; m < 2; ++m) qs[m] = MFMA16(aa[s], bv[s][m], qs[m]);
#pragma unroll
    for (int m = 0; m < 2; ++m)
#pragma unroll
      for (int j = 0; j < 4; ++j) OT[(16 * w + 4 * fq + j) * 40 + 16 * m + fr] = f2bf(qs[m][j]);
#pragma unroll
    for (int nn = 0; nn < 2; ++nn)
#pragma unroll
      for (int m = 0; m < 2; ++m) accS[nn][m] = accS[nn][m] * gl;
#pragma unroll
    for (int s = 0; s < 2; ++s)
#pragma unroll
      for (int nn = 0; nn < 2; ++nn)
#pragma unroll
        for (int m = 0; m < 2; ++m) accS[nn][m] = MFMA16(ak[s][nn], bv[s][m], accS[nn][m]);
#pragma unroll
    for (int nn = 0; nn < 2; ++nn)
#pragma unroll
      for (int m = 0; m < 2; ++m) {
        u32x2 o; o[0] = pk2(accS[nn][m][0], accS[nn][m][1]); o[1] = pk2(accS[nn][m][2], accS[nn][m][3]);
        *(u32x2*)(ST + (16 * m + fr) * 136 + 32 * w + 16 * nn + 4 * fq) = o;
      }
    LDS_BARRIER();
    {
      const int tk = tid >> 2, c8 = (tid & 3) * 8;
      *(u32x4*)(WSB(p, oraw) + ((size_t)b * SEQ + n * 64 + tk) * DM + h * 128 + vs * 32 + c8) = *(const u32x4*)(OT + tk * 40 + c8);
    }
  }
#undef F2_LOAD
}

DI void elem_phase(const Params& p, int l) {
  const int tid = opaque_tid(), lane = tid & 63;
  const size_t stride = (size_t)VGRID * 256;
  for (size_t idx = (size_t)opaque_bid() * 256 + tid; idx < (size_t)MTOK * 32; idx += stride) {
    const size_t tok = idx >> 5; const int ch = (int)(idx & 31), hh = ch >> 3, d0 = (ch & 7) * 8;
    const float l0 = WSF(p, lse)[tok * 12 + hh], l1 = WSF(p, lse)[tok * 12 + 4 + hh], l2 = WSF(p, lse)[tok * 12 + 8 + hh];
    const float mx = fmaxf(l0, fmaxf(l1, l2));
    const float e0 = __expf(l0 - mx), e1 = __expf(l1 - mx), e2 = __expf(l2 - mx);
    const float inv = 1.f / (e0 + e1 + e2);
    const float wg[3] = {e0 * inv, e1 * inv, e2 * inv};
    float y[8];
#pragma unroll
    for (int e = 0; e < 8; ++e) y[e] = 0.f;
#pragma unroll
    for (int g = 0; g < 3; ++g) {
      const u32x4 raw = *(const u32x4*)(WSB(p, og) + tok * 768 + g * 256 + hh * 64 + d0);
      float v[8]; unpack8(raw, v);
#pragma unroll
      for (int e = 0; e < 8; ++e) y[e] += wg[g] * v[e];
    }
    *(u32x4*)(WSB(p, yatt) + tok * 256 + hh * 64 + d0) = pack8(y);
  }
  for (size_t idx = (size_t)opaque_bid() * 256 + tid; idx < (size_t)MTOK * 128; idx += stride) {
    const size_t tok = idx >> 7; const int col = (int)(idx & 127) * 8;
    const u32x4 raw = *(const u32x4*)(WSB(p, oraw) + tok * DM + col);
    float v[8]; unpack8(raw, v);
    float ss = 0.f;
#pragma unroll
    for (int e = 0; e < 8; ++e) ss += v[e] * v[e];
    ss += shx(ss, 1, lane); ss += shx(ss, 2, lane); ss += shx(ss, 4, lane); ss += shx(ss, 8, lane);
    const float rstd = rsqrtf(ss * (1.f / 128.f) + EPS);
    const u32x4 graw = *(const u32x4*)(WSB(p, z) + tok * ZLD + Z_DNGATE + col);
    float gz[8]; unpack8(graw, gz);
    const float* gn = p.dn_norm + l * 128 + (col & 127);
    float y[8];
#pragma unroll
    for (int e = 0; e < 8; ++e) y[e] = v[e] * rstd * gn[e] * siluf_(gz[e]);
    *(u32x4*)(WSB(p, odn) + tok * DM + col) = pack8(y);
  }
}


#define XB_TMO      128
#define XB_XCNT(j)  (256  + 64 * (j))
#define XB_XSUB(j)  (1280 + 64 * (j))
#define XB_XGEN(j)  (2304 + 64 * (j))
#define XB_TOP      3328
#define XB_TOPGEN   3392
#define XCD_BAR_WORDS 3456
#define XB_SPIN_CAP (1u << 22)
#define LAS __attribute__((address_space(3)))
DI unsigned xb_ld(unsigned* p)              { return __hip_atomic_load(p, __ATOMIC_RELAXED, __HIP_MEMORY_SCOPE_AGENT); }
DI unsigned xb_add(unsigned* p, unsigned v) { return __hip_atomic_fetch_add(p, v, __ATOMIC_RELAXED, __HIP_MEMORY_SCOPE_AGENT); }
DI unsigned xb_xcc_id() { return (unsigned)__builtin_amdgcn_s_getreg((3 << 11) | 20) & 0xFu; }
#define XB_SPIN(cond, bar) do { unsigned _sp = 0; while (cond) { __builtin_amdgcn_s_sleep(1); \
    if ((++_sp & 255u) == 0u) { if (xb_ld(&(bar)[XB_TMO])) break; if (_sp > XB_SPIN_CAP) { atomicAdd(&(bar)[XB_TMO], 1u); break; } } } } while (0)
struct XcdBarrier { unsigned* bar; unsigned x; volatile LAS unsigned* st; };
DI XcdBarrier xcd_barrier_post(unsigned* bar, volatile LAS unsigned* st) {
  XcdBarrier b; b.bar = bar; b.x = xb_xcc_id(); b.st = st;
  if (threadIdx.x == 0) (void)xb_add(&bar[XB_XCNT(b.x)], 1u);
  return b;
}
DI void xcd_barrier_complete(unsigned* bar, unsigned x, unsigned& nloc, unsigned& nx) {
  const unsigned G = gridDim.x * gridDim.y * gridDim.z;
  unsigned sum, cnt, mine, sp = 0u;
  for (;;) {
    sum = 0u; cnt = 0u; mine = 0u;
#pragma unroll
    for (unsigned j = 0; j < 16; ++j) { const unsigned c = xb_ld(&bar[XB_XCNT(j)]); sum += c; cnt += (c > 0u) ? 1u : 0u; mine = (j == x) ? c : mine; }
    if (sum == G) break;
    __builtin_amdgcn_s_sleep(1);
    if ((++sp & 255u) == 0u) { if (xb_ld(&bar[XB_TMO])) break; if (sp > XB_SPIN_CAP) { atomicAdd(&bar[XB_TMO], 1u); break; } }
  }
  nloc = mine > 0u ? mine : 1u; nx = cnt > 0u ? cnt : 1u;
}
DI void xcd_barrier_impl(const XcdBarrier& b) {
  asm volatile("s_waitcnt vmcnt(0)" ::: "memory");
  __syncthreads();
  if (threadIdx.x == 0) {
    unsigned* bar = b.bar; asm volatile("" : "+s"(bar));
    __builtin_amdgcn_s_waitcnt(0);
    const unsigned nloc = b.st[0], nx = b.st[1];
    const unsigned old = xb_add(&bar[XB_XSUB(b.x)], 1u);
    const unsigned gen = old / nloc;
    if (old + 1u == (gen + 1u) * nloc) {
      __builtin_amdgcn_fence(__ATOMIC_RELEASE, "agent");
      asm volatile("s_waitcnt vmcnt(0)" ::: "memory");
      const unsigned og = xb_add(&bar[XB_TOP], 1u);
      const unsigned tg = og / nx;
      if (og + 1u == (tg + 1u) * nx) xb_add(&bar[XB_TOPGEN], 1u);
      else XB_SPIN(xb_ld(&bar[XB_TOPGEN]) == tg, bar);
      __builtin_amdgcn_fence(__ATOMIC_ACQUIRE, "agent");
      xb_add(&bar[XB_XGEN(b.x)], 1u);
      asm volatile("s_waitcnt vmcnt(0)" ::: "memory");
    } else {
      XB_SPIN(xb_ld(&bar[XB_XGEN(b.x)]) == gen, bar);
      __builtin_amdgcn_fence(__ATOMIC_ACQUIRE, "agent");
      asm volatile("s_waitcnt vmcnt(0)" ::: "memory");
    }
  }
  __syncthreads();
}

DI void xcd_barrier_census(char* ws, char* lds) {
  if (threadIdx.x == 0) {
    unsigned nloc, nx; xcd_barrier_complete((unsigned*)(ws + O_bar), xb_xcc_id(), nloc, nx);
    volatile LAS unsigned* st = (volatile LAS unsigned*)(lds + LDS_BYTES); st[0] = nloc; st[1] = nx;
  }
  __syncthreads();
}
DI void xcd_barrier_ws(char* ws, char* lds) {
  XcdBarrier b; b.bar = (unsigned*)(ws + O_bar); b.x = xb_xcc_id(); b.st = (volatile LAS unsigned*)(lds + LDS_BYTES);
  xcd_barrier_impl(b);
}
__global__ void __launch_bounds__(512, 2) fwd_megakernel(Params p) {
  __shared__ __attribute__((aligned(16))) char lds[LDS_BYTES + 16];
  cg::grid_group grid = cg::this_grid();
  if (threadIdx.x == 0) { *(volatile LAS unsigned*)(lds + LDS_BYTES) = 0u; *(volatile LAS unsigned*)(lds + LDS_BYTES + 4) = 0u; }
  __syncthreads();
  (void)xcd_barrier_post((unsigned*)(p.ws + O_bar), (volatile LAS unsigned*)(lds + LDS_BYTES));
  phase0(p, vlds(lds));
  convert_layer(p, 0, vlds(lds), opaque_bid(), VGRID);
  grid.sync();
  xcd_barrier_census(p.ws, lds);
  for (int l = 0; l < DEPTH; ++l) {
    const float* modl = WSF(p, mod) + (size_t)l * 8 * 9216;
    norm_phase(p, p.norm_ff1 + l * DM, modl + 0 * DM, modl + 1 * DM);
    xcd_barrier_ws(p.ws, lds);
    gemm_up_phase(p, WSW(p, W_up1, l), lds);
    xcd_barrier_ws(p.ws, lds);
    gemm_res_phase(p, WSB(p, hidden), DFF, WSW(p, W_down1, l), modl + 2 * DM, 0.5f, lds);
    xcd_barrier_ws(p.ws, lds);
    norm_phase(p, p.norm_mix + l * DM, modl + 3 * DM, modl + 4 * DM);
    xcd_barrier_ws(p.ws, lds);
    gemm_in_phase(p, WSW(p, W_in, l), lds);
    xcd_barrier_ws(p.ws, lds);
    {
      char* vl = vlds(lds);
      for (int it = opaque_bid(); it < 2048 + 512; it += VGRID) {
        if (it < 2048) dn_f1_item(p, l, it, vl); else attn_item(p, l, it - 2048, vl);
      }
    }
    xcd_barrier_ws(p.ws, lds);
    {
      char* vl = vlds(lds);
      const int vb = opaque_bid();
      if (vb < 256) dn_f2_item(p, vb, vl);
      else {
        for (int it = 512 + vb - 256; it < 1536; it += VGRID - 256) attn_item(p, l, it, vl);
        if (l + 1 < DEPTH) convert_layer(p, l + 1, vl, vb - 256, VGRID - 256);
      }
    }
    xcd_barrier_ws(p.ws, lds);
    elem_phase(p, l);
    xcd_barrier_ws(p.ws, lds);
    gemm_proj_phase(p, WSW(p, W_pa, l), WSW(p, W_pd, l), lds);
    xcd_barrier_ws(p.ws, lds);
    gemm_res_phase(p, WSB(p, mrg), DM, WSW(p, W_out, l), modl + 5 * DM, 1.0f, lds);
    xcd_barrier_ws(p.ws, lds);
    norm_phase(p, p.norm_ff2 + l * DM, modl + 6 * DM, modl + 7 * DM);
    xcd_barrier_ws(p.ws, lds);
    gemm_up_phase(p, WSW(p, W_up2, l), lds);
    xcd_barrier_ws(p.ws, lds);
    gemm_res_phase(p, WSB(p, hidden), DFF, WSW(p, W_down2, l), modl + 8 * DM, 0.5f, lds);
    xcd_barrier_ws(p.ws, lds);
  }
}

extern "C" void kernel_launch(void* const* d_in, const int* in_sizes, int n_in, void* d_out, int out_size, void* d_ws, size_t ws_size, hipStream_t stream) {
  static int grid_blocks = 0;
  if (!grid_blocks) {
    int dev = 0, cus = 0, per_cu = 0;
    hipGetDevice(&dev);
    hipDeviceGetAttribute(&cus, hipDeviceAttributeMultiprocessorCount, dev);
    hipOccupancyMaxActiveBlocksPerMultiprocessor(&per_cu, fwd_megakernel, 512, 0);
    if (per_cu > 1) per_cu = 1;
    grid_blocks = cus * per_cu;
    if (grid_blocks % 8) grid_blocks -= grid_blocks % 8;
  }
  Params p{};
  const float* const* in = (const float* const*)d_in;
  p.x = in[0]; p.c = in[1]; p.ada_w = in[2]; p.ada_b = in[3]; p.norm_ff1 = in[4]; p.w_up1 = in[5]; p.w_down1 = in[6]; p.norm_mix = in[7];
  p.w_in = in[8]; p.q_norm = in[9]; p.k_norm = in[10]; p.conv_w = in[11]; p.a_log = in[12]; p.dt_bias = in[13]; p.dn_norm = in[14];
  p.w_pa = in[15]; p.w_pd = in[16]; p.w_out = in[17]; p.norm_ff2 = in[18]; p.w_up2 = in[19]; p.w_down2 = in[20];
  p.out = (float*)d_out;
  p.ws = (char*)d_ws;
  if (WS_TOTAL > ws_size) { fprintf(stderr, "kernel_launch: workspace too small (%zu needed, %zu given)\n", (size_t)WS_TOTAL, ws_size); return; }
  if (hipMemsetAsync(p.ws + O_bar, 0, (size_t)3456 * 4, stream) != hipSuccess) fprintf(stderr, "kernel_launch: barrier memset failed\n");
  void* args[] = {&p};
  hipError_t e = hipLaunchCooperativeKernel((void*)fwd_megakernel, dim3(grid_blocks), dim3(512), args, 0, stream);
  if (e != hipSuccess) fprintf(stderr, "cooperative launch failed: %s (grid %d)\n", hipGetErrorString(e), grid_blocks);
}
```

```cpp
#include <hip/hip_runtime.h>
#include <hip/hip_cooperative_groups.h>
#include <cstdio>
#include <cstdint>
namespace cg = cooperative_groups;

typedef unsigned short bf16_t;
typedef short bf16x8 __attribute__((ext_vector_type(8)));
typedef short s16x4 __attribute__((ext_vector_type(4)));
typedef float f32x4 __attribute__((ext_vector_type(4)));
typedef float f32x16 __attribute__((ext_vector_type(16)));
typedef unsigned u32x4 __attribute__((ext_vector_type(4)));
typedef unsigned u32x2 __attribute__((ext_vector_type(2)));

#define DI __device__ __forceinline__
#define MFMA16(a, b, c) __builtin_amdgcn_mfma_f32_16x16x32_bf16((a), (b), (c), 0, 0, 0)
#define MFMA32(a, b, c) __builtin_amdgcn_mfma_f32_32x32x16_bf16((a), (b), (c), 0, 0, 0)

constexpr int DM = 1024, NB = 8, SEQ = 2048, MTOK = NB * SEQ, DFF = 2816, DEPTH = 4;
constexpr int ZLD = 3072;
constexpr int NINP = 8704;
constexpr int Z_DNGATE = 0, Z_MERGE = 1024;
constexpr int LDS_BYTES = 147456;
constexpr int VLDS = 73728;
constexpr int LROW = 144;
constexpr int TILE_BYTES = 256 * LROW;
constexpr int STAGE_BYTES = 2 * TILE_BYTES;
constexpr float EPS = 1e-6f;

struct Params {
  const float *x, *c, *ada_w, *ada_b, *norm_ff1, *w_up1, *w_down1, *norm_mix, *w_in, *q_norm, *k_norm, *conv_w, *a_log, *dt_bias,
      *dn_norm, *w_pa, *w_pd, *w_out, *norm_ff2, *w_up2, *w_down2;
  float* out;
  char* ws;
};
constexpr size_t al256(size_t b) { return (b + 255) & ~(size_t)255; }
constexpr size_t O_W_up1 = 0;
constexpr size_t O_W_down1 = O_W_up1 + al256((size_t)2 * DFF * DM * 2);
constexpr size_t O_W_in = O_W_down1 + al256((size_t)DM * DFF * 2);
constexpr size_t O_W_pa = O_W_in + al256((size_t)NINP * DM * 2);
constexpr size_t O_W_pd = O_W_pa + al256((size_t)DM * 256 * 2);
constexpr size_t O_W_out = O_W_pd + al256((size_t)DM * DM * 2);
constexpr size_t O_W_up2 = O_W_out + al256((size_t)DM * DM * 2);
constexpr size_t O_W_down2 = O_W_up2 + al256((size_t)2 * DFF * DM * 2);
constexpr size_t WSET_BYTES = O_W_down2 + al256((size_t)DM * DFF * 2);
constexpr size_t O_h = 2 * WSET_BYTES;
constexpr size_t O_z = O_h + al256((size_t)MTOK * DM * 2);
constexpr size_t O_zatt = O_z + al256((size_t)MTOK * ZLD * 2);
constexpr size_t O_zdn = O_zatt + al256((size_t)MTOK * 2304 * 2);
constexpr size_t O_hidden = O_zatt;
constexpr size_t O_og = O_zdn + al256((size_t)MTOK * 3072 * 2);
constexpr size_t O_yatt = O_og + al256((size_t)MTOK * 768 * 2);
constexpr size_t O_dW = O_yatt + al256((size_t)MTOK * 256 * 2);
constexpr size_t O_dUT = O_dW + al256((size_t)MTOK * DM * 2);
constexpr size_t O_mrg = O_dUT;
constexpr size_t O_dQD = O_dUT + al256((size_t)MTOK * DM * 2);
constexpr size_t O_dKDT = O_dQD + al256((size_t)MTOK * DM * 2);
constexpr size_t O_dAI = O_dKDT + al256((size_t)MTOK * DM * 2);
constexpr size_t O_oraw = O_dAI + al256((size_t)2048 * 4096 * 2);
constexpr size_t O_odn = O_dW;
constexpr size_t O_ab = O_oraw + al256((size_t)MTOK * DM * 2);
constexpr size_t O_mod = O_ab + al256((size_t)MTOK * 16 * 4);
constexpr size_t O_lse = O_mod + al256((size_t)DEPTH * 8 * 9216 * 4);
constexpr size_t O_dGL = O_lse + al256((size_t)MTOK * 12 * 4);
constexpr size_t O_bar = O_dGL + al256((size_t)2048 * 4);
constexpr size_t WS_TOTAL = O_bar + al256((size_t)3456 * 4);
#define WSB(p, name) ((bf16_t*)((p).ws + O_##name))
#define WSW(p, name, l_) ((bf16_t*)((p).ws + O_##name + (size_t)((l_) & 1) * WSET_BYTES))
#define WSF(p, name) ((float*)((p).ws + O_##name))

DI int opaque_tid() { int t = threadIdx.x; asm volatile("" : "+v"(t)); return t & 255; }
DI int real_tid() { int t = threadIdx.x; asm volatile("" : "+v"(t)); return t; }
DI int opaque_bid() { int h = threadIdx.x; asm volatile("" : "+v"(h)); int t = blockIdx.x; asm volatile("" : "+s"(t)); return t * 2 + __builtin_amdgcn_readfirstlane(h >> 8); }
DI int real_bid() { int t = blockIdx.x; asm volatile("" : "+s"(t)); return t; }
#define VGRID ((int)gridDim.x * 2)
DI char* vlds(char* lds) { unsigned t = threadIdx.x; asm volatile("" : "+v"(t)); unsigned off = (t >> 8) * VLDS; asm volatile("" : "+v"(off)); return lds + off; }
typedef float f32x2 __attribute__((ext_vector_type(2)));
typedef __bf16 hwbf16x2 __attribute__((ext_vector_type(2)));
DI unsigned pk2(float lo, float hi) { const f32x2 v = {lo, hi}; return __builtin_bit_cast(unsigned, __builtin_convertvector(v, hwbf16x2)); }
DI unsigned short f2bf(float x) { return (unsigned short)(pk2(x, 0.f) & 0xffffu); }
DI float bf2f(unsigned short v) { return __uint_as_float(((unsigned)v) << 16); }
DI float bflo(unsigned u) { return __uint_as_float(u << 16); }
DI float bfhi(unsigned u) { return __uint_as_float(u & 0xffff0000u); }
DI float shx(float v, int mask, int lane) { return __int_as_float(__builtin_amdgcn_ds_bpermute((lane ^ mask) << 2, __float_as_int(v))); }
DI float shup(float v, int off, int lane) { return __int_as_float(__builtin_amdgcn_ds_bpermute((lane - off) << 2, __float_as_int(v))); }
DI float sigmoidf_(float x) { return 1.f / (1.f + __expf(-x)); }
DI float siluf_(float x) { return x / (1.f + __expf(-x)); }
DI void unpack8(const u32x4& r, float (&v)[8]) {
  v[0] = bflo(r[0]); v[1] = bfhi(r[0]); v[2] = bflo(r[1]); v[3] = bfhi(r[1]);
  v[4] = bflo(r[2]); v[5] = bfhi(r[2]); v[6] = bflo(r[3]); v[7] = bfhi(r[3]);
}
DI u32x4 pack8(const float (&v)[8]) { u32x4 r; r[0] = pk2(v[0], v[1]); r[1] = pk2(v[2], v[3]); r[2] = pk2(v[4], v[5]); r[3] = pk2(v[6], v[7]); return r; }

template <int MH> DI void gemm_core_simple(const bf16_t* __restrict__ A, int lda, const bf16_t* __restrict__ Bt, int ldb, int K, f32x4 (&acc)[MH][4], char* lds) {
  const int tid = real_tid(), lane = tid & 63, wid = tid >> 6, wr = wid >> 2, wc = wid & 3, fr = lane & 15, fq = lane >> 4;
  const int sl = lane ^ ((lane >> 5) << 1);
  const int R0 = (wid >> 1) * 16 + (sl >> 2), C0 = (wid & 1) * 32 + (sl & 3) * 8;
  const bf16_t* gA = A + (size_t)R0 * lda + C0;
  const bf16_t* gB = Bt + (size_t)R0 * ldb + C0;
  const size_t sA = (size_t)64 * lda, sB = (size_t)64 * ldb;
  unsigned st_off = (unsigned)tid * 16u;
  const unsigned rd_off = (unsigned)((fr * 64 + fq * 16) ^ ((fr >> 3) << 5));
  unsigned rd_a = (unsigned)(wr * (MH * 2048)) + rd_off;
  unsigned rd_b = 32768u + (unsigned)(wc * 4096) + rd_off;
  asm volatile("" : "+v"(st_off), "+v"(rd_a), "+v"(rd_b));
  const int nk = K >> 6;
#define GSTAGE(sbase_, k0_)                                                                                                        \
  {                                                                                                                                \
    _Pragma("unroll") for (int j = 0; j < 4; ++j) {                                                                                \
      if (j < MH / 2) __builtin_amdgcn_global_load_lds((const unsigned*)(gA + j * sA + (k0_)), (unsigned*)(lds + ((sbase_) + j * 8192 + st_off)), 16, 0, 0);          \
      __builtin_amdgcn_global_load_lds((const unsigned*)(gB + j * sB + (k0_)), (unsigned*)(lds + ((sbase_) + 32768 + j * 8192 + st_off)), 16, 0, 0);  \
    }                                                                                                                              \
  }
  GSTAGE(0u, 0);
  asm volatile("s_waitcnt vmcnt(0)" ::: "memory");
  __syncthreads();
#pragma unroll 1
  for (int kt = 0; kt < nk; ++kt) {
    const unsigned sbase = (unsigned)(kt & 1) << 16;
    if (kt + 1 < nk) GSTAGE(65536u - sbase, (kt + 1) * 64);
    const char* pa = lds + (rd_a + sbase);
    const char* pb = lds + (rd_b + sbase);
    bf16x8 af[2 * MH], b0[4], b1[4];
    constexpr int B1S = MH >= 5 ? MH - 5 : 0;
#define RDA(g_) af[g_] = *(const bf16x8*)(pa + ((g_) % MH) * 2048 + ((g_) / MH) * 1024)
#define RDB(ks_, n_) *(const bf16x8*)(pb + ((n_) >> 1) * 16384 + ((n_) & 1) * 2048 + (ks_) * 1024)
    b0[0] = RDB(0, 0); b0[1] = RDB(0, 1); b0[2] = RDB(0, 2); b0[3] = RDB(0, 3);
    RDA(0); RDA(1); RDA(2);
    __builtin_amdgcn_sched_barrier(0);
#pragma unroll
    for (int g = 0; g < 2 * MH; ++g) {
      if (g + 3 < 2 * MH) RDA(g + 3);
      if (g >= B1S && g < B1S + 4) b1[g - B1S] = RDB(1, g - B1S);
      __builtin_amdgcn_sched_barrier(0);
      if (g < MH) {
#pragma unroll
        for (int n = 0; n < 4; ++n) acc[g % MH][n] = MFMA16(b0[n], af[g], acc[g % MH][n]);
      } else {
#pragma unroll
        for (int n = 0; n < 4; ++n) acc[g % MH][n] = MFMA16(b1[n], af[g], acc[g % MH][n]);
      }
      __builtin_amdgcn_sched_barrier(0);
    }
#undef RDA
#undef RDB
    asm volatile("s_waitcnt vmcnt(0)" ::: "memory");
    __syncthreads();
  }
#undef GSTAGE
}

DI void gemm_core(const bf16_t* __restrict__ A, int lda, const bf16_t* __restrict__ Bt, int ldb, int K, f32x4 (&acc)[8][4], char* lds) {
  const int tid = real_tid(), lane = tid & 63, wid = tid >> 6, wr = wid >> 2, wc = wid & 3, fr = lane & 15, fq = lane >> 4;
  const int sl = lane ^ ((lane >> 5) << 1);
  const int R0 = (wid >> 1) * 16 + (sl >> 2), C0 = (wid & 1) * 32 + (sl & 3) * 8;
  const bf16_t* gA = A + (size_t)R0 * lda + C0;
  const bf16_t* gB = Bt + (size_t)R0 * ldb + C0;
  const size_t sA = (size_t)64 * lda, sB = (size_t)64 * ldb;
  const unsigned rd_off = (unsigned)((fr * 64 + fq * 16) ^ ((fr >> 3) << 5));
  unsigned st0 = (unsigned)tid * 16u, st1 = st0 + 65536u;
  unsigned ra0 = (unsigned)(wr * 8192) + rd_off, ra1 = ra0 + 65536u;
  unsigned rb0 = 32768u + (unsigned)(wc * 4096) + rd_off, rb1 = rb0 + 65536u;
  asm volatile("" : "+v"(st0), "+v"(st1), "+v"(ra0), "+v"(ra1), "+v"(rb0), "+v"(rb1));
  const int nt = K >> 6;
  bf16x8 At[4][2], B0[2][2], B1[2][2];
#define STG_A(b_, h_, kt_) { const bf16_t* g_ = gA + (size_t)((h_) * 128) * lda + (size_t)(kt_) * 64; char* d_ = lds + (((b_) ? st1 : st0) + (h_) * 16384); \
    __builtin_amdgcn_global_load_lds((const unsigned*)g_, (unsigned*)d_, 16, 0, 0); __builtin_amdgcn_global_load_lds((const unsigned*)(g_ + sA), (unsigned*)(d_ + 8192), 16, 0, 0); }
#define STG_B(b_, h_, kt_) { const bf16_t* g_ = gB + (size_t)((h_) * 128) * ldb + (size_t)(kt_) * 64; char* d_ = lds + (((b_) ? st1 : st0) + 32768 + (h_) * 16384); \
    __builtin_amdgcn_global_load_lds((const unsigned*)g_, (unsigned*)d_, 16, 0, 0); __builtin_amdgcn_global_load_lds((const unsigned*)(g_ + sB), (unsigned*)(d_ + 8192), 16, 0, 0); }
#define LDA(b_, h_) { const char* s_ = lds + (((b_) ? ra1 : ra0) + (h_) * 16384); \
    _Pragma("unroll") for (int m = 0; m < 4; ++m) _Pragma("unroll") for (int k = 0; k < 2; ++k) At[m][k] = *(const bf16x8*)(s_ + m * 2048 + k * 1024); }
#define LDB(dst_, b_, h_) { const char* s_ = lds + (((b_) ? rb1 : rb0) + (h_) * 16384); \
    _Pragma("unroll") for (int n = 0; n < 2; ++n) _Pragma("unroll") for (int k = 0; k < 2; ++k) dst_[n][k] = *(const bf16x8*)(s_ + n * 2048 + k * 1024); }
#define MMA(ai_, bj_, Bx_) { __builtin_amdgcn_s_setprio(1); \
    _Pragma("unroll") for (int m = 0; m < 4; ++m) _Pragma("unroll") for (int n = 0; n < 2; ++n) _Pragma("unroll") for (int k = 0; k < 2; ++k) \
      acc[(ai_) * 4 + m][(bj_) * 2 + n] = MFMA16(Bx_[n][k], At[m][k], acc[(ai_) * 4 + m][(bj_) * 2 + n]); \
    __builtin_amdgcn_s_setprio(0); }
#define WAIT_V(n_) asm volatile("s_waitcnt vmcnt(" #n_ ")" ::: "memory")
#define WAIT_L(n_) asm volatile("s_waitcnt lgkmcnt(" #n_ ")" ::: "memory")
#define BAR __builtin_amdgcn_s_barrier()
#define SCHED __builtin_amdgcn_sched_barrier(0)
  WAIT_V(0);
  STG_B(0, 0, 0); STG_A(0, 0, 0); STG_B(0, 1, 0); STG_A(0, 1, 0);
  if (wr == 1) BAR;
  WAIT_V(4); BAR;
  STG_B(1, 0, 1); STG_A(1, 0, 1); STG_B(1, 1, 1);
  WAIT_V(6); BAR;
#pragma unroll 1
  for (int t = 0; t < nt - 2; t += 2) {
    LDB(B0, 0, 0); SCHED; LDA(0, 0); STG_A(1, 1, t + 1);
    WAIT_L(8); BAR; WAIT_L(0); MMA(0, 0, B0); BAR; SCHED;
    LDB(B1, 0, 1); STG_B(0, 0, t + 2);
    BAR; WAIT_L(0); MMA(0, 1, B1); BAR;
    LDA(0, 1); STG_A(0, 0, t + 2);
    BAR; WAIT_L(0); MMA(1, 0, B0); BAR; SCHED;
    STG_B(0, 1, t + 2);
    WAIT_V(6); BAR; MMA(1, 1, B1); BAR;
    LDB(B0, 1, 0); SCHED; LDA(1, 0); STG_A(0, 1, t + 2);
    WAIT_L(8); BAR; WAIT_L(0); MMA(0, 0, B0); BAR; SCHED;
    LDB(B1, 1, 1); STG_B(1, 0, t + 3);
    BAR; WAIT_L(0); MMA(0, 1, B1); BAR;
    LDA(1, 1); STG_A(1, 0, t + 3);
    BAR; WAIT_L(0); MMA(1, 0, B0); BAR; SCHED;
    STG_B(1, 1, t + 3);
    WAIT_V(6); BAR; MMA(1, 1, B1); BAR;
  }
  { LDB(B0, 0, 0); LDA(0, 0); STG_A(1, 1, nt - 1);
    BAR; WAIT_L(0); MMA(0, 0, B0); BAR;
    LDB(B1, 0, 1); BAR; WAIT_L(0); MMA(0, 1, B1); BAR;
    LDA(0, 1); WAIT_V(4); BAR; WAIT_L(0); MMA(1, 0, B0); MMA(1, 1, B1); BAR; }
  { LDB(B0, 1, 0); LDA(1, 0); WAIT_V(2); BAR; WAIT_L(0); MMA(0, 0, B0); BAR;
    LDB(B1, 1, 1); WAIT_V(0); BAR; WAIT_L(0); MMA(0, 1, B1); BAR;
    LDA(1, 1); BAR; WAIT_L(0); MMA(1, 0, B0); MMA(1, 1, B1); BAR; }
  if (wr == 0) BAR;
#undef STG_A
#undef STG_B
#undef LDA
#undef LDB
#undef MMA
#undef WAIT_V
#undef WAIT_L
#undef BAR
#undef SCHED
}

DI void tile_decode(int t, int& mt, int& nt) {
  const int xcd = t & 7, local = t >> 3;
  mt = 8 * xcd + (local & 7); nt = local >> 3;
}
template <int MH> DI void zero_acc(f32x4 (&acc)[MH][4]) {
#pragma unroll
  for (int m = 0; m < MH; ++m)
#pragma unroll
    for (int n = 0; n < 4; ++n) acc[m][n] = (f32x4){0.f, 0.f, 0.f, 0.f};
}
#define GEMM_IDS const int tid = real_tid(), lane = tid & 63, wid = tid >> 6, wr = wid >> 2, wc = wid & 3, fr = lane & 15, fq = lane >> 4
#define GEMM_IDS_AGAIN const int tid = real_tid(), lane = tid & 63, wid = tid >> 6, wr = wid >> 2, wc = wid & 3, fr = lane & 15, fq = lane >> 4; (void)lane; (void)wr; (void)wc
#define EROW(m) ((size_t)mt * 256 + ((m) >> 2) * 128 + wr * 64 + ((m) & 3) * 16 + fr)
#define ECOL8(bj) (nt * 256 + (bj) * 128 + wc * 32 + fq * 8)

template <int MH> DI void up_epilogue(const Params& p, const f32x4 (&acc)[MH][4], int mt, int half, int nt, int wr, int wc, int fr, int fq) {
#pragma unroll
  for (int m = 0; m < MH; ++m) {
    const size_t row = (size_t)mt * 256 + (MH == 8 ? (m >> 2) : half) * 128 + wr * 64 + (m & 3) * 16 + fr;
    const int hc = nt * 128 + wc * 32 + fq * 8;
    float o[8];
#pragma unroll
    for (int n = 0; n < 2; ++n)
#pragma unroll
      for (int j = 0; j < 4; ++j) { const float g = acc[m][n][j], u = acc[m][n + 2][j]; o[4 * n + j] = siluf_(g) * u; }
    *(u32x4*)(WSB(p, hidden) + row * DFF + hc) = pack8(o);
  }
}
DI void tail_decode(int bid, int nfull, int& mt, int& nt, int& half) { tile_decode(nfull + ((bid >> 4) << 3) + (bid & 7), mt, nt); half = (bid >> 3) & 1; }

DI void gemm_up_phase(const Params& p, const bf16_t* Bt, char* lds) {
  GEMM_IDS; (void)lane;
  constexpr int NT = 22, NFULL = (64 * NT / 256) * 256;
  for (int t = real_bid(); t < 64 * NT; t += gridDim.x) {
    int mt, nt; tile_decode(t, mt, nt);
    f32x4 acc[8][4]; zero_acc(acc);
    gemm_core(WSB(p, h) + (size_t)mt * 256 * DM, DM, Bt + (size_t)nt * 256 * DM, DM, DM, acc, lds);
    GEMM_IDS_AGAIN;
    up_epilogue<8>(p, acc, mt, 0, nt, wr, wc, fr, fq);
  }
}

DI void gemm_res_phase(const Params& p, const float* xin, const bf16_t* A, int K, const bf16_t* Bt, const float* gate, float coef, char* lds) {
  GEMM_IDS; (void)lane;
  constexpr int NT = 4;
  for (int t = real_bid(); t < 64 * NT; t += gridDim.x) {
    int mt, nt; tile_decode(t, mt, nt);
    f32x4 acc[8][4]; zero_acc(acc);
    gemm_core(A + (size_t)mt * 256 * K, K, Bt + (size_t)nt * 256 * K, K, K, acc, lds);
    GEMM_IDS_AGAIN;
    const int b = mt >> 3;
#pragma unroll
    for (int bj = 0; bj < 2; ++bj) {
      const int col = ECOL8(bj);
      const f32x4 g0 = *(const f32x4*)(gate + (size_t)b * 9216 + col), g1 = *(const f32x4*)(gate + (size_t)b * 9216 + col + 4);
#pragma unroll
      for (int m = 0; m < 8; ++m) {
        const size_t xo = EROW(m) * DM + col;
        f32x4 x0 = *(const f32x4*)(xin + xo), x1 = *(const f32x4*)(xin + xo + 4);
        x0 = x0 + (g0 * acc[m][2 * bj]) * coef; x1 = x1 + (g1 * acc[m][2 * bj + 1]) * coef;
        *(f32x4*)(p.out + xo) = x0; *(f32x4*)(p.out + xo + 4) = x1;
        if (m & 1) __builtin_amdgcn_sched_barrier(0);
      }
    }
  }
}

template <int MH> DI void in_epilogue(const Params& p, const f32x4 (&acc)[MH][4], int mt, int half, int nt, int wr, int wc, int fr, int fq) {
#define IN_ROW(m) ((size_t)mt * 256 + (MH == 8 ? ((m) >> 2) : half) * 128 + wr * 64 + ((m) & 3) * 16 + fr)
#define IN_PK(m, bj) ((u32x4){pk2(acc[m][2 * (bj)][0], acc[m][2 * (bj)][1]), pk2(acc[m][2 * (bj)][2], acc[m][2 * (bj)][3]), pk2(acc[m][2 * (bj) + 1][0], acc[m][2 * (bj) + 1][1]), pk2(acc[m][2 * (bj) + 1][2], acc[m][2 * (bj) + 1][3])})
  if (nt < 9) {
#pragma unroll
    for (int bj = 0; bj < 2; ++bj) {
      const int col = ECOL8(bj), sq = col / 768, rem = col - sq * 768, g = rem >> 8, hh = (rem >> 6) & 3, dd = rem & 63;
      const int sh = (g == 0) ? 0 : (g == 1 ? 2 : 4);
#pragma unroll
      for (int m = 0; m < MH; ++m) {
        const size_t row = IN_ROW(m);
        const int b = (int)(row >> 11), t = (int)(row & 2047);
        const int ridx = ((t & ((1 << sh) - 1)) << (11 - sh)) + (t >> sh);
        *(u32x4*)(WSB(p, zatt) + ((size_t)((((b * 3 + sq) * 3 + g) * 4 + hh) * 2048 + ridx)) * 64 + dd) = IN_PK(m, bj);
      }
    }
  } else if (nt < 21) {
#pragma unroll
    for (int bj = 0; bj < 2; ++bj) {
      const int c = ECOL8(bj) - 2304, seg = c >> 10, hd = (c >> 7) & 7, cc = c & 127;
#pragma unroll
      for (int m = 0; m < MH; ++m) {
        const size_t row = IN_ROW(m);
        const int b = (int)(row >> 11), t = (int)(row & 2047);
        *(u32x4*)(WSB(p, zdn) + ((size_t)(((b * 8 + hd) * 3 + seg) * 2048 + t)) * 128 + cc) = IN_PK(m, bj);
      }
    }
  } else if (nt < 33) {
#pragma unroll
    for (int m = 0; m < MH; ++m) {
      const size_t row = IN_ROW(m);
#pragma unroll
      for (int bj = 0; bj < 2; ++bj) *(u32x4*)(WSB(p, z) + row * ZLD + (ECOL8(bj) - 5376)) = IN_PK(m, bj);
    }
  } else if (wc == 0 && fq < 2) {
#pragma unroll
    for (int m = 0; m < MH; ++m) {
      float* ap = WSF(p, ab) + IN_ROW(m) * 16 + fq * 8;
      *(f32x4*)ap = acc[m][0]; *(f32x4*)(ap + 4) = acc[m][1];
    }
  }
#undef IN_ROW
#undef IN_PK
}
DI void gemm_in_phase(const Params& p, const bf16_t* Win, char* lds) {
  GEMM_IDS; (void)lane;
  constexpr int NT = 34, NFULL = (64 * NT / 256) * 256;
  for (int t = real_bid(); t < 64 * NT; t += gridDim.x) {
    int mt, nt; tile_decode(t, mt, nt);
    f32x4 acc[8][4]; zero_acc(acc);
    gemm_core(WSB(p, h) + (size_t)mt * 256 * DM, DM, Win + (size_t)nt * 256 * DM, DM, DM, acc, lds);
    GEMM_IDS_AGAIN;
    in_epilogue<8>(p, acc, mt, 0, nt, wr, wc, fr, fq);
  }
}

DI void gemm_proj_phase(const Params& p, const bf16_t* Wpa, const bf16_t* Wpd, char* lds) {
  GEMM_IDS; (void)lane;
  constexpr int NT = 4;
  for (int t = real_bid(); t < 64 * NT; t += gridDim.x) {
    int mt, nt; tile_decode(t, mt, nt);
    f32x4 acc[8][4]; zero_acc(acc);
    gemm_core(WSB(p, yatt) + (size_t)mt * 256 * 256, 256, Wpa + (size_t)nt * 256 * 256, 256, 256, acc, lds);
    GEMM_IDS_AGAIN;
#pragma unroll
    for (int m = 0; m < 8; ++m) {
      const size_t row = EROW(m);
#pragma unroll
      for (int bj = 0; bj < 2; ++bj) {
        const int col = ECOL8(bj);
        const u32x4 gz = *(const u32x4*)(WSB(p, z) + row * ZLD + Z_MERGE + col);
        float gt[8], o[8]; unpack8(gz, gt);
#pragma unroll
        for (int e = 0; e < 8; ++e) o[e] = sigmoidf_(gt[e]) * acc[m][2 * bj + (e >> 2)][e & 3];
        *(u32x4*)(WSB(p, mrg) + row * DM + col) = pack8(o);
      }
      __builtin_amdgcn_sched_barrier(0);
    }
  }
  for (int t = real_bid(); t < 64 * NT; t += gridDim.x) {
    int mt, nt; tile_decode(t, mt, nt);
    f32x4 acc[8][4]; zero_acc(acc);
    gemm_core(WSB(p, odn) + (size_t)mt * 256 * DM, DM, Wpd + (size_t)nt * 256 * DM, DM, DM, acc, lds);
    GEMM_IDS_AGAIN;
#pragma unroll
    for (int m = 0; m < 8; ++m) {
      const size_t row = EROW(m);
#pragma unroll
      for (int bj = 0; bj < 2; ++bj) {
        const int col = ECOL8(bj);
        const u32x4 gz = *(const u32x4*)(WSB(p, z) + row * ZLD + Z_MERGE + DM + col);
        const u32x4 pv = *(const u32x4*)(WSB(p, mrg) + row * DM + col);
        float gt[8], pr[8], o[8]; unpack8(gz, gt); unpack8(pv, pr);
#pragma unroll
        for (int e = 0; e < 8; ++e) o[e] = pr[e] + sigmoidf_(gt[e]) * acc[m][2 * bj + (e >> 2)][e & 3];
        *(u32x4*)(WSB(p, mrg) + row * DM + col) = pack8(o);
      }
      __builtin_amdgcn_sched_barrier(0);
    }
  }
}

DI void convert_matrix(const float* __restrict__ src, int ldsrc, bf16_t* __restrict__ dst, int K, int ncoltiles, int kind, char* lds, int start, int stride) {
  float* tl = (float*)lds;
  const int tid = opaque_tid();
  const int nkt = K >> 6;
  const int nitems = ncoltiles * nkt;
  for (int it = start; it < nitems; it += stride) {
    const int ct = it / nkt, kt = it - ct * nkt;
    int srccol0 = ct * 64, nvalid = 64;
    if (kind == 1) { const int T = ct >> 2, q = ct & 3; srccol0 = (q >> 1) * DFF + T * 128 + (q & 1) * 64; }
    else if (kind == 2) {
      if (ct < 100) srccol0 = ct * 64;
      else if (ct < 132) srccol0 = 6416 + (ct - 100) * 64;
      else if (ct == 132) { srccol0 = 6400; nvalid = 16; }
      else { srccol0 = 0; nvalid = 0; }
    }
    const int r = tid >> 4, c4 = (tid & 15) * 4;
#pragma unroll
    for (int ps = 0; ps < 4; ++ps) {
      const int kk = r + 16 * ps;
      f32x4 v = (f32x4){0.f, 0.f, 0.f, 0.f};
      if (c4 < nvalid) v = *(const f32x4*)(src + (size_t)(kt * 64 + kk) * ldsrc + srccol0 + c4);
      tl[kk * 65 + c4 + 0] = v[0]; tl[kk * 65 + c4 + 1] = v[1]; tl[kk * 65 + c4 + 2] = v[2]; tl[kk * 65 + c4 + 3] = v[3];
    }
    __syncthreads();
#pragma unroll
    for (int ps = 0; ps < 2; ++ps) {
      const int n = (tid >> 3) + 32 * ps, k8 = (tid & 7) * 8;
      float v[8];
      const int nl = (n & 32) + 8 * ((n & 15) >> 2) + 4 * ((n >> 4) & 1) + (n & 3);
#pragma unroll
      for (int e = 0; e < 8; ++e) v[e] = tl[(k8 + e) * 65 + nl];
      *(u32x4*)(dst + (size_t)(ct * 64 + n) * K + kt * 64 + k8) = pack8(v);
    }
    __syncthreads();
  }
}

DI void convert_layer(const Params& p, int l, char* lds, int start, int stride) {
  convert_matrix(p.w_up1 + (size_t)l * DM * 2 * DFF, 2 * DFF, WSW(p, W_up1, l), DM, 88, 1, lds, start, stride);
  convert_matrix(p.w_down1 + (size_t)l * DFF * DM, DM, WSW(p, W_down1, l), DFF, 16, 0, lds, start, stride);
  convert_matrix(p.w_in + (size_t)l * DM * 8464, 8464, WSW(p, W_in, l), DM, 136, 2, lds, start, stride);
  convert_matrix(p.w_pa + (size_t)l * 256 * DM, DM, WSW(p, W_pa, l), 256, 16, 0, lds, start, stride);
  convert_matrix(p.w_pd + (size_t)l * DM * DM, DM, WSW(p, W_pd, l), DM, 16, 0, lds, start, stride);
  convert_matrix(p.w_out + (size_t)l * DM * DM, DM, WSW(p, W_out, l), DM, 16, 0, lds, start, stride);
  convert_matrix(p.w_up2 + (size_t)l * DM * 2 * DFF, 2 * DFF, WSW(p, W_up2, l), DM, 88, 1, lds, start, stride);
  convert_matrix(p.w_down2 + (size_t)l * DFF * DM, DM, WSW(p, W_down2, l), DFF, 16, 0, lds, start, stride);
}

DI void norm_phase(const Params& p, const float* xin, const float* g, const float* shift, const float* scale  ) {
  const int tid = opaque_tid(), lane = tid & 63, wid = tid >> 6;
  const int nw = VGRID * 4;
  for (int row = opaque_bid() * 4 + wid; row < MTOK; row += nw) {
    const int b = row >> 11;
    const float* xp = xin + (size_t)row * DM;
    f32x4 v[4]; float ss = 0.f;
#pragma unroll
    for (int i = 0; i < 4; ++i) { v[i] = *(const f32x4*)(xp + i * 256 + lane * 4); ss += v[i][0] * v[i][0] + v[i][1] * v[i][1] + v[i][2] * v[i][2] + v[i][3] * v[i][3]; }
#pragma unroll
    for (int o = 1; o < 64; o <<= 1) ss += shx(ss, o, lane);
    const float rstd = rsqrtf(ss * (1.f / DM) + EPS);
#pragma unroll
    for (int i = 0; i < 4; ++i) {
      const int col = i * 256 + lane * 4;
      const f32x4 gv = *(const f32x4*)(g + col), sc = *(const f32x4*)(scale + (size_t)b * 9216 + col), sh = *(const f32x4*)(shift + (size_t)b * 9216 + col);
      float o[4];
#pragma unroll
      for (int j = 0; j < 4; ++j) o[j] = v[i][j] * rstd * gv[j] * (1.f + sc[j]) + sh[j];
      u32x2 w; w[0] = pk2(o[0], o[1]); w[1] = pk2(o[2], o[3]);
      *(u32x2*)(WSB(p, h) + (size_t)row * DM + col) = w;
    }
  }
}

DI void phase0(const Params& p, char* lds) {
  float* cact = (float*)lds;
  float* red = (float*)(lds + 32768);
  const int tid = opaque_tid(), lane = tid & 63, wid = tid >> 6;
  for (int i = tid; i < NB * DM; i += 256) cact[i] = siluf_(p.c[i]);
  __syncthreads();
  for (int it = opaque_bid(); it < 576; it += VGRID) {
    const int l = it / 144, cb = it - l * 144;
    float acc[8];
#pragma unroll
    for (int b = 0; b < 8; ++b) acc[b] = 0.f;
    const float* wp = p.ada_w + (size_t)l * DM * 9216 + cb * 64 + lane;
    const int kbeg = wid * 256;
#pragma unroll 1
    for (int k = kbeg; k < kbeg + 256; k += 8) {
      float wv[8];
#pragma unroll
      for (int u = 0; u < 8; ++u) wv[u] = wp[(size_t)(k + u) * 9216];
#pragma unroll
      for (int b = 0; b < 8; ++b) {
        const f32x4 c0 = *(const f32x4*)(cact + b * DM + k), c1 = *(const f32x4*)(cact + b * DM + k + 4);
        acc[b] += c0[0] * wv[0] + c0[1] * wv[1] + c0[2] * wv[2] + c0[3] * wv[3] + c1[0] * wv[4] + c1[1] * wv[5] + c1[2] * wv[6] + c1[3] * wv[7];
      }
    }
#pragma unroll
    for (int b = 0; b < 8; ++b) red[(wid * 8 + b) * 64 + lane] = acc[b];
    __syncthreads();
#pragma unroll
    for (int h2 = 0; h2 < 2; ++h2) {
      const int b = (tid >> 6) + 4 * h2, c = tid & 63;
      const float sum = red[(0 * 8 + b) * 64 + c] + red[(1 * 8 + b) * 64 + c] + red[(2 * 8 + b) * 64 + c] + red[(3 * 8 + b) * 64 + c];
      WSF(p, mod)[((size_t)l * 8 + b) * 9216 + cb * 64 + c] = sum + p.ada_b[(size_t)l * 9216 + cb * 64 + c];
    }
    __syncthreads();
  }
}

DI void attn_item(const Params& p, int l, int item, char* lds) {
  const int tid = opaque_tid(), lane = tid & 63, w = tid >> 6, r = lane & 31, hf = lane >> 5;
  const int blk16 = item & 15, hh = (item >> 4) & 3, rest = item >> 6, g = rest % 3, b = rest / 3;
  const int d = (g == 0) ? 1 : (g == 1 ? 4 : 16);
  const int nbk = 16 / d, res = blk16 / nbk, nb = blk16 - res * nbk;
  const int qcol = g * 256 + hh * 64;
  const int Lsub = 2048 / d;
  const bf16_t* zq = WSB(p, zatt) + ((size_t)((((b * 3 + 0) * 3 + g) * 4 + hh) * 2048 + res * Lsub)) * 64;
  const bf16_t* zk = WSB(p, zatt) + ((size_t)((((b * 3 + 1) * 3 + g) * 4 + hh) * 2048 + res * Lsub)) * 64;
  const bf16_t* zv = WSB(p, zatt) + ((size_t)((((b * 3 + 2) * 3 + g) * 4 + hh) * 2048 + res * Lsub)) * 64;
  bf16_t* VT = (bf16_t*)lds;
  float* nrm = (float*)(lds + 64 * 528);
  if (tid < 128) nrm[tid] = (tid < 64) ? p.q_norm[l * 64 + tid] : p.k_norm[l * 64 + tid - 64];
  const int qi = 32 * w + r;
  const int tq = (128 * nb + qi) * d + res;
  u32x4 vraw[8], qraw[4], kraw[5][4];
  {
    const int lk = 128 * (nb - 1) + tid, lkc = lk < 0 ? 0 : lk;
    const u32x4* src = (const u32x4*)(zv + (size_t)lkc * 64);
#pragma unroll
    for (int i = 0; i < 8; ++i) vraw[i] = src[i];
    const bf16_t* qp = zq + (size_t)(128 * nb + qi) * 64 + 8 * hf;
#pragma unroll
    for (int s = 0; s < 4; ++s) qraw[s] = *(const u32x4*)(qp + 16 * s);
#pragma unroll
    for (int i = 0; i < 2; ++i) {
      const int lkk = 128 * (nb - 1) + 32 * (w + i) + r, lkkc = lkk < 0 ? 0 : lkk;
      const bf16_t* kp = zk + (size_t)lkkc * 64 + 8 * hf;
#pragma unroll
      for (int s = 0; s < 4; ++s) kraw[i][s] = *(const u32x4*)(kp + 16 * s);
    }
  }
  __builtin_amdgcn_sched_barrier(0);
  {
    const int key = tid;
#pragma unroll
    for (int i = 0; i < 8; ++i)
#pragma unroll
      for (int e = 0; e < 4; ++e) {
        VT[(8 * i + 2 * e) * 264 + key] = (bf16_t)(vraw[i][e] & 0xffffu);
        VT[(8 * i + 2 * e + 1) * 264 + key] = (bf16_t)(vraw[i][e] >> 16);
      }
  }
  __syncthreads();
  bf16x8 qf[4];
  {
    float qv[4][8]; float ss = 0.f;
#pragma unroll
    for (int s = 0; s < 4; ++s) {
      unpack8(qraw[s], qv[s]);
#pragma unroll
      for (int j = 0; j < 8; ++j) ss += qv[s][j] * qv[s][j];
    }
    ss += shx(ss, 32, lane);
    const float rstd = rsqrtf(ss * (1.f / 64.f) + EPS) * 0.125f;
#pragma unroll
    for (int s = 0; s < 4; ++s) {
      const float* gn = nrm + 16 * s + 8 * hf;
      float o[8];
#pragma unroll
      for (int j = 0; j < 8; ++j) o[j] = qv[s][j] * rstd * gn[j];
      qf[s] = __builtin_bit_cast(bf16x8, pack8(o));
    }
  }
  f32x16 st[5];
#pragma unroll
  for (int i = 0; i < 5; ++i) {
    if (i + 2 < 5 && (nb > 0 || w + i + 2 >= 4)) {
      const int lkk = 128 * (nb - 1) + 32 * (w + i + 2) + r, lkkc = lkk < 0 ? 0 : lkk;
      const bf16_t* kp = zk + (size_t)lkkc * 64 + 8 * hf;
#pragma unroll
      for (int s = 0; s < 4; ++s) kraw[i + 2][s] = *(const u32x4*)(kp + 16 * s);
    }
    __builtin_amdgcn_sched_barrier(0);
#pragma unroll
    for (int e = 0; e < 16; ++e) st[i][e] = 0.f;
    if (nb > 0 || w + i >= 4) {
      float kv[4][8]; float ss = 0.f;
#pragma unroll
      for (int s = 0; s < 4; ++s) {
        unpack8(kraw[i][s], kv[s]);
#pragma unroll
        for (int j = 0; j < 8; ++j) ss += kv[s][j] * kv[s][j];
      }
      ss += shx(ss, 32, lane);
      const float rstd = rsqrtf(ss * (1.f / 64.f) + EPS);
#pragma unroll
      for (int s = 0; s < 4; ++s) {
        const float* gn = nrm + 64 + 16 * s + 8 * hf;
        float o[8];
#pragma unroll
        for (int j = 0; j < 8; ++j) o[j] = kv[s][j] * rstd * gn[j];
        const bf16x8 kf = __builtin_bit_cast(bf16x8, pack8(o));
        st[i] = MFMA32(kf, qf[s], st[i]);
      }
    }
  }
  float mx = -3.0e38f;
#pragma unroll
  for (int i = 0; i < 5; ++i)
#pragma unroll
    for (int e = 0; e < 16; ++e) {
      const int c = (e & 3) + 8 * (e >> 2) + 4 * hf;
      const bool valid = (nb > 0 || w + i >= 4) && (i == 0 ? c >= r : (i == 4 ? c <= r : true));
      st[i][e] = valid ? st[i][e] : -3.0e38f;
      mx = fmaxf(mx, st[i][e]);
    }
  mx = fmaxf(mx, shx(mx, 32, lane));
  float den = 0.f;
#pragma unroll
  for (int i = 0; i < 5; ++i)
#pragma unroll
    for (int e = 0; e < 16; ++e) {
      const float pe = (st[i][e] > -1.0e38f) ? __expf(st[i][e] - mx) : 0.f;
      st[i][e] = pe; den += pe;
    }
  den += shx(den, 32, lane);
  f32x16 ot[2];
#pragma unroll
  for (int dt = 0; dt < 2; ++dt)
#pragma unroll
    for (int e = 0; e < 16; ++e) ot[dt][e] = 0.f;
#pragma unroll
  for (int i = 0; i < 5; ++i)
#pragma unroll
    for (int s2 = 0; s2 < 2; ++s2) if (nb > 0 || w + i >= 4) {
      u32x4 pp;
      pp[0] = pk2(st[i][8 * s2 + 0], st[i][8 * s2 + 1]); pp[1] = pk2(st[i][8 * s2 + 2], st[i][8 * s2 + 3]);
      pp[2] = pk2(st[i][8 * s2 + 4], st[i][8 * s2 + 5]); pp[3] = pk2(st[i][8 * s2 + 6], st[i][8 * s2 + 7]);
      const bf16x8 pf = __builtin_bit_cast(bf16x8, pp);
#pragma unroll
      for (int dt = 0; dt < 2; ++dt) {
        const bf16_t* vp = VT + (32 * dt + r) * 264 + 32 * (w + i) + 16 * s2 + 4 * hf;
        const u32x2 lo = *(const u32x2*)vp, hi = *(const u32x2*)(vp + 8);
        u32x4 vv; vv[0] = lo[0]; vv[1] = lo[1]; vv[2] = hi[0]; vv[3] = hi[1];
        ot[dt] = MFMA32(__builtin_bit_cast(bf16x8, vv), pf, ot[dt]);
      }
    }
  const float inv = 1.f / den;
  const size_t tok = (size_t)b * SEQ + tq;
#pragma unroll
  for (int dt = 0; dt < 2; ++dt)
#pragma unroll
    for (int r4 = 0; r4 < 4; ++r4) {
      u32x2 wv; wv[0] = pk2(ot[dt][4 * r4 + 0] * inv, ot[dt][4 * r4 + 1] * inv); wv[1] = pk2(ot[dt][4 * r4 + 2] * inv, ot[dt][4 * r4 + 3] * inv);
      *(u32x2*)(WSB(p, og) + tok * 768 + qcol + 32 * dt + 8 * r4 + 4 * hf) = wv;
    }
  if (hf == 0) WSF(p, lse)[tok * 12 + g * 4 + hh] = mx + __logf(den);
  __syncthreads();
}

DI int lnd(int v) { asm volatile("" : "+s"(v)); return v; }
DI void dn_f1_item(const Params& p, int l, int chunk, char* lds) {
  const int tid = opaque_tid(), lane = tid & 63, w = tid >> 6, fr = lane & 15, fq = lane >> 4;
  const int n = chunk & 31, bh = chunk >> 5, h = bh & 7, b = bh >> 3;
  const int t0 = n * 64;
  const size_t rowbase = (size_t)b * SEQ;
  bf16_t* Qn = (bf16_t*)lds;
  bf16_t* Kn = (bf16_t*)(lds + 17408);
  bf16_t* KB = (bf16_t*)(lds + 2 * 17408);
  bf16_t* Vs = (bf16_t*)(lds + 3 * 17408);
  float* gcs = (float*)(lds + 4 * 17408);
  float* betas = gcs + 64;
  float* egc = gcs + 128;
  float* Am = (float*)lds;
  if (w == 0) {
    const size_t row = rowbase + t0 + lane;
    const float a = WSF(p, ab)[row * 16 + h], bb = WSF(p, ab)[row * 16 + 8 + h];
    const float xx = a + p.dt_bias[l * 8 + h];
    const float sp = xx > 20.f ? xx : log1pf(__expf(xx));
    float s = -__expf(p.a_log[l * 8 + h]) * sp;
#pragma unroll
    for (int off = 1; off < 64; off <<= 1) { const float t = shup(s, off, lane); if (lane >= off) s += t; }
    gcs[lane] = s; betas[lane] = sigmoidf_(bb); egc[lane] = __expf(s);
    if (lane == 63) WSF(p, dGL)[chunk] = __expf(s);
  }
  __syncthreads();
  const float gclast = gcs[63];
  const int cg8 = (tid & 15) * 8, rg = tid >> 4;
#pragma unroll 1
  for (int seg = 0; seg < 3; ++seg) {
    u32x4 rows[7];
#pragma unroll
    for (int r = 0; r < 7; ++r) {
      const int tt = t0 + 4 * rg - 3 + r;
      rows[r] = (u32x4){0u, 0u, 0u, 0u};
      if (tt >= 0) rows[r] = *(const u32x4*)(WSB(p, zdn) + ((size_t)(((b * 8 + h) * 3 + seg) * 2048 + tt)) * 128 + cg8);
    }
    float cw[4][8];
#pragma unroll
    for (int tap = 0; tap < 4; ++tap) {
      const float* cp = p.conv_w + ((size_t)l * 4 + tap) * 3072 + seg * 1024 + h * 128 + cg8;
      const f32x4 c0 = *(const f32x4*)cp, c1 = *(const f32x4*)(cp + 4);
      cw[tap][0] = c0[0]; cw[tap][1] = c0[1]; cw[tap][2] = c0[2]; cw[tap][3] = c0[3];
      cw[tap][4] = c1[0]; cw[tap][5] = c1[1]; cw[tap][6] = c1[2]; cw[tap][7] = c1[3];
    }
#pragma unroll
    for (int jt = 0; jt < 4; ++jt) {
      const int i = 4 * rg + jt;
      float val[8];
#pragma unroll
      for (int e = 0; e < 8; ++e) val[e] = 0.f;
#pragma unroll
      for (int tap = 0; tap < 4; ++tap) {
        float xv[8]; unpack8(rows[jt + tap], xv);
#pragma unroll
        for (int e = 0; e < 8; ++e) val[e] += cw[tap][e] * xv[e];
      }
      float ss = 0.f;
#pragma unroll
      for (int e = 0; e < 8; ++e) { val[e] = siluf_(val[e]); ss += val[e] * val[e]; }
      ss += shx(ss, 1, lane); ss += shx(ss, 2, lane); ss += shx(ss, 4, lane); ss += shx(ss, 8, lane);
      const float rn = rsqrtf(ss + EPS);
      if (seg == 0) {
        const float eg = egc[i];
        float qv[8], qd[8];
#pragma unroll
        for (int e = 0; e < 8; ++e) { qv[e] = val[e] * rn * 0.08838834764831845f; qd[e] = qv[e] * eg; }
        *(u32x4*)(Qn + i * 136 + cg8) = pack8(qv);
        *(u32x4*)(WSB(p, dQD) + ((size_t)lnd(chunk) * 64 + i) * 128 + cg8) = pack8(qd);
      } else if (seg == 1) {
        const float bt = betas[i];
        float kv[8], kb[8];
#pragma unroll
        for (int e = 0; e < 8; ++e) { kv[e] = val[e] * rn; kb[e] = kv[e] * bt; }
        *(u32x4*)(Kn + i * 136 + cg8) = pack8(kv);
        *(u32x4*)(KB + i * 136 + cg8) = pack8(kb);
      } else {
        *(u32x4*)(Vs + i * 136 + cg8) = pack8(val);
      }
    }
  }
  __syncthreads();
  {
    const int dcol = tid >> 1, half = tid & 1;
    u32x4 o4[4];
#pragma unroll
    for (int q = 0; q < 4; ++q)
#pragma unroll
      for (int e = 0; e < 4; ++e) {
        const int i0 = 32 * half + 8 * q + 2 * e;
        const float k0 = bf2f(Kn[i0 * 136 + dcol]) * __expf(gclast - gcs[i0]);
        const float k1 = bf2f(Kn[(i0 + 1) * 136 + dcol]) * __expf(gclast - gcs[i0 + 1]);
        o4[q][e] = pk2(k0, k1);
      }
    u32x4* dst = (u32x4*)(WSB(p, dKDT) + ((size_t)lnd(chunk) * 128 + dcol) * 64 + 32 * half);
#pragma unroll
    for (int q = 0; q < 4; ++q) dst[q] = o4[q];
  }
  f32x4 kk[4], qk[4];
#pragma unroll
  for (int nn = 0; nn < 4; ++nn) { kk[nn] = (f32x4){0.f, 0.f, 0.f, 0.f}; qk[nn] = (f32x4){0.f, 0.f, 0.f, 0.f}; }
#pragma unroll
  for (int s = 0; s < 4; ++s) {
    const bf16x8 akb = *(const bf16x8*)(KB + (16 * w + fr) * 136 + 32 * s + 8 * fq);
    const bf16x8 aq = *(const bf16x8*)(Qn + (16 * w + fr) * 136 + 32 * s + 8 * fq);
#pragma unroll
    for (int nn = 0; nn < 4; ++nn) {
      const bf16x8 bk = *(const bf16x8*)(Kn + (16 * nn + fr) * 136 + 32 * s + 8 * fq);
      kk[nn] = MFMA16(akb, bk, kk[nn]);
      qk[nn] = MFMA16(aq, bk, qk[nn]);
    }
  }
  __syncthreads();
#pragma unroll
  for (int nn = 0; nn < 4; ++nn)
#pragma unroll
    for (int j = 0; j < 4; ++j) {
      const int i = 16 * w + 4 * fq + j, jj = 16 * nn + fr;
      const float dec = __expf(fminf(gcs[i] - gcs[jj], 0.f));
      Am[i * 64 + jj] = (jj < i) ? kk[nn][j] * dec : 0.f;
      Kn[i * 72 + jj] = f2bf((jj <= i) ? qk[nn][j] * dec : 0.f);
    }
  __syncthreads();
#pragma unroll
  for (int ps = 0; ps < 2; ++ps) {
    const int id = tid + 256 * ps, i = id >> 3, c8 = (id & 7) * 8;
    *(u32x4*)(WSB(p, dAI) + ((size_t)lnd(chunk) * 64 + i) * 64 + c8) = *(const u32x4*)(Kn + i * 72 + c8);
  }
  {
    const int c = tid & 127; const bool isW = tid >= 128;
    const bf16_t* rsrc = isW ? KB : Vs;
    const float* msrc = isW ? egc : betas;
    float x[64];
#pragma unroll
    for (int i = 0; i < 64; ++i) x[i] = 0.f;
#pragma unroll
    for (int i = 0; i < 64; ++i) {
      const float rhs = bf2f(rsrc[i * 136 + c]) * msrc[i];
      float s0 = 0.f, s1 = 0.f, s2 = 0.f, s3 = 0.f;
#pragma unroll
      for (int j4 = 0; j4 < (i + 3) / 4; ++j4) {
        const f32x4 a = *(const f32x4*)(Am + i * 64 + 4 * j4);
        s0 += a[0] * x[4 * j4]; s1 += a[1] * x[4 * j4 + 1]; s2 += a[2] * x[4 * j4 + 2]; s3 += a[3] * x[4 * j4 + 3];
      }
      x[i] = rhs - ((s0 + s1) + (s2 + s3));
    }
    if (!isW) {
      u32x4* dst = (u32x4*)(WSB(p, dUT) + ((size_t)lnd(chunk) * 128 + c) * 64);
#pragma unroll
      for (int q = 0; q < 8; ++q) {
        u32x4 o; o[0] = pk2(x[8 * q], x[8 * q + 1]); o[1] = pk2(x[8 * q + 2], x[8 * q + 3]); o[2] = pk2(x[8 * q + 4], x[8 * q + 5]); o[3] = pk2(x[8 * q + 6], x[8 * q + 7]);
        dst[q] = o;
      }
    }
    __syncthreads();
    if (isW) {
#pragma unroll
      for (int i = 0; i < 64; ++i) Kn[i * 136 + c] = f2bf(x[i]);
    }
  }
  __syncthreads();
#pragma unroll
  for (int ps = 0; ps < 4; ++ps) {
    const int id = tid + 256 * ps, i = id >> 4, c8 = (id & 15) * 8;
    *(u32x4*)(WSB(p, dW) + ((size_t)lnd(chunk) * 64 + i) * 128 + c8) = *(const u32x4*)(Kn + i * 136 + c8);
  }
  __syncthreads();
}

#define LDS_BARRIER() do { asm volatile("s_waitcnt lgkmcnt(0)" ::: "memory"); __builtin_amdgcn_s_barrier(); asm volatile("" ::: "memory"); } while (0)
DI void dn_f2_item(const Params& p, int item, char* lds) {
  const int tid = opaque_tid(), lane = tid & 63, w = tid >> 6, fr = lane & 15, fq = lane >> 4;
  const int vs = item & 3, bh = item >> 2, h = bh & 7, b = bh >> 3;
  bf16_t* ST = (bf16_t*)lds;
  bf16_t* VT = (bf16_t*)(lds + 32 * 272);
  bf16_t* OT = (bf16_t*)(lds + 32 * 272 + 32 * 144);
  for (int i = tid; i < 32 * 136; i += 256) ST[i] = 0;
  f32x4 accS[2][2];
#pragma unroll
  for (int nn = 0; nn < 2; ++nn)
#pragma unroll
    for (int m = 0; m < 2; ++m) accS[nn][m] = (f32x4){0.f, 0.f, 0.f, 0.f};
  __syncthreads();
  bf16x8 naw[4], naq[4], naa[2], nak[2][2]; u32x2 nuu[2]; float ngl;
#define F2_LOAD(n_)                                                                                                     \
  {                                                                                                                     \
    const size_t chunk_ = (size_t)bh * 32 + (n_);                                                                       \
    const bf16_t* Wc = WSB(p, dW) + chunk_ * 8192; const bf16_t* QDc = WSB(p, dQD) + chunk_ * 8192;                     \
    const bf16_t* AIc = WSB(p, dAI) + chunk_ * 4096; const bf16_t* KDTc = WSB(p, dKDT) + chunk_ * 8192;                 \
    const bf16_t* UTc = WSB(p, dUT) + chunk_ * 8192;                                                                    \
    _Pragma("unroll") for (int s = 0; s < 4; ++s) {                                                                     \
      naw[s] = *(const bf16x8*)(Wc + (16 * w + fr) * 128 + 32 * s + 8 * fq);                                            \
      naq[s] = *(const bf16x8*)(QDc + (16 * w + fr) * 128 + 32 * s + 8 * fq);                                           \
    }                                                                                                                   \
    _Pragma("unroll") for (int s = 0; s < 2; ++s) {                                                                     \
      naa[s] = *(const bf16x8*)(AIc + (16 * w + fr) * 64 + 32 * s + 8 * fq);                                            \
      _Pragma("unroll") for (int nn = 0; nn < 2; ++nn) nak[s][nn] = *(const bf16x8*)(KDTc + (32 * w + 16 * nn + fr) * 64 + 32 * s + 8 * fq); \
    }                                                                                                                   \
    _Pragma("unroll") for (int m = 0; m < 2; ++m) nuu[m] = *(const u32x2*)(UTc + (vs * 32 + 16 * m + fr) * 64 + 16 * w + 4 * fq); \
    ngl = WSF(p, dGL)[chunk_];                                                                                          \
  }
  F2_LOAD(0);
  for (int n = 0; n < 32; ++n) {
    bf16x8 aw[4], aq[4], aa[2], ak[2][2]; u32x2 uu[2];
#pragma unroll
    for (int s = 0; s < 4; ++s) { aw[s] = naw[s]; aq[s] = naq[s]; }
#pragma unroll
    for (int s = 0; s < 2; ++s) { aa[s] = naa[s]; ak[s][0] = nak[s][0]; ak[s][1] = nak[s][1]; uu[s] = nuu[s]; }
    const float gl = ngl;
    if (n + 1 < 32) F2_LOAD(n + 1);
    f32x4 ws[2], qs[2];
#pragma unroll
    for (int m = 0; m < 2; ++m) { ws[m] = (f32x4){0.f, 0.f, 0.f, 0.f}; qs[m] = (f32x4){0.f, 0.f, 0.f, 0.f}; }
#pragma unroll
    for (int s = 0; s < 4; ++s) {
#pragma unroll
      for (int m = 0; m < 2; ++m) {
        const bf16x8 bs = *(const bf16x8*)(ST + (16 * m + fr) * 136 + 32 * s + 8 * fq);
        ws[m] = MFMA16(aw[s], bs, ws[m]);
        qs[m] = MFMA16(aq[s], bs, qs[m]);
      }
    }
#pragma unroll
    for (int m = 0; m < 2; ++m) {
      const float v0 = bflo(uu[m][0]) - ws[m][0], v1 = bfhi(uu[m][0]) - ws[m][1], v2 = bflo(uu[m][1]) - ws[m][2], v3 = bfhi(uu[m][1]) - ws[m][3];
      u32x2 o; o[0] = pk2(v0, v1); o[1] = pk2(v2, v3);
      *(u32x2*)(VT + (16 * m + fr) * 72 + 16 * w + 4 * fq) = o;
    }
    LDS_BARRIER();
    bf16x8 bv[2][2];
#pragma unroll
    for (int s = 0; s < 2; ++s)
#pragma unroll
      for (int m = 0; m < 2; ++m) bv[s][m] = *(const bf16x8*)(VT + (16 * m + fr) * 72 + 32 * s + 8 * fq);
#pragma unroll
    for (int s = 0; s < 2; ++s)
#pragma unroll
      for (int m = 0; m < 2; ++m) qs[m] = MFMA16(aa[s], bv[s][m], qs[m]);
#pragma unroll
    for (int m = 0; m < 2; ++m)
#pragma unroll
      for (int j = 0; j < 4; ++j) OT[(16 * w + 4 * fq + j) * 40 + 16 * m + fr] = f2bf(qs[m][j]);
#pragma unroll
    for (int nn = 0; nn < 2; ++nn)
#pragma unroll
      for (int m = 0; m < 2; ++m) accS[nn][m] = accS[nn][m] * gl;
#pragma unroll
    for (int s = 0; s < 2; ++s)
#pragma unroll
      for (int nn = 0; nn < 2; ++nn)
#pragma unroll
        for (int m = 0; m < 2; ++m) accS[nn][m] = MFMA16(ak[s][nn], bv[s][m], accS[nn][m]);
#pragma unroll
    for (int nn = 0; nn < 2; ++nn)
#pragma unroll
      for (int m = 0; m < 2; ++m) {
        u32x2 o; o[0] = pk2(accS[nn][m][0], accS[nn][m][1]); o[1] = pk2(accS[nn][m][2], accS[nn][m][3]);
        *(u32x2*)(ST + (16 * m + fr) * 136 + 32 * w + 16 * nn + 4 * fq) = o;
      }
    LDS_BARRIER();
    {
      const int tk = tid >> 2, c8 = (tid & 3) * 8;
      *(u32x4*)(WSB(p, oraw) + ((size_t)b * SEQ + n * 64 + tk) * DM + h * 128 + vs * 32 + c8) = *(const u32x4*)(OT + tk * 40 + c8);
    }
  }
#undef F2_LOAD
}

DI void elem_phase(const Params& p, int l) {
  const int tid = opaque_tid(), lane = tid & 63;
  const size_t stride = (size_t)VGRID * 256;
  for (size_t idx = (size_t)opaque_bid() * 256 + tid; idx < (size_t)MTOK * 32; idx += stride) {
    const size_t tok = idx >> 5; const int ch = (int)(idx & 31), hh = ch >> 3, d0 = (ch & 7) * 8;
    const float l0 = WSF(p, lse)[tok * 12 + hh], l1 = WSF(p, lse)[tok * 12 + 4 + hh], l2 = WSF(p, lse)[tok * 12 + 8 + hh];
    const float mx = fmaxf(l0, fmaxf(l1, l2));
    const float e0 = __expf(l0 - mx), e1 = __expf(l1 - mx), e2 = __expf(l2 - mx);
    const float inv = 1.f / (e0 + e1 + e2);
    const float wg[3] = {e0 * inv, e1 * inv, e2 * inv};
    float y[8];
#pragma unroll
    for (int e = 0; e < 8; ++e) y[e] = 0.f;
#pragma unroll
    for (int g = 0; g < 3; ++g) {
      const u32x4 raw = *(const u32x4*)(WSB(p, og) + tok * 768 + g * 256 + hh * 64 + d0);
      float v[8]; unpack8(raw, v);
#pragma unroll
      for (int e = 0; e < 8; ++e) y[e] += wg[g] * v[e];
    }
    *(u32x4*)(WSB(p, yatt) + tok * 256 + hh * 64 + d0) = pack8(y);
  }
  for (size_t idx = (size_t)opaque_bid() * 256 + tid; idx < (size_t)MTOK * 128; idx += stride) {
    const size_t tok = idx >> 7; const int col = (int)(idx & 127) * 8;
    const u32x4 raw = *(const u32x4*)(WSB(p, oraw) + tok * DM + col);
    float v[8]; unpack8(raw, v);
    float ss = 0.f;
#pragma unroll
    for (int e = 0; e < 8; ++e) ss += v[e] * v[e];
    ss += shx(ss, 1, lane); ss += shx(ss, 2, lane); ss += shx(ss, 4, lane); ss += shx(ss, 8, lane);
    const float rstd = rsqrtf(ss * (1.f / 128.f) + EPS);
    const u32x4 graw = *(const u32x4*)(WSB(p, z) + tok * ZLD + Z_DNGATE + col);
    float gz[8]; unpack8(graw, gz);
    const float* gn = p.dn_norm + l * 128 + (col & 127);
    float y[8];
#pragma unroll
    for (int e = 0; e < 8; ++e) y[e] = v[e] * rstd * gn[e] * siluf_(gz[e]);
    *(u32x4*)(WSB(p, odn) + tok * DM + col) = pack8(y);
  }
}


#define XB_TMO      128
#define XB_XCNT(j)  (256  + 64 * (j))
#define XB_XSUB(j)  (1280 + 64 * (j))
#define XB_XGEN(j)  (2304 + 64 * (j))
#define XB_TOP      3328
#define XB_TOPGEN   3392
#define XCD_BAR_WORDS 3456
#define XB_SPIN_CAP (1u << 22)
#define LAS __attribute__((address_space(3)))
DI unsigned xb_ld(unsigned* p)              { return __hip_atomic_load(p, __ATOMIC_RELAXED, __HIP_MEMORY_SCOPE_AGENT); }
DI unsigned xb_add(unsigned* p, unsigned v) { return __hip_atomic_fetch_add(p, v, __ATOMIC_RELAXED, __HIP_MEMORY_SCOPE_AGENT); }
DI unsigned xb_xcc_id() { return (unsigned)__builtin_amdgcn_s_getreg((3 << 11) | 20) & 0xFu; }
#define XB_SPIN(cond, bar) do { unsigned _sp = 0; while (cond) { __builtin_amdgcn_s_sleep(1); \
    if ((++_sp & 255u) == 0u) { if (xb_ld(&(bar)[XB_TMO])) break; if (_sp > XB_SPIN_CAP) { atomicAdd(&(bar)[XB_TMO], 1u); break; } } } } while (0)
struct XcdBarrier { unsigned* bar; unsigned x; volatile LAS unsigned* st; };
DI XcdBarrier xcd_barrier_post(unsigned* bar, volatile LAS unsigned* st) {
  XcdBarrier b; b.bar = bar; b.x = xb_xcc_id(); b.st = st;
  if (threadIdx.x == 0) (void)xb_add(&bar[XB_XCNT(b.x)], 1u);
  return b;
}
DI void xcd_barrier_complete(unsigned* bar, unsigned x, unsigned& nloc, unsigned& nx) {
  const unsigned G = gridDim.x * gridDim.y * gridDim.z;
  unsigned sum, cnt, mine, sp = 0u;
  for (;;) {
    sum = 0u; cnt = 0u; mine = 0u;
#pragma unroll
    for (unsigned j = 0; j < 16; ++j) { const unsigned c = xb_ld(&bar[XB_XCNT(j)]); sum += c; cnt += (c > 0u) ? 1u : 0u; mine = (j == x) ? c : mine; }
    if (sum == G) break;
    __builtin_amdgcn_s_sleep(1);
    if ((++sp & 255u) == 0u) { if (xb_ld(&bar[XB_TMO])) break; if (sp > XB_SPIN_CAP) { atomicAdd(&bar[XB_TMO], 1u); break; } }
  }
  nloc = mine > 0u ? mine : 1u; nx = cnt > 0u ? cnt : 1u;
}
DI void xcd_barrier_impl(const XcdBarrier& b) {
  asm volatile("s_waitcnt vmcnt(0)" ::: "memory");
  __syncthreads();
  if (threadIdx.x == 0) {
    unsigned* bar = b.bar; asm volatile("" : "+s"(bar));
    __builtin_amdgcn_s_waitcnt(0);
    const unsigned nloc = b.st[0], nx = b.st[1];
    const unsigned old = xb_add(&bar[XB_XSUB(b.x)], 1u);
    const unsigned gen = old / nloc;
    if (old + 1u == (gen + 1u) * nloc) {
      __builtin_amdgcn_fence(__ATOMIC_RELEASE, "agent");
      asm volatile("s_waitcnt vmcnt(0)" ::: "memory");
      const unsigned og = xb_add(&bar[XB_TOP], 1u);
      const unsigned tg = og / nx;
      if (og + 1u == (tg + 1u) * nx) xb_add(&bar[XB_TOPGEN], 1u);
      else XB_SPIN(xb_ld(&bar[XB_TOPGEN]) == tg, bar);
      __builtin_amdgcn_fence(__ATOMIC_ACQUIRE, "agent");
      xb_add(&bar[XB_XGEN(b.x)], 1u);
      asm volatile("s_waitcnt vmcnt(0)" ::: "memory");
    } else {
      XB_SPIN(xb_ld(&bar[XB_XGEN(b.x)]) == gen, bar);
      __builtin_amdgcn_fence(__ATOMIC_ACQUIRE, "agent");
      asm volatile("s_waitcnt vmcnt(0)" ::: "memory");
    }
  }
  __syncthreads();
}

DI void xcd_barrier_census(char* ws, char* lds) {
  if (threadIdx.x == 0) {
    unsigned nloc, nx; xcd_barrier_complete((unsigned*)(ws + O_bar), xb_xcc_id(), nloc, nx);
    volatile LAS unsigned* st = (volatile LAS unsigned*)(lds + LDS_BYTES); st[0] = nloc; st[1] = nx;
  }
  __syncthreads();
}
DI void xcd_barrier_ws(char* ws, char* lds) {
  XcdBarrier b; b.bar = (unsigned*)(ws + O_bar); b.x = xb_xcc_id(); b.st = (volatile LAS unsigned*)(lds + LDS_BYTES);
  xcd_barrier_impl(b);
}
__global__ void __launch_bounds__(512, 2) fwd_megakernel(Params p) {
  __shared__ __attribute__((aligned(16))) char lds[LDS_BYTES + 16];
  cg::grid_group grid = cg::this_grid();
  if (threadIdx.x == 0) { *(volatile LAS unsigned*)(lds + LDS_BYTES) = 0u; *(volatile LAS unsigned*)(lds + LDS_BYTES + 4) = 0u; }
  __syncthreads();
  (void)xcd_barrier_post((unsigned*)(p.ws + O_bar), (volatile LAS unsigned*)(lds + LDS_BYTES));
  phase0(p, vlds(lds));
  convert_layer(p, 0, vlds(lds), opaque_bid(), VGRID);
  grid.sync();
  xcd_barrier_census(p.ws, lds);
  for (int l = 0; l < DEPTH; ++l) {
    const float* modl = WSF(p, mod) + (size_t)l * 8 * 9216;
    norm_phase(p, l == 0 ? p.x : p.out, p.norm_ff1 + l * DM, modl + 0 * DM, modl + 1 * DM);
    xcd_barrier_ws(p.ws, lds);
    gemm_up_phase(p, WSW(p, W_up1, l), lds);
    xcd_barrier_ws(p.ws, lds);
    gemm_res_phase(p, l == 0 ? p.x : p.out, WSB(p, hidden), DFF, WSW(p, W_down1, l), modl + 2 * DM, 0.5f, lds);
    xcd_barrier_ws(p.ws, lds);
    norm_phase(p, p.out, p.norm_mix + l * DM, modl + 3 * DM, modl + 4 * DM);
    xcd_barrier_ws(p.ws, lds);
    gemm_in_phase(p, WSW(p, W_in, l), lds);
    xcd_barrier_ws(p.ws, lds);
    {
      char* vl = vlds(lds);
      for (int it = opaque_bid(); it < 2048 + 512; it += VGRID) {
        if (it < 2048) dn_f1_item(p, l, it, vl); else attn_item(p, l, it - 2048, vl);
      }
    }
    xcd_barrier_ws(p.ws, lds);
    {
      char* vl = vlds(lds);
      const int vb = opaque_bid();
      if (vb < 256) dn_f2_item(p, vb, vl);
      else {
        for (int it = 512 + vb - 256; it < 1536; it += VGRID - 256) attn_item(p, l, it, vl);
        if (l + 1 < DEPTH) convert_layer(p, l + 1, vl, vb - 256, VGRID - 256);
      }
    }
    xcd_barrier_ws(p.ws, lds);
    elem_phase(p, l);
    xcd_barrier_ws(p.ws, lds);
    gemm_proj_phase(p, WSW(p, W_pa, l), WSW(p, W_pd, l), lds);
    xcd_barrier_ws(p.ws, lds);
    gemm_res_phase(p, p.out, WSB(p, mrg), DM, WSW(p, W_out, l), modl + 5 * DM, 1.0f, lds);
    xcd_barrier_ws(p.ws, lds);
    norm_phase(p, p.out, p.norm_ff2 + l * DM, modl + 6 * DM, modl + 7 * DM);
    xcd_barrier_ws(p.ws, lds);
    gemm_up_phase(p, WSW(p, W_up2, l), lds);
    xcd_barrier_ws(p.ws, lds);
    gemm_res_phase(p, p.out, WSB(p, hidden), DFF, WSW(p, W_down2, l), modl + 8 * DM, 0.5f, lds);
    xcd_barrier_ws(p.ws, lds);
  }
}

extern "C" void kernel_launch(void* const* d_in, const int* in_sizes, int n_in, void* d_out, int out_size, void* d_ws, size_t ws_size, hipStream_t stream) {
  static int grid_blocks = 0;
  if (!grid_blocks) {
    int dev = 0, cus = 0, per_cu = 0;
    hipGetDevice(&dev);
    hipDeviceGetAttribute(&cus, hipDeviceAttributeMultiprocessorCount, dev);
    hipOccupancyMaxActiveBlocksPerMultiprocessor(&per_cu, fwd_megakernel, 512, 0);
    if (per_cu > 1) per_cu = 1;
    grid_blocks = cus * per_cu;
    if (grid_blocks % 8) grid_blocks -= grid_blocks % 8;
  }
  Params p{};
  const float* const* in = (const float* const*)d_in;
  p.x = in[0]; p.c = in[1]; p.ada_w = in[2]; p.ada_b = in[3]; p.norm_ff1 = in[4]; p.w_up1 = in[5]; p.w_down1 = in[6]; p.norm_mix = in[7];
  p.w_in = in[8]; p.q_norm = in[9]; p.k_norm = in[10]; p.conv_w = in[11]; p.a_log = in[12]; p.dt_bias = in[13]; p.dn_norm = in[14];
  p.w_pa = in[15]; p.w_pd = in[16]; p.w_out = in[17]; p.norm_ff2 = in[18]; p.w_up2 = in[19]; p.w_down2 = in[20];
  p.out = (float*)d_out;
  p.ws = (char*)d_ws;
  if (WS_TOTAL > ws_size) { fprintf(stderr, "kernel_launch: workspace too small (%zu needed, %zu given)\n", (size_t)WS_TOTAL, ws_size); return; }
  if (hipMemsetAsync(p.ws + O_bar, 0, (size_t)3456 * 4, stream) != hipSuccess) fprintf(stderr, "kernel_launch: barrier memset failed\n");
  void* args[] = {&p};
  hipError_t e = hipLaunchCooperativeKernel((void*)fwd_megakernel, dim3(grid_blocks), dim3(512), args, 0, stream);
  if (e != hipSuccess) fprintf(stderr, "cooperative launch failed: %s (grid %d)\n", hipGetErrorString(e), grid_blocks);
}
```

```cpp
#include <hip/hip_runtime.h>
#include <hip/hip_cooperative_groups.h>
#include <cstdio>
#include <cstdint>
namespace cg = cooperative_groups;

typedef unsigned short bf16_t;
typedef short bf16x8 __attribute__((ext_vector_type(8)));
typedef short s16x4 __attribute__((ext_vector_type(4)));
typedef float f32x4 __attribute__((ext_vector_type(4)));
typedef float f32x16 __attribute__((ext_vector_type(16)));
typedef unsigned u32x4 __attribute__((ext_vector_type(4)));
typedef unsigned u32x2 __attribute__((ext_vector_type(2)));

#define DI __device__ __forceinline__
#define MFMA16(a, b, c) __builtin_amdgcn_mfma_f32_16x16x32_bf16((a), (b), (c), 0, 0, 0)
#define MFMA32(a, b, c) __builtin_amdgcn_mfma_f32_32x32x16_bf16((a), (b), (c), 0, 0, 0)

constexpr int DM = 1024, NB = 8, SEQ = 2048, MTOK = NB * SEQ, DFF = 2816, DEPTH = 4;
constexpr int ZLD = 3072;
constexpr int NINP = 8704;
constexpr int Z_DNGATE = 0, Z_MERGE = 1024;
constexpr int LDS_BYTES = 147456;
constexpr int VLDS = 73728;
constexpr int LROW = 144;
constexpr int TILE_BYTES = 256 * LROW;
constexpr int STAGE_BYTES = 2 * TILE_BYTES;
constexpr float EPS = 1e-6f;

struct Params {
  const float *x, *c, *ada_w, *ada_b, *norm_ff1, *w_up1, *w_down1, *norm_mix, *w_in, *q_norm, *k_norm, *conv_w, *a_log, *dt_bias,
      *dn_norm, *w_pa, *w_pd, *w_out, *norm_ff2, *w_up2, *w_down2;
  float* out;
  char* ws;
};
constexpr size_t al256(size_t b) { return (b + 255) & ~(size_t)255; }
constexpr size_t O_W_up1 = 0;
constexpr size_t O_W_down1 = O_W_up1 + al256((size_t)2 * DFF * DM * 2);
constexpr size_t O_W_in = O_W_down1 + al256((size_t)DM * DFF * 2);
constexpr size_t O_W_pa = O_W_in + al256((size_t)NINP * DM * 2);
constexpr size_t O_W_pd = O_W_pa + al256((size_t)DM * 256 * 2);
constexpr size_t O_W_out = O_W_pd + al256((size_t)DM * DM * 2);
constexpr size_t O_W_up2 = O_W_out + al256((size_t)DM * DM * 2);
constexpr size_t O_W_down2 = O_W_up2 + al256((size_t)2 * DFF * DM * 2);
constexpr size_t WSET_BYTES = O_W_down2 + al256((size_t)DM * DFF * 2);
constexpr size_t O_h = 2 * WSET_BYTES;
constexpr size_t O_z = O_h + al256((size_t)MTOK * DM * 2);
constexpr size_t O_zatt = O_z + al256((size_t)MTOK * ZLD * 2);
constexpr size_t O_zdn = O_zatt + al256((size_t)MTOK * 2304 * 2);
constexpr size_t O_hidden = O_zatt;
constexpr size_t O_og = O_zdn + al256((size_t)MTOK * 3072 * 2);
constexpr size_t O_yatt = O_og + al256((size_t)MTOK * 768 * 2);
constexpr size_t O_dW = O_yatt + al256((size_t)MTOK * 256 * 2);
constexpr size_t O_dUT = O_dW + al256((size_t)MTOK * DM * 2);
constexpr size_t O_mrg = O_dUT;
constexpr size_t O_dQD = O_dUT + al256((size_t)MTOK * DM * 2);
constexpr size_t O_dKDT = O_dQD + al256((size_t)MTOK * DM * 2);
constexpr size_t O_dAI = O_dKDT + al256((size_t)MTOK * DM * 2);
constexpr size_t O_oraw = O_dAI + al256((size_t)2048 * 4096 * 2);
constexpr size_t O_odn = O_dW;
constexpr size_t O_ab = O_oraw + al256((size_t)MTOK * DM * 2);
constexpr size_t O_mod = O_ab + al256((size_t)MTOK * 16 * 4);
constexpr size_t O_lse = O_mod + al256((size_t)DEPTH * 8 * 9216 * 4);
constexpr size_t O_dGL = O_lse + al256((size_t)MTOK * 12 * 4);
constexpr size_t O_bar = O_dGL + al256((size_t)2048 * 4);
constexpr size_t WS_TOTAL = O_bar + al256((size_t)3456 * 4);
#define WSB(p, name) ((bf16_t*)((p).ws + O_##name))
#define WSW(p, name, l_) ((bf16_t*)((p).ws + O_##name + (size_t)((l_) & 1) * WSET_BYTES))
#define WSF(p, name) ((float*)((p).ws + O_##name))

DI int opaque_tid() { int t = threadIdx.x; asm volatile("" : "+v"(t)); return t & 255; }
DI int real_tid() { int t = threadIdx.x; asm volatile("" : "+v"(t)); return t; }
DI int opaque_bid() { int h = threadIdx.x; asm volatile("" : "+v"(h)); int t = blockIdx.x; asm volatile("" : "+s"(t)); return t * 2 + __builtin_amdgcn_readfirstlane(h >> 8); }
DI int real_bid() { int t = blockIdx.x; asm volatile("" : "+s"(t)); return t; }
#define VGRID ((int)gridDim.x * 2)
DI char* vlds(char* lds) { unsigned t = threadIdx.x; asm volatile("" : "+v"(t)); unsigned off = (t >> 8) * VLDS; asm volatile("" : "+v"(off)); return lds + off; }
typedef float f32x2 __attribute__((ext_vector_type(2)));
typedef __bf16 hwbf16x2 __attribute__((ext_vector_type(2)));
DI unsigned pk2(float lo, float hi) { const f32x2 v = {lo, hi}; return __builtin_bit_cast(unsigned, __builtin_convertvector(v, hwbf16x2)); }
DI unsigned short f2bf(float x) { return (unsigned short)(pk2(x, 0.f) & 0xffffu); }
DI float bf2f(unsigned short v) { return __uint_as_float(((unsigned)v) << 16); }
DI float bflo(unsigned u) { return __uint_as_float(u << 16); }
DI float bfhi(unsigned u) { return __uint_as_float(u & 0xffff0000u); }
DI float shx(float v, int mask, int lane) { return __int_as_float(__builtin_amdgcn_ds_bpermute((lane ^ mask) << 2, __float_as_int(v))); }
DI float shup(float v, int off, int lane) { return __int_as_float(__builtin_amdgcn_ds_bpermute((lane - off) << 2, __float_as_int(v))); }
DI float sigmoidf_(float x) { return 1.f / (1.f + __expf(-x)); }
DI float siluf_(float x) { return x / (1.f + __expf(-x)); }
DI void unpack8(const u32x4& r, float (&v)[8]) {
  v[0] = bflo(r[0]); v[1] = bfhi(r[0]); v[2] = bflo(r[1]); v[3] = bfhi(r[1]);
  v[4] = bflo(r[2]); v[5] = bfhi(r[2]); v[6] = bflo(r[3]); v[7] = bfhi(r[3]);
}
DI u32x4 pack8(const float (&v)[8]) { u32x4 r; r[0] = pk2(v[0], v[1]); r[1] = pk2(v[2], v[3]); r[2] = pk2(v[4], v[5]); r[3] = pk2(v[6], v[7]); return r; }

template <int MH> DI void gemm_core_simple(const bf16_t* __restrict__ A, int lda, const bf16_t* __restrict__ Bt, int ldb, int K, f32x4 (&acc)[MH][4], char* lds) {
  const int tid = real_tid(), lane = tid & 63, wid = tid >> 6, wr = wid >> 2, wc = wid & 3, fr = lane & 15, fq = lane >> 4;
  const int sl = lane ^ ((lane >> 5) << 1);
  const int R0 = (wid >> 1) * 16 + (sl >> 2), C0 = (wid & 1) * 32 + (sl & 3) * 8;
  const bf16_t* gA = A + (size_t)R0 * lda + C0;
  const bf16_t* gB = Bt + (size_t)R0 * ldb + C0;
  const size_t sA = (size_t)64 * lda, sB = (size_t)64 * ldb;
  unsigned st_off = (unsigned)tid * 16u;
  const unsigned rd_off = (unsigned)((fr * 64 + fq * 16) ^ ((fr >> 3) << 5));
  unsigned rd_a = (unsigned)(wr * (MH * 2048)) + rd_off;
  unsigned rd_b = 32768u + (unsigned)(wc * 4096) + rd_off;
  asm volatile("" : "+v"(st_off), "+v"(rd_a), "+v"(rd_b));
  const int nk = K >> 6;
#define GSTAGE(sbase_, k0_)                                                                                                        \
  {                                                                                                                                \
    _Pragma("unroll") for (int j = 0; j < 4; ++j) {                                                                                \
      if (j < MH / 2) __builtin_amdgcn_global_load_lds((const unsigned*)(gA + j * sA + (k0_)), (unsigned*)(lds + ((sbase_) + j * 8192 + st_off)), 16, 0, 0);          \
      __builtin_amdgcn_global_load_lds((const unsigned*)(gB + j * sB + (k0_)), (unsigned*)(lds + ((sbase_) + 32768 + j * 8192 + st_off)), 16, 0, 0);  \
    }                                                                                                                              \
  }
  GSTAGE(0u, 0);
  asm volatile("s_waitcnt vmcnt(0)" ::: "memory");
  __syncthreads();
#pragma unroll 1
  for (int kt = 0; kt < nk; ++kt) {
    const unsigned sbase = (unsigned)(kt & 1) << 16;
    if (kt + 1 < nk) GSTAGE(65536u - sbase, (kt + 1) * 64);
    const char* pa = lds + (rd_a + sbase);
    const char* pb = lds + (rd_b + sbase);
    bf16x8 af[2 * MH], b0[4], b1[4];
    constexpr int B1S = MH >= 5 ? MH - 5 : 0;
#define RDA(g_) af[g_] = *(const bf16x8*)(pa + ((g_) % MH) * 2048 + ((g_) / MH) * 1024)
#define RDB(ks_, n_) *(const bf16x8*)(pb + ((n_) >> 1) * 16384 + ((n_) & 1) * 2048 + (ks_) * 1024)
    b0[0] = RDB(0, 0); b0[1] = RDB(0, 1); b0[2] = RDB(0, 2); b0[3] = RDB(0, 3);
    RDA(0); RDA(1); RDA(2);
    __builtin_amdgcn_sched_barrier(0);
#pragma unroll
    for (int g = 0; g < 2 * MH; ++g) {
      if (g + 3 < 2 * MH) RDA(g + 3);
      if (g >= B1S && g < B1S + 4) b1[g - B1S] = RDB(1, g - B1S);
      __builtin_amdgcn_sched_barrier(0);
      if (g < MH) {
#pragma unroll
        for (int n = 0; n < 4; ++n) acc[g % MH][n] = MFMA16(b0[n], af[g], acc[g % MH][n]);
      } else {
#pragma unroll
        for (int n = 0; n < 4; ++n) acc[g % MH][n] = MFMA16(b1[n], af[g], acc[g % MH][n]);
      }
      __builtin_amdgcn_sched_barrier(0);
    }
#undef RDA
#undef RDB
    asm volatile("s_waitcnt vmcnt(0)" ::: "memory");
    __syncthreads();
  }
#undef GSTAGE
}

DI void gemm_core(const bf16_t* __restrict__ A, int lda, const bf16_t* __restrict__ Bt, int ldb, int K, f32x4 (&acc)[8][4], char* lds) {
  const int tid = real_tid(), lane = tid & 63, wid = tid >> 6, wr = wid >> 2, wc = wid & 3, fr = lane & 15, fq = lane >> 4;
  const int sl = lane ^ ((lane >> 5) << 1);
  const int R0 = (wid >> 1) * 16 + (sl >> 2), C0 = (wid & 1) * 32 + (sl & 3) * 8;
  const bf16_t* gA = A + (size_t)R0 * lda + C0;
  const bf16_t* gB = Bt + (size_t)R0 * ldb + C0;
  const size_t sA = (size_t)64 * lda, sB = (size_t)64 * ldb;
  const unsigned rd_off = (unsigned)((fr * 64 + fq * 16) ^ ((fr >> 3) << 5));
  unsigned st0 = (unsigned)tid * 16u, st1 = st0 + 65536u;
  unsigned ra0 = (unsigned)(wr * 8192) + rd_off, ra1 = ra0 + 65536u;
  unsigned rb0 = 32768u + (unsigned)(wc * 4096) + rd_off, rb1 = rb0 + 65536u;
  asm volatile("" : "+v"(st0), "+v"(st1), "+v"(ra0), "+v"(ra1), "+v"(rb0), "+v"(rb1));
  const int nt = K >> 6;
  bf16x8 At[4][2], B0[2][2], B1[2][2];
#define STG_A(b_, h_, kt_) { const bf16_t* g_ = gA + (size_t)((h_) * 128) * lda + (size_t)(kt_) * 64; char* d_ = lds + (((b_) ? st1 : st0) + (h_) * 16384); \
    __builtin_amdgcn_global_load_lds((const unsigned*)g_, (unsigned*)d_, 16, 0, 0); __builtin_amdgcn_global_load_lds((const unsigned*)(g_ + sA), (unsigned*)(d_ + 8192), 16, 0, 0); }
#define STG_B(b_, h_, kt_) { const bf16_t* g_ = gB + (size_t)((h_) * 128) * ldb + (size_t)(kt_) * 64; char* d_ = lds + (((b_) ? st1 : st0) + 32768 + (h_) * 16384); \
    __builtin_amdgcn_global_load_lds((const unsigned*)g_, (unsigned*)d_, 16, 0, 0); __builtin_amdgcn_global_load_lds((const unsigned*)(g_ + sB), (unsigned*)(d_ + 8192), 16, 0, 0); }
#define LDA(b_, h_) { const char* s_ = lds + (((b_) ? ra1 : ra0) + (h_) * 16384); \
    _Pragma("unroll") for (int m = 0; m < 4; ++m) _Pragma("unroll") for (int k = 0; k < 2; ++k) At[m][k] = *(const bf16x8*)(s_ + m * 2048 + k * 1024); }
#define LDB(dst_, b_, h_) { const char* s_ = lds + (((b_) ? rb1 : rb0) + (h_) * 16384); \
    _Pragma("unroll") for (int n = 0; n < 2; ++n) _Pragma("unroll") for (int k = 0; k < 2; ++k) dst_[n][k] = *(const bf16x8*)(s_ + n * 2048 + k * 1024); }
#define MMA(ai_, bj_, Bx_) { __builtin_amdgcn_s_setprio(1); \
    _Pragma("unroll") for (int m = 0; m < 4; ++m) _Pragma("unroll") for (int n = 0; n < 2; ++n) _Pragma("unroll") for (int k = 0; k < 2; ++k) \
      acc[(ai_) * 4 + m][(bj_) * 2 + n] = MFMA16(Bx_[n][k], At[m][k], acc[(ai_) * 4 + m][(bj_) * 2 + n]); \
    __builtin_amdgcn_s_setprio(0); }
#define WAIT_V(n_) asm volatile("s_waitcnt vmcnt(" #n_ ")" ::: "memory")
#define WAIT_L(n_) asm volatile("s_waitcnt lgkmcnt(" #n_ ")" ::: "memory")
#define BAR __builtin_amdgcn_s_barrier()
#define SCHED __builtin_amdgcn_sched_barrier(0)
  WAIT_V(0);
  STG_B(0, 0, 0); STG_A(0, 0, 0); STG_B(0, 1, 0); STG_A(0, 1, 0);
  if (wr == 1) BAR;
  WAIT_V(4); BAR;
  STG_B(1, 0, 1); STG_A(1, 0, 1); STG_B(1, 1, 1);
  WAIT_V(6); BAR;
#pragma unroll 1
  for (int t = 0; t < nt - 2; t += 2) {
    LDB(B0, 0, 0); SCHED; LDA(0, 0); STG_A(1, 1, t + 1);
    WAIT_L(8); BAR; WAIT_L(0); MMA(0, 0, B0); BAR; SCHED;
    LDB(B1, 0, 1); STG_B(0, 0, t + 2);
    BAR; WAIT_L(0); MMA(0, 1, B1); BAR;
    LDA(0, 1); STG_A(0, 0, t + 2);
    BAR; WAIT_L(0); MMA(1, 0, B0); BAR; SCHED;
    STG_B(0, 1, t + 2);
    WAIT_V(6); BAR; MMA(1, 1, B1); BAR;
    LDB(B0, 1, 0); SCHED; LDA(1, 0); STG_A(0, 1, t + 2);
    WAIT_L(8); BAR; WAIT_L(0); MMA(0, 0, B0); BAR; SCHED;
    LDB(B1, 1, 1); STG_B(1, 0, t + 3);
    BAR; WAIT_L(0); MMA(0, 1, B1); BAR;
    LDA(1, 1); STG_A(1, 0, t + 3);
    BAR; WAIT_L(0); MMA(1, 0, B0); BAR; SCHED;
    STG_B(1, 1, t + 3);
    WAIT_V(6); BAR; MMA(1, 1, B1); BAR;
  }
  { LDB(B0, 0, 0); LDA(0, 0); STG_A(1, 1, nt - 1);
    BAR; WAIT_L(0); MMA(0, 0, B0); BAR;
    LDB(B1, 0, 1); BAR; WAIT_L(0); MMA(0, 1, B1); BAR;
    LDA(0, 1); WAIT_V(4); BAR; WAIT_L(0); MMA(1, 0, B0); MMA(1, 1, B1); BAR; }
  { LDB(B0, 1, 0); LDA(1, 0); WAIT_V(2); BAR; WAIT_L(0); MMA(0, 0, B0); BAR;
    LDB(B1, 1, 1); WAIT_V(0); BAR; WAIT_L(0); MMA(0, 1, B1); BAR;
    LDA(1, 1); BAR; WAIT_L(0); MMA(1, 0, B0); MMA(1, 1, B1); BAR; }
  if (wr == 0) BAR;
#undef STG_A
#undef STG_B
#undef LDA
#undef LDB
#undef MMA
#undef WAIT_V
#undef WAIT_L
#undef BAR
#undef SCHED
}

DI void tile_decode(int t, int& mt, int& nt) {
  const int xcd = t & 7, local = t >> 3;
  mt = 8 * xcd + (local & 7); nt = local >> 3;
}
template <int MH> DI void zero_acc(f32x4 (&acc)[MH][4]) {
#pragma unroll
  for (int m = 0; m < MH; ++m)
#pragma unroll
    for (int n = 0; n < 4; ++n) acc[m][n] = (f32x4){0.f, 0.f, 0.f, 0.f};
}
#define GEMM_IDS const int tid = real_tid(), lane = tid & 63, wid = tid >> 6, wr = wid >> 2, wc = wid & 3, fr = lane & 15, fq = lane >> 4
#define GEMM_IDS_AGAIN const int tid = real_tid(), lane = tid & 63, wid = tid >> 6, wr = wid >> 2, wc = wid & 3, fr = lane & 15, fq = lane >> 4; (void)lane; (void)wr; (void)wc
#define EROW(m) ((size_t)mt * 256 + ((m) >> 2) * 128 + wr * 64 + ((m) & 3) * 16 + fr)
#define ECOL8(bj) (nt * 256 + (bj) * 128 + wc * 32 + fq * 8)

template <int MH> DI void up_epilogue(const Params& p, const f32x4 (&acc)[MH][4], int mt, int half, int nt, int wr, int wc, int fr, int fq) {
#pragma unroll
  for (int m = 0; m < MH; ++m) {
    const size_t row = (size_t)mt * 256 + (MH == 8 ? (m >> 2) : half) * 128 + wr * 64 + (m & 3) * 16 + fr;
    const int hc = nt * 128 + wc * 32 + fq * 8;
    float o[8];
#pragma unroll
    for (int n = 0; n < 2; ++n)
#pragma unroll
      for (int j = 0; j < 4; ++j) { const float g = acc[m][n][j], u = acc[m][n + 2][j]; o[4 * n + j] = siluf_(g) * u; }
    *(u32x4*)(WSB(p, hidden) + row * DFF + hc) = pack8(o);
  }
}
DI void tail_decode(int bid, int nfull, int& mt, int& nt, int& half) { tile_decode(nfull + ((bid >> 4) << 3) + (bid & 7), mt, nt); half = (bid >> 3) & 1; }

DI void gemm_up_phase(const Params& p, const bf16_t* Bt, char* lds) {
  GEMM_IDS; (void)lane;
  constexpr int NT = 22, NFULL = (64 * NT / 256) * 256;
  for (int t = real_bid(); t < 64 * NT; t += gridDim.x) {
    int mt, nt; tile_decode(t, mt, nt);
    f32x4 acc[8][4]; zero_acc(acc);
    gemm_core(WSB(p, h) + (size_t)mt * 256 * DM, DM, Bt + (size_t)nt * 256 * DM, DM, DM, acc, lds);
    GEMM_IDS_AGAIN;
    up_epilogue<8>(p, acc, mt, 0, nt, wr, wc, fr, fq);
  }
}

DI void gemm_res_phase(const Params& p, const float* xin, const bf16_t* A, int K, const bf16_t* Bt, const float* gate, float coef, char* lds) {
  GEMM_IDS; (void)lane;
  constexpr int NT = 4;
  for (int t = real_bid(); t < 64 * NT; t += gridDim.x) {
    int mt, nt; tile_decode(t, mt, nt);
    f32x4 acc[8][4]; zero_acc(acc);
    gemm_core(A + (size_t)mt * 256 * K, K, Bt + (size_t)nt * 256 * K, K, K, acc, lds);
    GEMM_IDS_AGAIN;
    const int b = mt >> 3;
#pragma unroll
    for (int bj = 0; bj < 2; ++bj) {
      const int col = ECOL8(bj);
      const f32x4 g0 = *(const f32x4*)(gate + (size_t)b * 9216 + col), g1 = *(const f32x4*)(gate + (size_t)b * 9216 + col + 4);
#pragma unroll
      for (int m = 0; m < 8; ++m) {
        const size_t xo = EROW(m) * DM + col;
        f32x4 x0 = *(const f32x4*)(xin + xo), x1 = *(const f32x4*)(xin + xo + 4);
        x0 = x0 + (g0 * acc[m][2 * bj]) * coef; x1 = x1 + (g1 * acc[m][2 * bj + 1]) * coef;
        *(f32x4*)(p.out + xo) = x0; *(f32x4*)(p.out + xo + 4) = x1;
        if (m & 1) __builtin_amdgcn_sched_barrier(0);
      }
    }
  }
}

template <int MH> DI void in_epilogue(const Params& p, const f32x4 (&acc)[MH][4], int mt, int half, int nt, int wr, int wc, int fr, int fq) {
#define IN_ROW(m) ((size_t)mt * 256 + (MH == 8 ? ((m) >> 2) : half) * 128 + wr * 64 + ((m) & 3) * 16 + fr)
#define IN_PK(m, bj) ((u32x4){pk2(acc[m][2 * (bj)][0], acc[m][2 * (bj)][1]), pk2(acc[m][2 * (bj)][2], acc[m][2 * (bj)][3]), pk2(acc[m][2 * (bj) + 1][0], acc[m][2 * (bj) + 1][1]), pk2(acc[m][2 * (bj) + 1][2], acc[m][2 * (bj) + 1][3])})
  if (nt < 9) {
#pragma unroll
    for (int bj = 0; bj < 2; ++bj) {
      const int col = ECOL8(bj), sq = col / 768, rem = col - sq * 768, g = rem >> 8, hh = (rem >> 6) & 3, dd = rem & 63;
      const int sh = (g == 0) ? 0 : (g == 1 ? 2 : 4);
#pragma unroll
      for (int m = 0; m < MH; ++m) {
        const size_t row = IN_ROW(m);
        const int b = (int)(row >> 11), t = (int)(row & 2047);
        const int ridx = ((t & ((1 << sh) - 1)) << (11 - sh)) + (t >> sh);
        *(u32x4*)(WSB(p, zatt) + ((size_t)((((b * 3 + sq) * 3 + g) * 4 + hh) * 2048 + ridx)) * 64 + dd) = IN_PK(m, bj);
      }
    }
  } else if (nt < 21) {
#pragma unroll
    for (int bj = 0; bj < 2; ++bj) {
      const int c = ECOL8(bj) - 2304, seg = c >> 10, hd = (c >> 7) & 7, cc = c & 127;
#pragma unroll
      for (int m = 0; m < MH; ++m) {
        const size_t row = IN_ROW(m);
        const int b = (int)(row >> 11), t = (int)(row & 2047);
        *(u32x4*)(WSB(p, zdn) + ((size_t)(((b * 8 + hd) * 3 + seg) * 2048 + t)) * 128 + cc) = IN_PK(m, bj);
      }
    }
  } else if (nt < 33) {
#pragma unroll
    for (int m = 0; m < MH; ++m) {
      const size_t row = IN_ROW(m);
#pragma unroll
      for (int bj = 0; bj < 2; ++bj) *(u32x4*)(WSB(p, z) + row * ZLD + (ECOL8(bj) - 5376)) = IN_PK(m, bj);
    }
  } else if (wc == 0 && fq < 2) {
#pragma unroll
    for (int m = 0; m < MH; ++m) {
      float* ap = WSF(p, ab) + IN_ROW(m) * 16 + fq * 8;
      *(f32x4*)ap = acc[m][0]; *(f32x4*)(ap + 4) = acc[m][1];
    }
  }
#undef IN_ROW
#undef IN_PK
}
DI void gemm_in_phase(const Params& p, const bf16_t* Win, char* lds) {
  GEMM_IDS; (void)lane;
  constexpr int NT = 34, NFULL = (64 * NT / 256) * 256;
  for (int t = real_bid(); t < 64 * NT; t += gridDim.x) {
    int mt, nt; tile_decode(t, mt, nt);
    f32x4 acc[8][4]; zero_acc(acc);
    gemm_core(WSB(p, h) + (size_t)mt * 256 * DM, DM, Win + (size_t)nt * 256 * DM, DM, DM, acc, lds);
    GEMM_IDS_AGAIN;
    in_epilogue<8>(p, acc, mt, 0, nt, wr, wc, fr, fq);
  }
}

DI void gemm_proj_phase(const Params& p, const bf16_t* Wpa, const bf16_t* Wpd, char* lds) {
  GEMM_IDS; (void)lane;
  constexpr int NT = 4;
  for (int t = real_bid(); t < 64 * NT; t += gridDim.x) {
    int mt, nt; tile_decode(t, mt, nt);
    f32x4 acc[8][4]; zero_acc(acc);
    gemm_core(WSB(p, yatt) + (size_t)mt * 256 * 256, 256, Wpa + (size_t)nt * 256 * 256, 256, 256, acc, lds);
    GEMM_IDS_AGAIN;
#pragma unroll
    for (int m = 0; m < 8; ++m) {
      const size_t row = EROW(m);
#pragma unroll
      for (int bj = 0; bj < 2; ++bj) {
        const int col = ECOL8(bj);
        const u32x4 gz = *(const u32x4*)(WSB(p, z) + row * ZLD + Z_MERGE + col);
        float gt[8], o[8]; unpack8(gz, gt);
#pragma unroll
        for (int e = 0; e < 8; ++e) o[e] = sigmoidf_(gt[e]) * acc[m][2 * bj + (e >> 2)][e & 3];
        *(u32x4*)(WSB(p, mrg) + row * DM + col) = pack8(o);
      }
      __builtin_amdgcn_sched_barrier(0);
    }
  }
  for (int t = real_bid(); t < 64 * NT; t += gridDim.x) {
    int mt, nt; tile_decode(t, mt, nt);
    f32x4 acc[8][4]; zero_acc(acc);
    gemm_core(WSB(p, odn) + (size_t)mt * 256 * DM, DM, Wpd + (size_t)nt * 256 * DM, DM, DM, acc, lds);
    GEMM_IDS_AGAIN;
#pragma unroll
    for (int m = 0; m < 8; ++m) {
      const size_t row = EROW(m);
#pragma unroll
      for (int bj = 0; bj < 2; ++bj) {
        const int col = ECOL8(bj);
        const u32x4 gz = *(const u32x4*)(WSB(p, z) + row * ZLD + Z_MERGE + DM + col);
        const u32x4 pv = *(const u32x4*)(WSB(p, mrg) + row * DM + col);
        float gt[8], pr[8], o[8]; unpack8(gz, gt); unpack8(pv, pr);
#pragma unroll
        for (int e = 0; e < 8; ++e) o[e] = pr[e] + sigmoidf_(gt[e]) * acc[m][2 * bj + (e >> 2)][e & 3];
        *(u32x4*)(WSB(p, mrg) + row * DM + col) = pack8(o);
      }
      __builtin_amdgcn_sched_barrier(0);
    }
  }
}

DI void convert_matrix(const float* __restrict__ src, int ldsrc, bf16_t* __restrict__ dst, int K, int ncoltiles, int kind, char* lds, int start, int stride) {
  float* tl = (float*)lds;
  const int tid = opaque_tid();
  const int nkt = K >> 6;
  const int nitems = ncoltiles * nkt;
  for (int it = start; it < nitems; it += stride) {
    const int ct = it / nkt, kt = it - ct * nkt;
    int srccol0 = ct * 64, nvalid = 64;
    if (kind == 1) { const int T = ct >> 2, q = ct & 3; srccol0 = (q >> 1) * DFF + T * 128 + (q & 1) * 64; }
    else if (kind == 2) {
      if (ct < 100) srccol0 = ct * 64;
      else if (ct < 132) srccol0 = 6416 + (ct - 100) * 64;
      else if (ct == 132) { srccol0 = 6400; nvalid = 16; }
      else { srccol0 = 0; nvalid = 0; }
    }
    const int r = tid >> 4, c4 = (tid & 15) * 4;
#pragma unroll
    for (int ps = 0; ps < 4; ++ps) {
      const int kk = r + 16 * ps;
      f32x4 v = (f32x4){0.f, 0.f, 0.f, 0.f};
      if (c4 < nvalid) v = *(const f32x4*)(src + (size_t)(kt * 64 + kk) * ldsrc + srccol0 + c4);
      tl[kk * 65 + c4 + 0] = v[0]; tl[kk * 65 + c4 + 1] = v[1]; tl[kk * 65 + c4 + 2] = v[2]; tl[kk * 65 + c4 + 3] = v[3];
    }
    __syncthreads();
#pragma unroll
    for (int ps = 0; ps < 2; ++ps) {
      const int n = (tid >> 3) + 32 * ps, k8 = (tid & 7) * 8;
      float v[8];
      const int nl = (n & 32) + 8 * ((n & 15) >> 2) + 4 * ((n >> 4) & 1) + (n & 3);
#pragma unroll
      for (int e = 0; e < 8; ++e) v[e] = tl[(k8 + e) * 65 + nl];
      *(u32x4*)(dst + (size_t)(ct * 64 + n) * K + kt * 64 + k8) = pack8(v);
    }
    __syncthreads();
  }
}

DI void convert_layer(const Params& p, int l, char* lds, int start, int stride) {
  convert_matrix(p.w_up1 + (size_t)l * DM * 2 * DFF, 2 * DFF, WSW(p, W_up1, l), DM, 88, 1, lds, start, stride);
  convert_matrix(p.w_down1 + (size_t)l * DFF * DM, DM, WSW(p, W_down1, l), DFF, 16, 0, lds, start, stride);
  convert_matrix(p.w_in + (size_t)l * DM * 8464, 8464, WSW(p, W_in, l), DM, 136, 2, lds, start, stride);
  convert_matrix(p.w_pa + (size_t)l * 256 * DM, DM, WSW(p, W_pa, l), 256, 16, 0, lds, start, stride);
  convert_matrix(p.w_pd + (size_t)l * DM * DM, DM, WSW(p, W_pd, l), DM, 16, 0, lds, start, stride);
  convert_matrix(p.w_out + (size_t)l * DM * DM, DM, WSW(p, W_out, l), DM, 16, 0, lds, start, stride);
  convert_matrix(p.w_up2 + (size_t)l * DM * 2 * DFF, 2 * DFF, WSW(p, W_up2, l), DM, 88, 1, lds, start, stride);
  convert_matrix(p.w_down2 + (size_t)l * DFF * DM, DM, WSW(p, W_down2, l), DFF, 16, 0, lds, start, stride);
}

DI void norm_phase(const Params& p, const float* xin, const float* g, const float* shift, const float* scale  ) {
  const int tid = opaque_tid(), lane = tid & 63, wid = tid >> 6;
  const int nw = VGRID * 4;
  for (int row = opaque_bid() * 4 + wid; row < MTOK; row += nw) {
    const int b = row >> 11;
    const float* xp = xin + (size_t)row * DM;
    f32x4 v[2][2]; float ss = 0.f;
#pragma unroll
    for (int i = 0; i < 2; ++i)
#pragma unroll
      for (int hq = 0; hq < 2; ++hq) {
        v[i][hq] = *(const f32x4*)(xp + i * 512 + lane * 8 + hq * 4);
        ss += v[i][hq][0] * v[i][hq][0] + v[i][hq][1] * v[i][hq][1] + v[i][hq][2] * v[i][hq][2] + v[i][hq][3] * v[i][hq][3];
      }
#pragma unroll
    for (int o = 1; o < 64; o <<= 1) ss += shx(ss, o, lane);
    const float rstd = rsqrtf(ss * (1.f / DM) + EPS);
#pragma unroll
    for (int i = 0; i < 2; ++i) {
      const int col = i * 512 + lane * 8;
      float o[8];
#pragma unroll
      for (int hq = 0; hq < 2; ++hq) {
        const f32x4 gv = *(const f32x4*)(g + col + hq * 4), sc = *(const f32x4*)(scale + (size_t)b * 9216 + col + hq * 4), sh = *(const f32x4*)(shift + (size_t)b * 9216 + col + hq * 4);
#pragma unroll
        for (int j = 0; j < 4; ++j) o[hq * 4 + j] = v[i][hq][j] * rstd * gv[j] * (1.f + sc[j]) + sh[j];
      }
      *(u32x4*)(WSB(p, h) + (size_t)row * DM + col) = pack8(o);
    }
  }
}

DI void phase0(const Params& p, char* lds) {
  float* cact = (float*)lds;
  float* red = (float*)(lds + 32768);
  const int tid = opaque_tid(), lane = tid & 63, wid = tid >> 6;
  for (int i = tid; i < NB * DM; i += 256) cact[i] = siluf_(p.c[i]);
  __syncthreads();
  for (int it = opaque_bid(); it < 576; it += VGRID) {
    const int l = it / 144, cb = it - l * 144;
    float acc[8];
#pragma unroll
    for (int b = 0; b < 8; ++b) acc[b] = 0.f;
    const float* wp = p.ada_w + (size_t)l * DM * 9216 + cb * 64 + lane;
    const int kbeg = wid * 256;
#pragma unroll 1
    for (int k = kbeg; k < kbeg + 256; k += 8) {
      float wv[8];
#pragma unroll
      for (int u = 0; u < 8; ++u) wv[u] = wp[(size_t)(k + u) * 9216];
#pragma unroll
      for (int b = 0; b < 8; ++b) {
        const f32x4 c0 = *(const f32x4*)(cact + b * DM + k), c1 = *(const f32x4*)(cact + b * DM + k + 4);
        acc[b] += c0[0] * wv[0] + c0[1] * wv[1] + c0[2] * wv[2] + c0[3] * wv[3] + c1[0] * wv[4] + c1[1] * wv[5] + c1[2] * wv[6] + c1[3] * wv[7];
      }
    }
#pragma unroll
    for (int b = 0; b < 8; ++b) red[(wid * 8 + b) * 64 + lane] = acc[b];
    __syncthreads();
#pragma unroll
    for (int h2 = 0; h2 < 2; ++h2) {
      const int b = (tid >> 6) + 4 * h2, c = tid & 63;
      const float sum = red[(0 * 8 + b) * 64 + c] + red[(1 * 8 + b) * 64 + c] + red[(2 * 8 + b) * 64 + c] + red[(3 * 8 + b) * 64 + c];
      WSF(p, mod)[((size_t)l * 8 + b) * 9216 + cb * 64 + c] = sum + p.ada_b[(size_t)l * 9216 + cb * 64 + c];
    }
    __syncthreads();
  }
}

DI void attn_item(const Params& p, int l, int item, char* lds) {
  const int tid = opaque_tid(), lane = tid & 63, w = tid >> 6, r = lane & 31, hf = lane >> 5;
  const int blk16 = item & 15, hh = (item >> 4) & 3, rest = item >> 6, g = rest % 3, b = rest / 3;
  const int d = (g == 0) ? 1 : (g == 1 ? 4 : 16);
  const int nbk = 16 / d, res = blk16 / nbk, nb = blk16 - res * nbk;
  const int qcol = g * 256 + hh * 64;
  const int Lsub = 2048 / d;
  const bf16_t* zq = WSB(p, zatt) + ((size_t)((((b * 3 + 0) * 3 + g) * 4 + hh) * 2048 + res * Lsub)) * 64;
  const bf16_t* zk = WSB(p, zatt) + ((size_t)((((b * 3 + 1) * 3 + g) * 4 + hh) * 2048 + res * Lsub)) * 64;
  const bf16_t* zv = WSB(p, zatt) + ((size_t)((((b * 3 + 2) * 3 + g) * 4 + hh) * 2048 + res * Lsub)) * 64;
  bf16_t* VT = (bf16_t*)lds;
  float* nrm = (float*)(lds + 64 * 528);
  if (tid < 128) nrm[tid] = (tid < 64) ? p.q_norm[l * 64 + tid] : p.k_norm[l * 64 + tid - 64];
  const int qi = 32 * w + r;
  const int tq = (128 * nb + qi) * d + res;
  u32x4 vraw[8], qraw[4], kraw[5][4];
  {
    const int lk = 128 * (nb - 1) + tid, lkc = lk < 0 ? 0 : lk;
    const u32x4* src = (const u32x4*)(zv + (size_t)lkc * 64);
#pragma unroll
    for (int i = 0; i < 8; ++i) vraw[i] = src[i];
    const bf16_t* qp = zq + (size_t)(128 * nb + qi) * 64 + 8 * hf;
#pragma unroll
    for (int s = 0; s < 4; ++s) qraw[s] = *(const u32x4*)(qp + 16 * s);
#pragma unroll
    for (int i = 0; i < 2; ++i) {
      const int lkk = 128 * (nb - 1) + 32 * (w + i) + r, lkkc = lkk < 0 ? 0 : lkk;
      const bf16_t* kp = zk + (size_t)lkkc * 64 + 8 * hf;
#pragma unroll
      for (int s = 0; s < 4; ++s) kraw[i][s] = *(const u32x4*)(kp + 16 * s);
    }
  }
  __builtin_amdgcn_sched_barrier(0);
  {
    const int key = tid;
#pragma unroll
    for (int i = 0; i < 8; ++i)
#pragma unroll
      for (int e = 0; e < 4; ++e) {
        constexpr int d0 = 0;
        const int da = 8 * i + 2 * e + d0, db = da + 1;
        VT[(32 * (da >> 5) + 8 * ((da >> 2) & 3) + 4 * ((da >> 4) & 1) + (da & 3)) * 264 + key] = (bf16_t)(vraw[i][e] & 0xffffu);
        VT[(32 * (db >> 5) + 8 * ((db >> 2) & 3) + 4 * ((db >> 4) & 1) + (db & 3)) * 264 + key] = (bf16_t)(vraw[i][e] >> 16);
      }
  }
  __syncthreads();
  bf16x8 qf[4];
  {
    float qv[4][8]; float ss = 0.f;
#pragma unroll
    for (int s = 0; s < 4; ++s) {
      unpack8(qraw[s], qv[s]);
#pragma unroll
      for (int j = 0; j < 8; ++j) ss += qv[s][j] * qv[s][j];
    }
    ss += shx(ss, 32, lane);
    const float rstd = rsqrtf(ss * (1.f / 64.f) + EPS) * 0.125f;
#pragma unroll
    for (int s = 0; s < 4; ++s) {
      const float* gn = nrm + 16 * s + 8 * hf;
      float o[8];
#pragma unroll
      for (int j = 0; j < 8; ++j) o[j] = qv[s][j] * rstd * gn[j];
      qf[s] = __builtin_bit_cast(bf16x8, pack8(o));
    }
  }
  f32x16 st[5];
#pragma unroll
  for (int i = 0; i < 5; ++i) {
    if (i + 2 < 5 && (nb > 0 || w + i + 2 >= 4)) {
      const int lkk = 128 * (nb - 1) + 32 * (w + i + 2) + r, lkkc = lkk < 0 ? 0 : lkk;
      const bf16_t* kp = zk + (size_t)lkkc * 64 + 8 * hf;
#pragma unroll
      for (int s = 0; s < 4; ++s) kraw[i + 2][s] = *(const u32x4*)(kp + 16 * s);
    }
    __builtin_amdgcn_sched_barrier(0);
#pragma unroll
    for (int e = 0; e < 16; ++e) st[i][e] = 0.f;
    if (nb > 0 || w + i >= 4) {
      float kv[4][8]; float ss = 0.f;
#pragma unroll
      for (int s = 0; s < 4; ++s) {
        unpack8(kraw[i][s], kv[s]);
#pragma unroll
        for (int j = 0; j < 8; ++j) ss += kv[s][j] * kv[s][j];
      }
      ss += shx(ss, 32, lane);
      const float rstd = rsqrtf(ss * (1.f / 64.f) + EPS);
#pragma unroll
      for (int s = 0; s < 4; ++s) {
        const float* gn = nrm + 64 + 16 * s + 8 * hf;
        float o[8];
#pragma unroll
        for (int j = 0; j < 8; ++j) o[j] = kv[s][j] * rstd * gn[j];
        const bf16x8 kf = __builtin_bit_cast(bf16x8, pack8(o));
        st[i] = MFMA32(kf, qf[s], st[i]);
      }
    }
  }
  float mx = -3.0e38f;
#pragma unroll
  for (int i = 0; i < 5; ++i)
#pragma unroll
    for (int e = 0; e < 16; ++e) {
      const int c = (e & 3) + 8 * (e >> 2) + 4 * hf;
      const bool valid = (nb > 0 || w + i >= 4) && (i == 0 ? c >= r : (i == 4 ? c <= r : true));
      st[i][e] = valid ? st[i][e] : -3.0e38f;
      mx = fmaxf(mx, st[i][e]);
    }
  mx = fmaxf(mx, shx(mx, 32, lane));
  float den = 0.f;
#pragma unroll
  for (int i = 0; i < 5; ++i)
#pragma unroll
    for (int e = 0; e < 16; ++e) {
      const float pe = (st[i][e] > -1.0e38f) ? __expf(st[i][e] - mx) : 0.f;
      st[i][e] = pe; den += pe;
    }
  den += shx(den, 32, lane);
  f32x16 ot[2];
#pragma unroll
  for (int dt = 0; dt < 2; ++dt)
#pragma unroll
    for (int e = 0; e < 16; ++e) ot[dt][e] = 0.f;
#pragma unroll
  for (int i = 0; i < 5; ++i)
#pragma unroll
    for (int s2 = 0; s2 < 2; ++s2) if (nb > 0 || w + i >= 4) {
      u32x4 pp;
      pp[0] = pk2(st[i][8 * s2 + 0], st[i][8 * s2 + 1]); pp[1] = pk2(st[i][8 * s2 + 2], st[i][8 * s2 + 3]);
      pp[2] = pk2(st[i][8 * s2 + 4], st[i][8 * s2 + 5]); pp[3] = pk2(st[i][8 * s2 + 6], st[i][8 * s2 + 7]);
      const bf16x8 pf = __builtin_bit_cast(bf16x8, pp);
#pragma unroll
      for (int dt = 0; dt < 2; ++dt) {
        const bf16_t* vp = VT + (32 * dt + r) * 264 + 32 * (w + i) + 16 * s2 + 4 * hf;
        const u32x2 lo = *(const u32x2*)vp, hi = *(const u32x2*)(vp + 8);
        u32x4 vv; vv[0] = lo[0]; vv[1] = lo[1]; vv[2] = hi[0]; vv[3] = hi[1];
        ot[dt] = MFMA32(__builtin_bit_cast(bf16x8, vv), pf, ot[dt]);
      }
    }
  const float inv = 1.f / den;
  const size_t tok = (size_t)b * SEQ + tq;
#pragma unroll
  for (int dt = 0; dt < 2; ++dt)
#pragma unroll
    for (int h8 = 0; h8 < 2; ++h8) {
      float o[8];
#pragma unroll
      for (int e = 0; e < 8; ++e) o[e] = ot[dt][8 * h8 + e] * inv;
      *(u32x4*)(WSB(p, og) + tok * 768 + qcol + 32 * dt + 16 * hf + 8 * h8) = pack8(o);
    }
  if (hf == 0) WSF(p, lse)[tok * 12 + g * 4 + hh] = mx + __logf(den);
  __syncthreads();
}

DI int lnd(int v) { asm volatile("" : "+s"(v)); return v; }
DI void dn_f1_item(const Params& p, int l, int chunk, char* lds) {
  const int tid = opaque_tid(), lane = tid & 63, w = tid >> 6, fr = lane & 15, fq = lane >> 4;
  const int n = chunk & 31, bh = chunk >> 5, h = bh & 7, b = bh >> 3;
  const int t0 = n * 64;
  const size_t rowbase = (size_t)b * SEQ;
  bf16_t* Qn = (bf16_t*)lds;
  bf16_t* Kn = (bf16_t*)(lds + 17408);
  bf16_t* KB = (bf16_t*)(lds + 2 * 17408);
  bf16_t* Vs = (bf16_t*)(lds + 3 * 17408);
  float* gcs = (float*)(lds + 4 * 17408);
  float* betas = gcs + 64;
  float* egc = gcs + 128;
  float* Am = (float*)lds;
  if (w == 0) {
    const size_t row = rowbase + t0 + lane;
    const float a = WSF(p, ab)[row * 16 + h], bb = WSF(p, ab)[row * 16 + 8 + h];
    const float xx = a + p.dt_bias[l * 8 + h];
    const float sp = xx > 20.f ? xx : log1pf(__expf(xx));
    float s = -__expf(p.a_log[l * 8 + h]) * sp;
#pragma unroll
    for (int off = 1; off < 64; off <<= 1) { const float t = shup(s, off, lane); if (lane >= off) s += t; }
    gcs[lane] = s; betas[lane] = sigmoidf_(bb); egc[lane] = __expf(s);
    if (lane == 63) WSF(p, dGL)[chunk] = __expf(s);
  }
  __syncthreads();
  const float gclast = gcs[63];
  const int cg8 = (tid & 15) * 8, rg = tid >> 4;
#pragma unroll 1
  for (int seg = 0; seg < 3; ++seg) {
    u32x4 rows[7];
#pragma unroll
    for (int r = 0; r < 7; ++r) {
      const int tt = t0 + 4 * rg - 3 + r;
      rows[r] = (u32x4){0u, 0u, 0u, 0u};
      if (tt >= 0) rows[r] = *(const u32x4*)(WSB(p, zdn) + ((size_t)(((b * 8 + h) * 3 + seg) * 2048 + tt)) * 128 + cg8);
    }
    float cw[4][8];
#pragma unroll
    for (int tap = 0; tap < 4; ++tap) {
      const float* cp = p.conv_w + ((size_t)l * 4 + tap) * 3072 + seg * 1024 + h * 128 + cg8;
      const f32x4 c0 = *(const f32x4*)cp, c1 = *(const f32x4*)(cp + 4);
      cw[tap][0] = c0[0]; cw[tap][1] = c0[1]; cw[tap][2] = c0[2]; cw[tap][3] = c0[3];
      cw[tap][4] = c1[0]; cw[tap][5] = c1[1]; cw[tap][6] = c1[2]; cw[tap][7] = c1[3];
    }
#pragma unroll
    for (int jt = 0; jt < 4; ++jt) {
      const int i = 4 * rg + jt;
      float val[8];
#pragma unroll
      for (int e = 0; e < 8; ++e) val[e] = 0.f;
#pragma unroll
      for (int tap = 0; tap < 4; ++tap) {
        float xv[8]; unpack8(rows[jt + tap], xv);
#pragma unroll
        for (int e = 0; e < 8; ++e) val[e] += cw[tap][e] * xv[e];
      }
      float ss = 0.f;
#pragma unroll
      for (int e = 0; e < 8; ++e) { val[e] = siluf_(val[e]); ss += val[e] * val[e]; }
      ss += shx(ss, 1, lane); ss += shx(ss, 2, lane); ss += shx(ss, 4, lane); ss += shx(ss, 8, lane);
      const float rn = rsqrtf(ss + EPS);
      if (seg == 0) {
        const float eg = egc[i];
        float qv[8], qd[8];
#pragma unroll
        for (int e = 0; e < 8; ++e) { qv[e] = val[e] * rn * 0.08838834764831845f; qd[e] = qv[e] * eg; }
        *(u32x4*)(Qn + i * 136 + cg8) = pack8(qv);
        *(u32x4*)(WSB(p, dQD) + ((size_t)lnd(chunk) * 64 + i) * 128 + cg8) = pack8(qd);
      } else if (seg == 1) {
        const float bt = betas[i];
        float kv[8], kb[8];
#pragma unroll
        for (int e = 0; e < 8; ++e) { kv[e] = val[e] * rn; kb[e] = kv[e] * bt; }
        *(u32x4*)(Kn + i * 136 + cg8) = pack8(kv);
        *(u32x4*)(KB + i * 136 + cg8) = pack8(kb);
      } else {
        *(u32x4*)(Vs + i * 136 + cg8) = pack8(val);
      }
    }
  }
  __syncthreads();
  {
    const int dcol = tid >> 1, half = tid & 1;
    u32x4 o4[4];
#pragma unroll
    for (int q = 0; q < 4; ++q)
#pragma unroll
      for (int e = 0; e < 4; ++e) {
        const int i0 = 32 * half + 8 * q + 2 * e;
        const float k0 = bf2f(Kn[i0 * 136 + dcol]) * __expf(gclast - gcs[i0]);
        const float k1 = bf2f(Kn[(i0 + 1) * 136 + dcol]) * __expf(gclast - gcs[i0 + 1]);
        o4[q][e] = pk2(k0, k1);
      }
    u32x4* dst = (u32x4*)(WSB(p, dKDT) + ((size_t)lnd(chunk) * 128 + dcol) * 64 + 32 * half);
#pragma unroll
    for (int q = 0; q < 4; ++q) dst[q] = o4[q];
  }
  f32x4 kk[4], qk[4];
#pragma unroll
  for (int nn = 0; nn < 4; ++nn) { kk[nn] = (f32x4){0.f, 0.f, 0.f, 0.f}; qk[nn] = (f32x4){0.f, 0.f, 0.f, 0.f}; }
#pragma unroll
  for (int s = 0; s < 4; ++s) {
    const bf16x8 akb = *(const bf16x8*)(KB + (16 * w + fr) * 136 + 32 * s + 8 * fq);
    const bf16x8 aq = *(const bf16x8*)(Qn + (16 * w + fr) * 136 + 32 * s + 8 * fq);
#pragma unroll
    for (int nn = 0; nn < 4; ++nn) {
      const bf16x8 bk = *(const bf16x8*)(Kn + (16 * nn + fr) * 136 + 32 * s + 8 * fq);
      kk[nn] = MFMA16(akb, bk, kk[nn]);
      qk[nn] = MFMA16(aq, bk, qk[nn]);
    }
  }
  __syncthreads();
#pragma unroll
  for (int nn = 0; nn < 4; ++nn)
#pragma unroll
    for (int j = 0; j < 4; ++j) {
      const int i = 16 * w + 4 * fq + j, jj = 16 * nn + fr;
      const float dec = __expf(fminf(gcs[i] - gcs[jj], 0.f));
      Am[i * 64 + jj] = (jj < i) ? kk[nn][j] * dec : 0.f;
      Kn[i * 72 + jj] = f2bf((jj <= i) ? qk[nn][j] * dec : 0.f);
    }
  __syncthreads();
#pragma unroll
  for (int ps = 0; ps < 2; ++ps) {
    const int id = tid + 256 * ps, i = id >> 3, c8 = (id & 7) * 8;
    *(u32x4*)(WSB(p, dAI) + ((size_t)lnd(chunk) * 64 + i) * 64 + c8) = *(const u32x4*)(Kn + i * 72 + c8);
  }
  {
    const int c = tid & 127; const bool isW = tid >= 128;
    const bf16_t* rsrc = isW ? KB : Vs;
    const float* msrc = isW ? egc : betas;
    float x[64];
#pragma unroll
    for (int i = 0; i < 64; ++i) x[i] = 0.f;
#pragma unroll
    for (int i = 0; i < 64; ++i) {
      const float rhs = bf2f(rsrc[i * 136 + c]) * msrc[i];
      float s0 = 0.f, s1 = 0.f, s2 = 0.f, s3 = 0.f;
#pragma unroll
      for (int j4 = 0; j4 < (i + 3) / 4; ++j4) {
        const f32x4 a = *(const f32x4*)(Am + i * 64 + 4 * j4);
        s0 += a[0] * x[4 * j4]; s1 += a[1] * x[4 * j4 + 1]; s2 += a[2] * x[4 * j4 + 2]; s3 += a[3] * x[4 * j4 + 3];
      }
      x[i] = rhs - ((s0 + s1) + (s2 + s3));
    }
    if (!isW) {
      u32x4* dst = (u32x4*)(WSB(p, dUT) + ((size_t)lnd(chunk) * 128 + c) * 64);
#pragma unroll
      for (int q = 0; q < 8; ++q) {
        u32x4 o; o[0] = pk2(x[8 * q], x[8 * q + 1]); o[1] = pk2(x[8 * q + 2], x[8 * q + 3]); o[2] = pk2(x[8 * q + 4], x[8 * q + 5]); o[3] = pk2(x[8 * q + 6], x[8 * q + 7]);
        dst[q] = o;
      }
    }
    __syncthreads();
    if (isW) {
#pragma unroll
      for (int i = 0; i < 64; ++i) Kn[i * 136 + c] = f2bf(x[i]);
    }
  }
  __syncthreads();
#pragma unroll
  for (int ps = 0; ps < 4; ++ps) {
    const int id = tid + 256 * ps, i = id >> 4, c8 = (id & 15) * 8;
    *(u32x4*)(WSB(p, dW) + ((size_t)lnd(chunk) * 64 + i) * 128 + c8) = *(const u32x4*)(Kn + i * 136 + c8);
  }
  __syncthreads();
}

#define LDS_BARRIER() do { asm volatile("s_waitcnt lgkmcnt(0)" ::: "memory"); __builtin_amdgcn_s_barrier(); asm volatile("" ::: "memory"); } while (0)
DI void dn_f2_item(const Params& p, int item, char* lds) {
  const int tid = opaque_tid(), lane = tid & 63, w = tid >> 6, fr = lane & 15, fq = lane >> 4;
  const int vs = item & 3, bh = item >> 2, h = bh & 7, b = bh >> 3;
  bf16_t* ST = (bf16_t*)lds;
  bf16_t* VT = (bf16_t*)(lds + 32 * 272);
  bf16_t* OT = (bf16_t*)(lds + 32 * 272 + 32 * 144);
  for (int i = tid; i < 32 * 136; i += 256) ST[i] = 0;
  f32x4 accS[2][2];
#pragma unroll
  for (int nn = 0; nn < 2; ++nn)
#pragma unroll
    for (int m = 0; m < 2; ++m) accS[nn][m] = (f32x4){0.f, 0.f, 0.f, 0.f};
  __syncthreads();
  bf16x8 naw[4], naq[4], naa[2], nak[2][2]; u32x2 nuu[2]; float ngl;
#define F2_LOAD(n_)                                                                                                     \
  {                                                                                                                     \
    const size_t chunk_ = (size_t)bh * 32 + (n_);                                                                       \
    const bf16_t* Wc = WSB(p, dW) + chunk_ * 8192; const bf16_t* QDc = WSB(p, dQD) + chunk_ * 8192;                     \
    const bf16_t* AIc = WSB(p, dAI) + chunk_ * 4096; const bf16_t* KDTc = WSB(p, dKDT) + chunk_ * 8192;                 \
    const bf16_t* UTc = WSB(p, dUT) + chunk_ * 8192;                                                                    \
    _Pragma("unroll") for (int s = 0; s < 4; ++s) {                                                                     \
      naw[s] = *(const bf16x8*)(Wc + (16 * w + fr) * 128 + 32 * s + 8 * fq);                                            \
      naq[s] = *(const bf16x8*)(QDc + (16 * w + fr) * 128 + 32 * s + 8 * fq);                                           \
    }                                                                                                                   \
    _Pragma("unroll") for (int s = 0; s < 2; ++s) {                                                                     \
      naa[s] = *(const bf16x8*)(AIc + (16 * w + fr) * 64 + 32 * s + 8 * fq);                                            \
      _Pragma("unroll") for (int nn = 0; nn < 2; ++nn) nak[s][nn] = *(const bf16x8*)(KDTc + (32 * w + 16 * nn + fr) * 64 + 32 * s + 8 * fq); \
    }                                                                                                                   \
    _Pragma("unroll") for (int m = 0; m < 2; ++m) nuu[m] = *(const u32x2*)(UTc + (vs * 32 + 16 * m + fr) * 64 + 16 * w + 4 * fq); \
    ngl = WSF(p, dGL)[chunk_];                                                                                          \
  }
  F2_LOAD(0);
  for (int n = 0; n < 32; ++n) {
    bf16x8 aw[4], aq[4], aa[2], ak[2][2]; u32x2 uu[2];
#pragma unroll
    for (int s = 0; s < 4; ++s) { aw[s] = naw[s]; aq[s] = naq[s]; }
#pragma unroll
    for (int s = 0; s < 2; ++s) { aa[s] = naa[s]; ak[s][0] = nak[s][0]; ak[s][1] = nak[s][1]; uu[s] = nuu[s]; }
    const float gl = ngl;
    if (n + 1 < 32) F2_LOAD(n + 1);
    f32x4 ws[2], qs[2];
#pragma unroll
    for (int m = 0; m < 2; ++m) { ws[m] = (f32x4){0.f, 0.f, 0.f, 0.f}; qs[m] = (f32x4){0.f, 0.f, 0.f, 0.f}; }
#pragma unroll
    for (int s = 0; s < 4; ++s) {
#pragma unroll
      for (int m = 0; m < 2; ++m) {
        const bf16x8 bs = *(const bf16x8*)(ST + (16 * m + fr) * 136 + 32 * s + 8 * fq);
        ws[m] = MFMA16(aw[s], bs, ws[m]);
        qs[m] = MFMA16(aq[s], bs, qs[m]);
      }
    }
#pragma unroll
    for (int m = 0; m < 2; ++m) {
      const float v0 = bflo(uu[m][0]) - ws[m][0], v1 = bfhi(uu[m][0]) - ws[m][1], v2 = bflo(uu[m][1]) - ws[m][2], v3 = bfhi(uu[m][1]) - ws[m][3];
      u32x2 o; o[0] = pk2(v0, v1); o[1] = pk2(v2, v3);
      *(u32x2*)(VT + (16 * m + fr) * 72 + 16 * w + 4 * fq) = o;
    }
    LDS_BARRIER();
    bf16x8 bv[2][2];
#pragma unroll
    for (int s = 0; s < 2; ++s)
#pragma unroll
      for (int m = 0; m < 2; ++m) bv[s][m] = *(const bf16x8*)(VT + (16 * m + fr) * 72 + 32 * s + 8 * fq);
#pragma unroll
    for (int s = 0; s < 2; ++s)
#pragma unroll
      for (int m = 0; m < 2; ++m) qs[m] = MFMA16(aa[s], bv[s][m], qs[m]);
#pragma unroll
    for (int m = 0; m < 2; ++m)
#pragma unroll
      for (int j = 0; j < 4; ++j) OT[(16 * w + 4 * fq + j) * 40 + 16 * m + fr] = f2bf(qs[m][j]);
#pragma unroll
    for (int nn = 0; nn < 2; ++nn)
#pragma unroll
      for (int m = 0; m < 2; ++m) accS[nn][m] = accS[nn][m] * gl;
#pragma unroll
    for (int s = 0; s < 2; ++s)
#pragma unroll
      for (int nn = 0; nn < 2; ++nn)
#pragma unroll
        for (int m = 0; m < 2; ++m) accS[nn][m] = MFMA16(ak[s][nn], bv[s][m], accS[nn][m]);
#pragma unroll
    for (int nn = 0; nn < 2; ++nn)
#pragma unroll
      for (int m = 0; m < 2; ++m) {
        u32x2 o; o[0] = pk2(accS[nn][m][0], accS[nn][m][1]); o[1] = pk2(accS[nn][m][2], accS[nn][m][3]);
        *(u32x2*)(ST + (16 * m + fr) * 136 + 32 * w + 16 * nn + 4 * fq) = o;
      }
    LDS_BARRIER();
    {
      const int tk = tid >> 2, c8 = (tid & 3) * 8;
      *(u32x4*)(WSB(p, oraw) + ((size_t)b * SEQ + n * 64 + tk) * DM + h * 128 + vs * 32 + c8) = *(const u32x4*)(OT + tk * 40 + c8);
    }
  }
#undef F2_LOAD
}

DI void elem_phase(const Params& p, int l) {
  const int tid = opaque_tid(), lane = tid & 63;
  const size_t stride = (size_t)VGRID * 256;
  for (size_t idx = (size_t)opaque_bid() * 256 + tid; idx < (size_t)MTOK * 32; idx += stride) {
    const size_t tok = idx >> 5; const int ch = (int)(idx & 31), hh = ch >> 3, d0 = (ch & 7) * 8;
    const float l0 = WSF(p, lse)[tok * 12 + hh], l1 = WSF(p, lse)[tok * 12 + 4 + hh], l2 = WSF(p, lse)[tok * 12 + 8 + hh];
    const float mx = fmaxf(l0, fmaxf(l1, l2));
    const float e0 = __expf(l0 - mx), e1 = __expf(l1 - mx), e2 = __expf(l2 - mx);
    const float inv = 1.f / (e0 + e1 + e2);
    const float wg[3] = {e0 * inv, e1 * inv, e2 * inv};
    float y[8];
#pragma unroll
    for (int e = 0; e < 8; ++e) y[e] = 0.f;
#pragma unroll
    for (int g = 0; g < 3; ++g) {
      const u32x4 raw = *(const u32x4*)(WSB(p, og) + tok * 768 + g * 256 + hh * 64 + d0);
      float v[8]; unpack8(raw, v);
#pragma unroll
      for (int e = 0; e < 8; ++e) y[e] += wg[g] * v[e];
    }
    *(u32x4*)(WSB(p, yatt) + tok * 256 + hh * 64 + d0) = pack8(y);
  }
  for (size_t idx = (size_t)opaque_bid() * 256 + tid; idx < (size_t)MTOK * 128; idx += stride) {
    const size_t tok = idx >> 7; const int col = (int)(idx & 127) * 8;
    const u32x4 raw = *(const u32x4*)(WSB(p, oraw) + tok * DM + col);
    float v[8]; unpack8(raw, v);
    float ss = 0.f;
#pragma unroll
    for (int e = 0; e < 8; ++e) ss += v[e] * v[e];
    ss += shx(ss, 1, lane); ss += shx(ss, 2, lane); ss += shx(ss, 4, lane); ss += shx(ss, 8, lane);
    const float rstd = rsqrtf(ss * (1.f / 128.f) + EPS);
    const u32x4 graw = *(const u32x4*)(WSB(p, z) + tok * ZLD + Z_DNGATE + col);
    float gz[8]; unpack8(graw, gz);
    const float* gn = p.dn_norm + l * 128 + (col & 127);
    float y[8];
#pragma unroll
    for (int e = 0; e < 8; ++e) y[e] = v[e] * rstd * gn[e] * siluf_(gz[e]);
    *(u32x4*)(WSB(p, odn) + tok * DM + col) = pack8(y);
  }
}


#define XB_TMO      128
#define XB_XCNT(j)  (256  + 64 * (j))
#define XB_XSUB(j)  (1280 + 64 * (j))
#define XB_XGEN(j)  (2304 + 64 * (j))
#define XB_TOP      3328
#define XB_TOPGEN   3392
#define XCD_BAR_WORDS 3456
#define XB_SPIN_CAP (1u << 22)
#define LAS __attribute__((address_space(3)))
DI unsigned xb_ld(unsigned* p)              { return __hip_atomic_load(p, __ATOMIC_RELAXED, __HIP_MEMORY_SCOPE_AGENT); }
DI unsigned xb_add(unsigned* p, unsigned v) { return __hip_atomic_fetch_add(p, v, __ATOMIC_RELAXED, __HIP_MEMORY_SCOPE_AGENT); }
DI unsigned xb_xcc_id() { return (unsigned)__builtin_amdgcn_s_getreg((3 << 11) | 20) & 0xFu; }
#define XB_SPIN(cond, bar) do { unsigned _sp = 0; while (cond) { __builtin_amdgcn_s_sleep(1); \
    if ((++_sp & 255u) == 0u) { if (xb_ld(&(bar)[XB_TMO])) break; if (_sp > XB_SPIN_CAP) { atomicAdd(&(bar)[XB_TMO], 1u); break; } } } } while (0)
struct XcdBarrier { unsigned* bar; unsigned x; volatile LAS unsigned* st; };
DI XcdBarrier xcd_barrier_post(unsigned* bar, volatile LAS unsigned* st) {
  XcdBarrier b; b.bar = bar; b.x = xb_xcc_id(); b.st = st;
  if (threadIdx.x == 0) (void)xb_add(&bar[XB_XCNT(b.x)], 1u);
  return b;
}
DI void xcd_barrier_complete(unsigned* bar, unsigned x, unsigned& nloc, unsigned& nx) {
  const unsigned G = gridDim.x * gridDim.y * gridDim.z;
  unsigned sum, cnt, mine, sp = 0u;
  for (;;) {
    sum = 0u; cnt = 0u; mine = 0u;
#pragma unroll
    for (unsigned j = 0; j < 16; ++j) { const unsigned c = xb_ld(&bar[XB_XCNT(j)]); sum += c; cnt += (c > 0u) ? 1u : 0u; mine = (j == x) ? c : mine; }
    if (sum == G) break;
    __builtin_amdgcn_s_sleep(1);
    if ((++sp & 255u) == 0u) { if (xb_ld(&bar[XB_TMO])) break; if (sp > XB_SPIN_CAP) { atomicAdd(&bar[XB_TMO], 1u); break; } }
  }
  nloc = mine > 0u ? mine : 1u; nx = cnt > 0u ? cnt : 1u;
}
DI void xcd_barrier_impl(const XcdBarrier& b) {
  asm volatile("s_waitcnt vmcnt(0)" ::: "memory");
  __syncthreads();
  if (threadIdx.x == 0) {
    unsigned* bar = b.bar; asm volatile("" : "+s"(bar));
    __builtin_amdgcn_s_waitcnt(0);
    const unsigned nloc = b.st[0], nx = b.st[1];
    const unsigned old = xb_add(&bar[XB_XSUB(b.x)], 1u);
    const unsigned gen = old / nloc;
    if (old + 1u == (gen + 1u) * nloc) {
      __builtin_amdgcn_fence(__ATOMIC_RELEASE, "agent");
      asm volatile("s_waitcnt vmcnt(0)" ::: "memory");
      const unsigned og = xb_add(&bar[XB_TOP], 1u);
      const unsigned tg = og / nx;
      if (og + 1u == (tg + 1u) * nx) xb_add(&bar[XB_TOPGEN], 1u);
      else XB_SPIN(xb_ld(&bar[XB_TOPGEN]) == tg, bar);
      __builtin_amdgcn_fence(__ATOMIC_ACQUIRE, "agent");
      xb_add(&bar[XB_XGEN(b.x)], 1u);
      asm volatile("s_waitcnt vmcnt(0)" ::: "memory");
    } else {
      XB_SPIN(xb_ld(&bar[XB_XGEN(b.x)]) == gen, bar);
      __builtin_amdgcn_fence(__ATOMIC_ACQUIRE, "agent");
      asm volatile("s_waitcnt vmcnt(0)" ::: "memory");
    }
  }
  __syncthreads();
}

DI void xcd_barrier_census(char* ws, char* lds) {
  if (threadIdx.x == 0) {
    unsigned nloc, nx; xcd_barrier_complete((unsigned*)(ws + O_bar), xb_xcc_id(), nloc, nx);
    volatile LAS unsigned* st = (volatile LAS unsigned*)(lds + LDS_BYTES); st[0] = nloc; st[1] = nx;
  }
  __syncthreads();
}
DI void xcd_barrier_ws(char* ws, char* lds) {
  XcdBarrier b; b.bar = (unsigned*)(ws + O_bar); b.x = xb_xcc_id(); b.st = (volatile LAS unsigned*)(lds + LDS_BYTES);
  xcd_barrier_impl(b);
}
__global__ void __launch_bounds__(512, 2) fwd_megakernel(Params p) {
  __shared__ __attribute__((aligned(16))) char lds[LDS_BYTES + 16];
  cg::grid_group grid = cg::this_grid();
  if (threadIdx.x == 0) { *(volatile LAS unsigned*)(lds + LDS_BYTES) = 0u; *(volatile LAS unsigned*)(lds + LDS_BYTES + 4) = 0u; }
  __syncthreads();
  (void)xcd_barrier_post((unsigned*)(p.ws + O_bar), (volatile LAS unsigned*)(lds + LDS_BYTES));
  phase0(p, vlds(lds));
  convert_layer(p, 0, vlds(lds), opaque_bid(), VGRID);
  grid.sync();
  xcd_barrier_census(p.ws, lds);
  for (int l = 0; l < DEPTH; ++l) {
    const float* modl = WSF(p, mod) + (size_t)l * 8 * 9216;
    norm_phase(p, l == 0 ? p.x : p.out, p.norm_ff1 + l * DM, modl + 0 * DM, modl + 1 * DM);
    xcd_barrier_ws(p.ws, lds);
    gemm_up_phase(p, WSW(p, W_up1, l), lds);
    xcd_barrier_ws(p.ws, lds);
    gemm_res_phase(p, l == 0 ? p.x : p.out, WSB(p, hidden), DFF, WSW(p, W_down1, l), modl + 2 * DM, 0.5f, lds);
    xcd_barrier_ws(p.ws, lds);
    norm_phase(p, p.out, p.norm_mix + l * DM, modl + 3 * DM, modl + 4 * DM);
    xcd_barrier_ws(p.ws, lds);
    gemm_in_phase(p, WSW(p, W_in, l), lds);
    xcd_barrier_ws(p.ws, lds);
    {
      char* vl = vlds(lds);
      for (int it = opaque_bid(); it < 2048 + 512; it += VGRID) {
        if (it < 2048) dn_f1_item(p, l, it, vl); else attn_item(p, l, it - 2048, vl);
      }
    }
    xcd_barrier_ws(p.ws, lds);
    {
      char* vl = vlds(lds);
      const int vb = opaque_bid();
      if (vb < 256) dn_f2_item(p, vb, vl);
      else {
        for (int it = 512 + vb - 256; it < 1536; it += VGRID - 256) attn_item(p, l, it, vl);
        if (l + 1 < DEPTH) convert_layer(p, l + 1, vl, vb - 256, VGRID - 256);
      }
    }
    xcd_barrier_ws(p.ws, lds);
    elem_phase(p, l);
    xcd_barrier_ws(p.ws, lds);
    gemm_proj_phase(p, WSW(p, W_pa, l), WSW(p, W_pd, l), lds);
    xcd_barrier_ws(p.ws, lds);
    gemm_res_phase(p, p.out, WSB(p, mrg), DM, WSW(p, W_out, l), modl + 5 * DM, 1.0f, lds);
    xcd_barrier_ws(p.ws, lds);
    norm_phase(p, p.out, p.norm_ff2 + l * DM, modl + 6 * DM, modl + 7 * DM);
    xcd_barrier_ws(p.ws, lds);
    gemm_up_phase(p, WSW(p, W_up2, l), lds);
    xcd_barrier_ws(p.ws, lds);
    gemm_res_phase(p, p.out, WSB(p, hidden), DFF, WSW(p, W_down2, l), modl + 8 * DM, 0.5f, lds);
    xcd_barrier_ws(p.ws, lds);
  }
}

extern "C" void kernel_launch(void* const* d_in, const int* in_sizes, int n_in, void* d_out, int out_size, void* d_ws, size_t ws_size, hipStream_t stream) {
  static int grid_blocks = 0;
  if (!grid_blocks) {
    int dev = 0, cus = 0, per_cu = 0;
    hipGetDevice(&dev);
    hipDeviceGetAttribute(&cus, hipDeviceAttributeMultiprocessorCount, dev);
    hipOccupancyMaxActiveBlocksPerMultiprocessor(&per_cu, fwd_megakernel, 512, 0);
    if (per_cu > 1) per_cu = 1;
    grid_blocks = cus * per_cu;
    if (grid_blocks % 8) grid_blocks -= grid_blocks % 8;
  }
  Params p{};
  const float* const* in = (const float* const*)d_in;
  p.x = in[0]; p.c = in[1]; p.ada_w = in[2]; p.ada_b = in[3]; p.norm_ff1 = in[4]; p.w_up1 = in[5]; p.w_down1 = in[6]; p.norm_mix = in[7];
  p.w_in = in[8]; p.q_norm = in[9]; p.k_norm = in[10]; p.conv_w = in[11]; p.a_log = in[12]; p.dt_bias = in[13]; p.dn_norm = in[14];
  p.w_pa = in[15]; p.w_pd = in[16]; p.w_out = in[17]; p.norm_ff2 = in[18]; p.w_up2 = in[19]; p.w_down2 = in[20];
  p.out = (float*)d_out;
  p.ws = (char*)d_ws;
  if (WS_TOTAL > ws_size) { fprintf(stderr, "kernel_launch: workspace too small (%zu needed, %zu given)\n", (size_t)WS_TOTAL, ws_size); return; }
  if (hipMemsetAsync(p.ws + O_bar, 0, (size_t)3456 * 4, stream) != hipSuccess) fprintf(stderr, "kernel_launch: barrier memset failed\n");
  void* args[] = {&p};
  hipError_t e = hipLaunchCooperativeKernel((void*)fwd_megakernel, dim3(grid_blocks), dim3(512), args, 0, stream);
  if (e != hipSuccess) fprintf(stderr, "cooperative launch failed: %s (grid %d)\n", hipGetErrorString(e), grid_blocks);
}
```

```cpp
#include <hip/hip_runtime.h>
#include <hip/hip_cooperative_groups.h>
#include <cstdio>
#include <cstdint>
namespace cg = cooperative_groups;

typedef unsigned short bf16_t;
typedef short bf16x8 __attribute__((ext_vector_type(8)));
typedef short s16x4 __attribute__((ext_vector_type(4)));
typedef float f32x4 __attribute__((ext_vector_type(4)));
typedef float f32x16 __attribute__((ext_vector_type(16)));
typedef unsigned u32x4 __attribute__((ext_vector_type(4)));
typedef unsigned u32x2 __attribute__((ext_vector_type(2)));

#define DI __device__ __forceinline__
#define MFMA16(a, b, c) __builtin_amdgcn_mfma_f32_16x16x32_bf16((a), (b), (c), 0, 0, 0)
#define MFMA32(a, b, c) __builtin_amdgcn_mfma_f32_32x32x16_bf16((a), (b), (c), 0, 0, 0)

constexpr int DM = 1024, NB = 8, SEQ = 2048, MTOK = NB * SEQ, DFF = 2816, DEPTH = 4;
constexpr int ZLD = 3072;
constexpr int NINP = 8704;
constexpr int Z_DNGATE = 0, Z_MERGE = 1024;
constexpr int LDS_BYTES = 147456;
constexpr int VLDS = 73728;
constexpr int LROW = 144;
constexpr int TILE_BYTES = 256 * LROW;
constexpr int STAGE_BYTES = 2 * TILE_BYTES;
constexpr float EPS = 1e-6f;

struct Params {
  const float *x, *c, *ada_w, *ada_b, *norm_ff1, *w_up1, *w_down1, *norm_mix, *w_in, *q_norm, *k_norm, *conv_w, *a_log, *dt_bias,
      *dn_norm, *w_pa, *w_pd, *w_out, *norm_ff2, *w_up2, *w_down2;
  float* out;
  char* ws;
};
constexpr size_t al256(size_t b) { return (b + 255) & ~(size_t)255; }
constexpr size_t O_W_up1 = 0;
constexpr size_t O_W_down1 = O_W_up1 + al256((size_t)2 * DFF * DM * 2);
constexpr size_t O_W_in = O_W_down1 + al256((size_t)DM * DFF * 2);
constexpr size_t O_W_pa = O_W_in + al256((size_t)NINP * DM * 2);
constexpr size_t O_W_pd = O_W_pa + al256((size_t)DM * 256 * 2);
constexpr size_t O_W_out = O_W_pd + al256((size_t)DM * DM * 2);
constexpr size_t O_W_up2 = O_W_out + al256((size_t)DM * DM * 2);
constexpr size_t O_W_down2 = O_W_up2 + al256((size_t)2 * DFF * DM * 2);
constexpr size_t WSET_BYTES = O_W_down2 + al256((size_t)DM * DFF * 2);
constexpr size_t O_h = 2 * WSET_BYTES;
constexpr size_t O_z = O_h + al256((size_t)MTOK * DM * 2);
constexpr size_t O_zatt = O_z + al256((size_t)MTOK * ZLD * 2);
constexpr size_t O_zdn = O_zatt + al256((size_t)MTOK * 2304 * 2);
constexpr size_t O_hidden = O_zatt;
constexpr size_t O_og = O_zdn + al256((size_t)MTOK * 3072 * 2);
constexpr size_t O_yatt = O_og + al256((size_t)MTOK * 768 * 2);
constexpr size_t O_dW = O_yatt + al256((size_t)MTOK * 256 * 2);
constexpr size_t O_dUT = O_dW + al256((size_t)MTOK * DM * 2);
constexpr size_t O_mrg = O_dUT;
constexpr size_t O_dQD = O_dUT + al256((size_t)MTOK * DM * 2);
constexpr size_t O_dKDT = O_dQD + al256((size_t)MTOK * DM * 2);
constexpr size_t O_dAI = O_dKDT + al256((size_t)MTOK * DM * 2);
constexpr size_t O_oraw = O_dAI + al256((size_t)2048 * 4096 * 2);
constexpr size_t O_odn = O_dW;
constexpr size_t O_ab = O_oraw + al256((size_t)MTOK * DM * 2);
constexpr size_t O_mod = O_ab + al256((size_t)MTOK * 16 * 4);
constexpr size_t O_lse = O_mod + al256((size_t)DEPTH * 8 * 9216 * 4);
constexpr size_t O_dGL = O_lse + al256((size_t)MTOK * 12 * 4);
constexpr size_t O_bar = O_dGL + al256((size_t)2048 * 4);
constexpr size_t WS_TOTAL = O_bar + al256((size_t)3456 * 4);
#define WSB(p, name) ((bf16_t*)((p).ws + O_##name))
#define WSW(p, name, l_) ((bf16_t*)((p).ws + O_##name + (size_t)((l_) & 1) * WSET_BYTES))
#define WSF(p, name) ((float*)((p).ws + O_##name))

DI int opaque_tid() { int t = threadIdx.x; asm volatile("" : "+v"(t)); return t & 255; }
DI int real_tid() { int t = threadIdx.x; asm volatile("" : "+v"(t)); return t; }
DI int opaque_bid() { int h = threadIdx.x; asm volatile("" : "+v"(h)); int t = blockIdx.x; asm volatile("" : "+s"(t)); return t * 2 + __builtin_amdgcn_readfirstlane(h >> 8); }
DI int real_bid() { int t = blockIdx.x; asm volatile("" : "+s"(t)); return t; }
#define VGRID ((int)gridDim.x * 2)
DI char* vlds(char* lds) { unsigned t = threadIdx.x; asm volatile("" : "+v"(t)); unsigned off = (t >> 8) * VLDS; asm volatile("" : "+v"(off)); return lds + off; }
typedef float f32x2 __attribute__((ext_vector_type(2)));
typedef __bf16 hwbf16x2 __attribute__((ext_vector_type(2)));
DI unsigned pk2(float lo, float hi) { const f32x2 v = {lo, hi}; return __builtin_bit_cast(unsigned, __builtin_convertvector(v, hwbf16x2)); }
DI unsigned short f2bf(float x) { return (unsigned short)(pk2(x, 0.f) & 0xffffu); }
DI float bf2f(unsigned short v) { return __uint_as_float(((unsigned)v) << 16); }
DI float bflo(unsigned u) { return __uint_as_float(u << 16); }
DI float bfhi(unsigned u) { return __uint_as_float(u & 0xffff0000u); }
DI float shx(float v, int mask, int lane) { return __int_as_float(__builtin_amdgcn_ds_bpermute((lane ^ mask) << 2, __float_as_int(v))); }
DI float shup(float v, int off, int lane) { return __int_as_float(__builtin_amdgcn_ds_bpermute((lane - off) << 2, __float_as_int(v))); }
DI float sigmoidf_(float x) { return __builtin_amdgcn_rcpf(1.f + __expf(-x)); }
DI float siluf_(float x) { return x * __builtin_amdgcn_rcpf(1.f + __expf(-x)); }
DI void unpack8(const u32x4& r, float (&v)[8]) {
  v[0] = bflo(r[0]); v[1] = bfhi(r[0]); v[2] = bflo(r[1]); v[3] = bfhi(r[1]);
  v[4] = bflo(r[2]); v[5] = bfhi(r[2]); v[6] = bflo(r[3]); v[7] = bfhi(r[3]);
}
DI u32x4 pack8(const float (&v)[8]) { u32x4 r; r[0] = pk2(v[0], v[1]); r[1] = pk2(v[2], v[3]); r[2] = pk2(v[4], v[5]); r[3] = pk2(v[6], v[7]); return r; }

template <int MH> DI void gemm_core_simple(const bf16_t* __restrict__ A, int lda, const bf16_t* __restrict__ Bt, int ldb, int K, f32x4 (&acc)[MH][4], char* lds) {
  const int tid = real_tid(), lane = tid & 63, wid = tid >> 6, wr = wid >> 2, wc = wid & 3, fr = lane & 15, fq = lane >> 4;
  const int sl = lane ^ ((lane >> 5) << 1);
  const int R0 = (wid >> 1) * 16 + (sl >> 2), C0 = (wid & 1) * 32 + (sl & 3) * 8;
  const bf16_t* gA = A + (size_t)R0 * lda + C0;
  const bf16_t* gB = Bt + (size_t)R0 * ldb + C0;
  const size_t sA = (size_t)64 * lda, sB = (size_t)64 * ldb;
  unsigned st_off = (unsigned)tid * 16u;
  const unsigned rd_off = (unsigned)((fr * 64 + fq * 16) ^ ((fr >> 3) << 5));
  unsigned rd_a = (unsigned)(wr * (MH * 2048)) + rd_off;
  unsigned rd_b = 32768u + (unsigned)(wc * 4096) + rd_off;
  asm volatile("" : "+v"(st_off), "+v"(rd_a), "+v"(rd_b));
  const int nk = K >> 6;
#define GSTAGE(sbase_, k0_)                                                                                                        \
  {                                                                                                                                \
    _Pragma("unroll") for (int j = 0; j < 4; ++j) {                                                                                \
      if (j < MH / 2) __builtin_amdgcn_global_load_lds((const unsigned*)(gA + j * sA + (k0_)), (unsigned*)(lds + ((sbase_) + j * 8192 + st_off)), 16, 0, 0);          \
      __builtin_amdgcn_global_load_lds((const unsigned*)(gB + j * sB + (k0_)), (unsigned*)(lds + ((sbase_) + 32768 + j * 8192 + st_off)), 16, 0, 0);  \
    }                                                                                                                              \
  }
  GSTAGE(0u, 0);
  asm volatile("s_waitcnt vmcnt(0)" ::: "memory");
  __syncthreads();
#pragma unroll 1
  for (int kt = 0; kt < nk; ++kt) {
    const unsigned sbase = (unsigned)(kt & 1) << 16;
    if (kt + 1 < nk) GSTAGE(65536u - sbase, (kt + 1) * 64);
    const char* pa = lds + (rd_a + sbase);
    const char* pb = lds + (rd_b + sbase);
    bf16x8 af[2 * MH], b0[4], b1[4];
    constexpr int B1S = MH >= 5 ? MH - 5 : 0;
#define RDA(g_) af[g_] = *(const bf16x8*)(pa + ((g_) % MH) * 2048 + ((g_) / MH) * 1024)
#define RDB(ks_, n_) *(const bf16x8*)(pb + ((n_) >> 1) * 16384 + ((n_) & 1) * 2048 + (ks_) * 1024)
    b0[0] = RDB(0, 0); b0[1] = RDB(0, 1); b0[2] = RDB(0, 2); b0[3] = RDB(0, 3);
    RDA(0); RDA(1); RDA(2);
    __builtin_amdgcn_sched_barrier(0);
#pragma unroll
    for (int g = 0; g < 2 * MH; ++g) {
      if (g + 3 < 2 * MH) RDA(g + 3);
      if (g >= B1S && g < B1S + 4) b1[g - B1S] = RDB(1, g - B1S);
      __builtin_amdgcn_sched_barrier(0);
      if (g < MH) {
#pragma unroll
        for (int n = 0; n < 4; ++n) acc[g % MH][n] = MFMA16(b0[n], af[g], acc[g % MH][n]);
      } else {
#pragma unroll
        for (int n = 0; n < 4; ++n) acc[g % MH][n] = MFMA16(b1[n], af[g], acc[g % MH][n]);
      }
      __builtin_amdgcn_sched_barrier(0);
    }
#undef RDA
#undef RDB
    asm volatile("s_waitcnt vmcnt(0)" ::: "memory");
    __syncthreads();
  }
#undef GSTAGE
}

DI void gemm_core(const bf16_t* __restrict__ A, int lda, const bf16_t* __restrict__ Bt, int ldb, int K, f32x4 (&acc)[8][4], char* lds) {
  const int tid = real_tid(), lane = tid & 63, wid = tid >> 6, wr = wid >> 2, wc = wid & 3, fr = lane & 15, fq = lane >> 4;
  const int sl = lane ^ ((lane >> 5) << 1);
  const int R0 = (wid >> 1) * 16 + (sl >> 2), C0 = (wid & 1) * 32 + (sl & 3) * 8;
  const bf16_t* gA = A + (size_t)R0 * lda + C0;
  const bf16_t* gB = Bt + (size_t)R0 * ldb + C0;
  const size_t sA = (size_t)64 * lda, sB = (size_t)64 * ldb;
  const unsigned rd_off = (unsigned)((fr * 64 + fq * 16) ^ ((fr >> 3) << 5));
  unsigned st0 = (unsigned)tid * 16u, st1 = st0 + 65536u;
  unsigned ra0 = (unsigned)(wr * 8192) + rd_off, ra1 = ra0 + 65536u;
  unsigned rb0 = 32768u + (unsigned)(wc * 4096) + rd_off, rb1 = rb0 + 65536u;
  asm volatile("" : "+v"(st0), "+v"(st1), "+v"(ra0), "+v"(ra1), "+v"(rb0), "+v"(rb1));
  const int nt = K >> 6;
  bf16x8 At[4][2], B0[2][2], B1[2][2];
#define STG_A(b_, h_, kt_) { const bf16_t* g_ = gA + (size_t)((h_) * 128) * lda + (size_t)(kt_) * 64; char* d_ = lds + (((b_) ? st1 : st0) + (h_) * 16384); \
    __builtin_amdgcn_global_load_lds((const unsigned*)g_, (unsigned*)d_, 16, 0, 0); __builtin_amdgcn_global_load_lds((const unsigned*)(g_ + sA), (unsigned*)(d_ + 8192), 16, 0, 0); }
#define STG_B(b_, h_, kt_) { const bf16_t* g_ = gB + (size_t)((h_) * 128) * ldb + (size_t)(kt_) * 64; char* d_ = lds + (((b_) ? st1 : st0) + 32768 + (h_) * 16384); \
    __builtin_amdgcn_global_load_lds((const unsigned*)g_, (unsigned*)d_, 16, 0, 0); __builtin_amdgcn_global_load_lds((const unsigned*)(g_ + sB), (unsigned*)(d_ + 8192), 16, 0, 0); }
#define LDA(b_, h_) { const char* s_ = lds + (((b_) ? ra1 : ra0) + (h_) * 16384); \
    _Pragma("unroll") for (int m = 0; m < 4; ++m) _Pragma("unroll") for (int k = 0; k < 2; ++k) At[m][k] = *(const bf16x8*)(s_ + m * 2048 + k * 1024); }
#define LDB(dst_, b_, h_) { const char* s_ = lds + (((b_) ? rb1 : rb0) + (h_) * 16384); \
    _Pragma("unroll") for (int n = 0; n < 2; ++n) _Pragma("unroll") for (int k = 0; k < 2; ++k) dst_[n][k] = *(const bf16x8*)(s_ + n * 2048 + k * 1024); }
#define MMA(ai_, bj_, Bx_) { __builtin_amdgcn_s_setprio(1); \
    _Pragma("unroll") for (int m = 0; m < 4; ++m) _Pragma("unroll") for (int n = 0; n < 2; ++n) _Pragma("unroll") for (int k = 0; k < 2; ++k) \
      acc[(ai_) * 4 + m][(bj_) * 2 + n] = MFMA16(Bx_[n][k], At[m][k], acc[(ai_) * 4 + m][(bj_) * 2 + n]); \
    __builtin_amdgcn_s_setprio(0); }
#define WAIT_V(n_) asm volatile("s_waitcnt vmcnt(" #n_ ")" ::: "memory")
#define WAIT_L(n_) asm volatile("s_waitcnt lgkmcnt(" #n_ ")" ::: "memory")
#define BAR __builtin_amdgcn_s_barrier()
#define SCHED __builtin_amdgcn_sched_barrier(0)
  WAIT_V(0);
  STG_B(0, 0, 0); STG_A(0, 0, 0); STG_B(0, 1, 0); STG_A(0, 1, 0);
  if (wr == 1) BAR;
  WAIT_V(4); BAR;
  STG_B(1, 0, 1); STG_A(1, 0, 1); STG_B(1, 1, 1);
  WAIT_V(6); BAR;
#pragma unroll 1
  for (int t = 0; t < nt - 2; t += 2) {
    LDB(B0, 0, 0); SCHED; LDA(0, 0); STG_A(1, 1, t + 1);
    WAIT_L(8); BAR; WAIT_L(0); MMA(0, 0, B0); BAR; SCHED;
    LDB(B1, 0, 1); STG_B(0, 0, t + 2);
    BAR; WAIT_L(0); MMA(0, 1, B1); BAR;
    LDA(0, 1); STG_A(0, 0, t + 2);
    BAR; WAIT_L(0); MMA(1, 0, B0); BAR; SCHED;
    STG_B(0, 1, t + 2);
    WAIT_V(6); BAR; MMA(1, 1, B1); BAR;
    LDB(B0, 1, 0); SCHED; LDA(1, 0); STG_A(0, 1, t + 2);
    WAIT_L(8); BAR; WAIT_L(0); MMA(0, 0, B0); BAR; SCHED;
    LDB(B1, 1, 1); STG_B(1, 0, t + 3);
    BAR; WAIT_L(0); MMA(0, 1, B1); BAR;
    LDA(1, 1); STG_A(1, 0, t + 3);
    BAR; WAIT_L(0); MMA(1, 0, B0); BAR; SCHED;
    STG_B(1, 1, t + 3);
    WAIT_V(6); BAR; MMA(1, 1, B1); BAR;
  }
  { LDB(B0, 0, 0); LDA(0, 0); STG_A(1, 1, nt - 1);
    BAR; WAIT_L(0); MMA(0, 0, B0); BAR;
    LDB(B1, 0, 1); BAR; WAIT_L(0); MMA(0, 1, B1); BAR;
    LDA(0, 1); WAIT_V(4); BAR; WAIT_L(0); MMA(1, 0, B0); MMA(1, 1, B1); BAR; }
  { LDB(B0, 1, 0); LDA(1, 0); WAIT_V(2); BAR; WAIT_L(0); MMA(0, 0, B0); BAR;
    LDB(B1, 1, 1); WAIT_V(0); BAR; WAIT_L(0); MMA(0, 1, B1); BAR;
    LDA(1, 1); BAR; WAIT_L(0); MMA(1, 0, B0); MMA(1, 1, B1); BAR; }
  if (wr == 0) BAR;
#undef STG_A
#undef STG_B
#undef LDA
#undef LDB
#undef MMA
#undef WAIT_V
#undef WAIT_L
#undef BAR
#undef SCHED
}

DI void tile_decode(int t, int& mt, int& nt) {
  const int xcd = t & 7, local = t >> 3;
  mt = 8 * xcd + (local & 7); nt = local >> 3;
}
template <int MH> DI void zero_acc(f32x4 (&acc)[MH][4]) {
#pragma unroll
  for (int m = 0; m < MH; ++m)
#pragma unroll
    for (int n = 0; n < 4; ++n) acc[m][n] = (f32x4){0.f, 0.f, 0.f, 0.f};
}
#define GEMM_IDS const int tid = real_tid(), lane = tid & 63, wid = tid >> 6, wr = wid >> 2, wc = wid & 3, fr = lane & 15, fq = lane >> 4
#define GEMM_IDS_AGAIN const int tid = real_tid(), lane = tid & 63, wid = tid >> 6, wr = wid >> 2, wc = wid & 3, fr = lane & 15, fq = lane >> 4; (void)lane; (void)wr; (void)wc
#define EROW(m) ((size_t)mt * 256 + ((m) >> 2) * 128 + wr * 64 + ((m) & 3) * 16 + fr)
#define ECOL8(bj) (nt * 256 + (bj) * 128 + wc * 32 + fq * 8)

template <int MH> DI void up_epilogue(const Params& p, const f32x4 (&acc)[MH][4], int mt, int half, int nt, int wr, int wc, int fr, int fq) {
#pragma unroll
  for (int m = 0; m < MH; ++m) {
    const size_t row = (size_t)mt * 256 + (MH == 8 ? (m >> 2) : half) * 128 + wr * 64 + (m & 3) * 16 + fr;
    const int hc = nt * 128 + wc * 32 + fq * 8;
    float o[8];
#pragma unroll
    for (int n = 0; n < 2; ++n)
#pragma unroll
      for (int j = 0; j < 4; ++j) { const float g = acc[m][n][j], u = acc[m][n + 2][j]; o[4 * n + j] = siluf_(g) * u; }
    *(u32x4*)(WSB(p, hidden) + row * DFF + hc) = pack8(o);
  }
}
DI void tail_decode(int bid, int nfull, int& mt, int& nt, int& half) { tile_decode(nfull + ((bid >> 4) << 3) + (bid & 7), mt, nt); half = (bid >> 3) & 1; }

DI void gemm_up_phase(const Params& p, const bf16_t* Bt, char* lds) {
  GEMM_IDS; (void)lane;
  constexpr int NT = 22, NFULL = (64 * NT / 256) * 256;
  for (int t = real_bid(); t < 64 * NT; t += gridDim.x) {
    int mt, nt; tile_decode(t, mt, nt);
    f32x4 acc[8][4]; zero_acc(acc);
    gemm_core(WSB(p, h) + (size_t)mt * 256 * DM, DM, Bt + (size_t)nt * 256 * DM, DM, DM, acc, lds);
    GEMM_IDS_AGAIN;
    up_epilogue<8>(p, acc, mt, 0, nt, wr, wc, fr, fq);
  }
}

DI void gemm_res_phase(const Params& p, const float* xin, const bf16_t* A, int K, const bf16_t* Bt, const float* gate, float coef, char* lds) {
  GEMM_IDS; (void)lane;
  constexpr int NT = 4;
  for (int t = real_bid(); t < 64 * NT; t += gridDim.x) {
    int mt, nt; tile_decode(t, mt, nt);
    f32x4 acc[8][4]; zero_acc(acc);
    gemm_core(A + (size_t)mt * 256 * K, K, Bt + (size_t)nt * 256 * K, K, K, acc, lds);
    GEMM_IDS_AGAIN;
    const int b = mt >> 3;
#pragma unroll
    for (int bj = 0; bj < 2; ++bj) {
      const int col = ECOL8(bj);
      const f32x4 g0 = *(const f32x4*)(gate + (size_t)b * 9216 + col), g1 = *(const f32x4*)(gate + (size_t)b * 9216 + col + 4);
#pragma unroll
      for (int m = 0; m < 8; ++m) {
        const size_t xo = EROW(m) * DM + col;
        f32x4 x0 = *(const f32x4*)(xin + xo), x1 = *(const f32x4*)(xin + xo + 4);
        x0 = x0 + (g0 * acc[m][2 * bj]) * coef; x1 = x1 + (g1 * acc[m][2 * bj + 1]) * coef;
        *(f32x4*)(p.out + xo) = x0; *(f32x4*)(p.out + xo + 4) = x1;
        if (m & 1) __builtin_amdgcn_sched_barrier(0);
      }
    }
  }
}

template <int MH> DI void in_epilogue(const Params& p, const f32x4 (&acc)[MH][4], int mt, int half, int nt, int wr, int wc, int fr, int fq) {
#define IN_ROW(m) ((size_t)mt * 256 + (MH == 8 ? ((m) >> 2) : half) * 128 + wr * 64 + ((m) & 3) * 16 + fr)
#define IN_PK(m, bj) ((u32x4){pk2(acc[m][2 * (bj)][0], acc[m][2 * (bj)][1]), pk2(acc[m][2 * (bj)][2], acc[m][2 * (bj)][3]), pk2(acc[m][2 * (bj) + 1][0], acc[m][2 * (bj) + 1][1]), pk2(acc[m][2 * (bj) + 1][2], acc[m][2 * (bj) + 1][3])})
  if (nt < 9) {
#pragma unroll
    for (int bj = 0; bj < 2; ++bj) {
      const int col = ECOL8(bj), sq = col / 768, rem = col - sq * 768, g = rem >> 8, hh = (rem >> 6) & 3, dd = rem & 63;
      const int sh = (g == 0) ? 0 : (g == 1 ? 2 : 4);
#pragma unroll
      for (int m = 0; m < MH; ++m) {
        const size_t row = IN_ROW(m);
        const int b = (int)(row >> 11), t = (int)(row & 2047);
        const int ridx = ((t & ((1 << sh) - 1)) << (11 - sh)) + (t >> sh);
        *(u32x4*)(WSB(p, zatt) + ((size_t)((((b * 3 + sq) * 3 + g) * 4 + hh) * 2048 + ridx)) * 64 + dd) = IN_PK(m, bj);
      }
    }
  } else if (nt < 21) {
#pragma unroll
    for (int bj = 0; bj < 2; ++bj) {
      const int c = ECOL8(bj) - 2304, seg = c >> 10, hd = (c >> 7) & 7, cc = c & 127;
#pragma unroll
      for (int m = 0; m < MH; ++m) {
        const size_t row = IN_ROW(m);
        const int b = (int)(row >> 11), t = (int)(row & 2047);
        *(u32x4*)(WSB(p, zdn) + ((size_t)(((b * 8 + hd) * 3 + seg) * 2048 + t)) * 128 + cc) = IN_PK(m, bj);
      }
    }
  } else if (nt < 33) {
#pragma unroll
    for (int m = 0; m < MH; ++m) {
      const size_t row = IN_ROW(m);
#pragma unroll
      for (int bj = 0; bj < 2; ++bj) *(u32x4*)(WSB(p, z) + row * ZLD + (ECOL8(bj) - 5376)) = IN_PK(m, bj);
    }
  } else if (wc == 0 && fq < 2) {
#pragma unroll
    for (int m = 0; m < MH; ++m) {
      float* ap = WSF(p, ab) + IN_ROW(m) * 16 + fq * 8;
      *(f32x4*)ap = acc[m][0]; *(f32x4*)(ap + 4) = acc[m][1];
    }
  }
#undef IN_ROW
#undef IN_PK
}
DI void gemm_in_phase(const Params& p, const bf16_t* Win, char* lds) {
  GEMM_IDS; (void)lane;
  constexpr int NT = 34, NFULL = (64 * NT / 256) * 256;
  for (int t = real_bid(); t < 64 * NT; t += gridDim.x) {
    int mt, nt; tile_decode(t, mt, nt);
    f32x4 acc[8][4]; zero_acc(acc);
    gemm_core(WSB(p, h) + (size_t)mt * 256 * DM, DM, Win + (size_t)nt * 256 * DM, DM, DM, acc, lds);
    GEMM_IDS_AGAIN;
    in_epilogue<8>(p, acc, mt, 0, nt, wr, wc, fr, fq);
  }
}

DI void gemm_proj_phase(const Params& p, const bf16_t* Wpa, const bf16_t* Wpd, char* lds) {
  GEMM_IDS; (void)lane;
  constexpr int NT = 4;
  for (int t = real_bid(); t < 64 * NT; t += gridDim.x) {
    int mt, nt; tile_decode(t, mt, nt);
    f32x4 acc[8][4]; zero_acc(acc);
    gemm_core(WSB(p, yatt) + (size_t)mt * 256 * 256, 256, Wpa + (size_t)nt * 256 * 256, 256, 256, acc, lds);
    GEMM_IDS_AGAIN;
#pragma unroll
    for (int m = 0; m < 8; ++m) {
      const size_t row = EROW(m);
#pragma unroll
      for (int bj = 0; bj < 2; ++bj) {
        const int col = ECOL8(bj);
        const u32x4 gz = *(const u32x4*)(WSB(p, z) + row * ZLD + Z_MERGE + col);
        float gt[8], o[8]; unpack8(gz, gt);
#pragma unroll
        for (int e = 0; e < 8; ++e) o[e] = sigmoidf_(gt[e]) * acc[m][2 * bj + (e >> 2)][e & 3];
        *(u32x4*)(WSB(p, mrg) + row * DM + col) = pack8(o);
      }
      __builtin_amdgcn_sched_barrier(0);
    }
  }
  for (int t = real_bid(); t < 64 * NT; t += gridDim.x) {
    int mt, nt; tile_decode(t, mt, nt);
    f32x4 acc[8][4]; zero_acc(acc);
    gemm_core(WSB(p, odn) + (size_t)mt * 256 * DM, DM, Wpd + (size_t)nt * 256 * DM, DM, DM, acc, lds);
    GEMM_IDS_AGAIN;
#pragma unroll
    for (int m = 0; m < 8; ++m) {
      const size_t row = EROW(m);
#pragma unroll
      for (int bj = 0; bj < 2; ++bj) {
        const int col = ECOL8(bj);
        const u32x4 gz = *(const u32x4*)(WSB(p, z) + row * ZLD + Z_MERGE + DM + col);
        const u32x4 pv = *(const u32x4*)(WSB(p, mrg) + row * DM + col);
        float gt[8], pr[8], o[8]; unpack8(gz, gt); unpack8(pv, pr);
#pragma unroll
        for (int e = 0; e < 8; ++e) o[e] = pr[e] + sigmoidf_(gt[e]) * acc[m][2 * bj + (e >> 2)][e & 3];
        *(u32x4*)(WSB(p, mrg) + row * DM + col) = pack8(o);
      }
      __builtin_amdgcn_sched_barrier(0);
    }
  }
}

DI void convert_matrix(const float* __restrict__ src, int ldsrc, bf16_t* __restrict__ dst, int K, int ncoltiles, int kind, char* lds, int start, int stride) {
  float* tl = (float*)lds;
  const int tid = opaque_tid();
  const int nkt = K >> 6;
  const int nitems = ncoltiles * nkt;
  for (int it = start; it < nitems; it += stride) {
    const int ct = it / nkt, kt = it - ct * nkt;
    int srccol0 = ct * 64, nvalid = 64;
    if (kind == 1) { const int T = ct >> 2, q = ct & 3; srccol0 = (q >> 1) * DFF + T * 128 + (q & 1) * 64; }
    else if (kind == 2) {
      if (ct < 100) srccol0 = ct * 64;
      else if (ct < 132) srccol0 = 6416 + (ct - 100) * 64;
      else if (ct == 132) { srccol0 = 6400; nvalid = 16; }
      else { srccol0 = 0; nvalid = 0; }
    }
    const int r = tid >> 4, c4 = (tid & 15) * 4;
#pragma unroll
    for (int ps = 0; ps < 4; ++ps) {
      const int kk = r + 16 * ps;
      f32x4 v = (f32x4){0.f, 0.f, 0.f, 0.f};
      if (c4 < nvalid) v = *(const f32x4*)(src + (size_t)(kt * 64 + kk) * ldsrc + srccol0 + c4);
      tl[kk * 65 + c4 + 0] = v[0]; tl[kk * 65 + c4 + 1] = v[1]; tl[kk * 65 + c4 + 2] = v[2]; tl[kk * 65 + c4 + 3] = v[3];
    }
    __syncthreads();
#pragma unroll
    for (int ps = 0; ps < 2; ++ps) {
      const int n = (tid >> 3) + 32 * ps, k8 = (tid & 7) * 8;
      float v[8];
      const int nl = (n & 32) + 8 * ((n & 15) >> 2) + 4 * ((n >> 4) & 1) + (n & 3);
#pragma unroll
      for (int e = 0; e < 8; ++e) v[e] = tl[(k8 + e) * 65 + nl];
      *(u32x4*)(dst + (size_t)(ct * 64 + n) * K + kt * 64 + k8) = pack8(v);
    }
    __syncthreads();
  }
}

DI void convert_layer(const Params& p, int l, char* lds, int start, int stride) {
  convert_matrix(p.w_up1 + (size_t)l * DM * 2 * DFF, 2 * DFF, WSW(p, W_up1, l), DM, 88, 1, lds, start, stride);
  convert_matrix(p.w_down1 + (size_t)l * DFF * DM, DM, WSW(p, W_down1, l), DFF, 16, 0, lds, start, stride);
  convert_matrix(p.w_in + (size_t)l * DM * 8464, 8464, WSW(p, W_in, l), DM, 136, 2, lds, start, stride);
  convert_matrix(p.w_pa + (size_t)l * 256 * DM, DM, WSW(p, W_pa, l), 256, 16, 0, lds, start, stride);
  convert_matrix(p.w_pd + (size_t)l * DM * DM, DM, WSW(p, W_pd, l), DM, 16, 0, lds, start, stride);
  convert_matrix(p.w_out + (size_t)l * DM * DM, DM, WSW(p, W_out, l), DM, 16, 0, lds, start, stride);
  convert_matrix(p.w_up2 + (size_t)l * DM * 2 * DFF, 2 * DFF, WSW(p, W_up2, l), DM, 88, 1, lds, start, stride);
  convert_matrix(p.w_down2 + (size_t)l * DFF * DM, DM, WSW(p, W_down2, l), DFF, 16, 0, lds, start, stride);
}

DI void norm_phase(const Params& p, const float* xin, const float* g, const float* shift, const float* scale  ) {
  const int tid = opaque_tid(), lane = tid & 63, wid = tid >> 6;
  const int nw = VGRID * 4;
  for (int row = opaque_bid() * 4 + wid; row < MTOK; row += nw) {
    const int b = row >> 11;
    const float* xp = xin + (size_t)row * DM;
    f32x4 v[2][2]; float ss = 0.f;
#pragma unroll
    for (int i = 0; i < 2; ++i)
#pragma unroll
      for (int hq = 0; hq < 2; ++hq) {
        v[i][hq] = *(const f32x4*)(xp + i * 512 + lane * 8 + hq * 4);
        ss += v[i][hq][0] * v[i][hq][0] + v[i][hq][1] * v[i][hq][1] + v[i][hq][2] * v[i][hq][2] + v[i][hq][3] * v[i][hq][3];
      }
#pragma unroll
    for (int o = 1; o < 64; o <<= 1) ss += shx(ss, o, lane);
    const float rstd = rsqrtf(ss * (1.f / DM) + EPS);
#pragma unroll
    for (int i = 0; i < 2; ++i) {
      const int col = i * 512 + lane * 8;
      float o[8];
#pragma unroll
      for (int hq = 0; hq < 2; ++hq) {
        const f32x4 gv = *(const f32x4*)(g + col + hq * 4), sc = *(const f32x4*)(scale + (size_t)b * 9216 + col + hq * 4), sh = *(const f32x4*)(shift + (size_t)b * 9216 + col + hq * 4);
#pragma unroll
        for (int j = 0; j < 4; ++j) o[hq * 4 + j] = v[i][hq][j] * rstd * gv[j] * (1.f + sc[j]) + sh[j];
      }
      *(u32x4*)(WSB(p, h) + (size_t)row * DM + col) = pack8(o);
    }
  }
}

DI void phase0(const Params& p, char* lds) {
  float* cact = (float*)lds;
  float* red = (float*)(lds + 32768);
  const int tid = opaque_tid(), lane = tid & 63, wid = tid >> 6;
  for (int i = tid; i < NB * DM; i += 256) cact[i] = siluf_(p.c[i]);
  __syncthreads();
  for (int it = opaque_bid(); it < 576; it += VGRID) {
    const int l = it / 144, cb = it - l * 144;
    float acc[8];
#pragma unroll
    for (int b = 0; b < 8; ++b) acc[b] = 0.f;
    const float* wp = p.ada_w + (size_t)l * DM * 9216 + cb * 64 + lane;
    const int kbeg = wid * 256;
#pragma unroll 1
    for (int k = kbeg; k < kbeg + 256; k += 8) {
      float wv[8];
#pragma unroll
      for (int u = 0; u < 8; ++u) wv[u] = wp[(size_t)(k + u) * 9216];
#pragma unroll
      for (int b = 0; b < 8; ++b) {
        const f32x4 c0 = *(const f32x4*)(cact + b * DM + k), c1 = *(const f32x4*)(cact + b * DM + k + 4);
        acc[b] += c0[0] * wv[0] + c0[1] * wv[1] + c0[2] * wv[2] + c0[3] * wv[3] + c1[0] * wv[4] + c1[1] * wv[5] + c1[2] * wv[6] + c1[3] * wv[7];
      }
    }
#pragma unroll
    for (int b = 0; b < 8; ++b) red[(wid * 8 + b) * 64 + lane] = acc[b];
    __syncthreads();
#pragma unroll
    for (int h2 = 0; h2 < 2; ++h2) {
      const int b = (tid >> 6) + 4 * h2, c = tid & 63;
      const float sum = red[(0 * 8 + b) * 64 + c] + red[(1 * 8 + b) * 64 + c] + red[(2 * 8 + b) * 64 + c] + red[(3 * 8 + b) * 64 + c];
      WSF(p, mod)[((size_t)l * 8 + b) * 9216 + cb * 64 + c] = sum + p.ada_b[(size_t)l * 9216 + cb * 64 + c];
    }
    __syncthreads();
  }
}

DI void attn_item(const Params& p, int l, int item, char* lds) {
  const int tid = opaque_tid(), lane = tid & 63, w = tid >> 6, r = lane & 31, hf = lane >> 5;
  const int blk16 = item & 15, hh = (item >> 4) & 3, rest = item >> 6, g = rest % 3, b = rest / 3;
  const int d = (g == 0) ? 1 : (g == 1 ? 4 : 16);
  const int nbk = 16 / d, res = blk16 / nbk, nb = blk16 - res * nbk;
  const int qcol = g * 256 + hh * 64;
  const int Lsub = 2048 / d;
  const bf16_t* zq = WSB(p, zatt) + ((size_t)((((b * 3 + 0) * 3 + g) * 4 + hh) * 2048 + res * Lsub)) * 64;
  const bf16_t* zk = WSB(p, zatt) + ((size_t)((((b * 3 + 1) * 3 + g) * 4 + hh) * 2048 + res * Lsub)) * 64;
  const bf16_t* zv = WSB(p, zatt) + ((size_t)((((b * 3 + 2) * 3 + g) * 4 + hh) * 2048 + res * Lsub)) * 64;
  bf16_t* VT = (bf16_t*)lds;
  float* nrm = (float*)(lds + 64 * 528);
  if (tid < 128) nrm[tid] = (tid < 64) ? p.q_norm[l * 64 + tid] : p.k_norm[l * 64 + tid - 64];
  const int qi = 32 * w + r;
  const int tq = (128 * nb + qi) * d + res;
  u32x4 vraw[8], qraw[4], kraw[5][4];
  {
    const int lk = 128 * (nb - 1) + tid, lkc = lk < 0 ? 0 : lk;
    const u32x4* src = (const u32x4*)(zv + (size_t)lkc * 64);
#pragma unroll
    for (int i = 0; i < 8; ++i) vraw[i] = src[i];
    const bf16_t* qp = zq + (size_t)(128 * nb + qi) * 64 + 8 * hf;
#pragma unroll
    for (int s = 0; s < 4; ++s) qraw[s] = *(const u32x4*)(qp + 16 * s);
#pragma unroll
    for (int i = 0; i < 2; ++i) {
      const int lkk = 128 * (nb - 1) + 32 * (w + i) + r, lkkc = lkk < 0 ? 0 : lkk;
      const bf16_t* kp = zk + (size_t)lkkc * 64 + 8 * hf;
#pragma unroll
      for (int s = 0; s < 4; ++s) kraw[i][s] = *(const u32x4*)(kp + 16 * s);
    }
  }
  __builtin_amdgcn_sched_barrier(0);
  {
    const int key = tid;
#pragma unroll
    for (int i = 0; i < 8; ++i)
#pragma unroll
      for (int e = 0; e < 4; ++e) {
        constexpr int d0 = 0;
        const int da = 8 * i + 2 * e + d0, db = da + 1;
        VT[(32 * (da >> 5) + 8 * ((da >> 2) & 3) + 4 * ((da >> 4) & 1) + (da & 3)) * 264 + key] = (bf16_t)(vraw[i][e] & 0xffffu);
        VT[(32 * (db >> 5) + 8 * ((db >> 2) & 3) + 4 * ((db >> 4) & 1) + (db & 3)) * 264 + key] = (bf16_t)(vraw[i][e] >> 16);
      }
  }
  __syncthreads();
  bf16x8 qf[4];
  {
    float qv[4][8]; float ss = 0.f;
#pragma unroll
    for (int s = 0; s < 4; ++s) {
      unpack8(qraw[s], qv[s]);
#pragma unroll
      for (int j = 0; j < 8; ++j) ss += qv[s][j] * qv[s][j];
    }
    ss += shx(ss, 32, lane);
    const float rstd = rsqrtf(ss * (1.f / 64.f) + EPS) * 0.125f;
#pragma unroll
    for (int s = 0; s < 4; ++s) {
      const float* gn = nrm + 16 * s + 8 * hf;
      float o[8];
#pragma unroll
      for (int j = 0; j < 8; ++j) o[j] = qv[s][j] * rstd * gn[j];
      qf[s] = __builtin_bit_cast(bf16x8, pack8(o));
    }
  }
  f32x16 st[5];
#pragma unroll
  for (int i = 0; i < 5; ++i) {
    if (i + 2 < 5 && (nb > 0 || w + i + 2 >= 4)) {
      const int lkk = 128 * (nb - 1) + 32 * (w + i + 2) + r, lkkc = lkk < 0 ? 0 : lkk;
      const bf16_t* kp = zk + (size_t)lkkc * 64 + 8 * hf;
#pragma unroll
      for (int s = 0; s < 4; ++s) kraw[i + 2][s] = *(const u32x4*)(kp + 16 * s);
    }
    __builtin_amdgcn_sched_barrier(0);
#pragma unroll
    for (int e = 0; e < 16; ++e) st[i][e] = 0.f;
    if (nb > 0 || w + i >= 4) {
      float kv[4][8]; float ss = 0.f;
#pragma unroll
      for (int s = 0; s < 4; ++s) {
        unpack8(kraw[i][s], kv[s]);
#pragma unroll
        for (int j = 0; j < 8; ++j) ss += kv[s][j] * kv[s][j];
      }
      ss += shx(ss, 32, lane);
      const float rstd = rsqrtf(ss * (1.f / 64.f) + EPS);
#pragma unroll
      for (int s = 0; s < 4; ++s) {
        const float* gn = nrm + 64 + 16 * s + 8 * hf;
        float o[8];
#pragma unroll
        for (int j = 0; j < 8; ++j) o[j] = kv[s][j] * rstd * gn[j];
        const bf16x8 kf = __builtin_bit_cast(bf16x8, pack8(o));
        st[i] = MFMA32(kf, qf[s], st[i]);
      }
    }
  }
  float mx = -3.0e38f;
#pragma unroll
  for (int i = 0; i < 5; ++i)
#pragma unroll
    for (int e = 0; e < 16; ++e) {
      const int c = (e & 3) + 8 * (e >> 2) + 4 * hf;
      const bool valid = (nb > 0 || w + i >= 4) && (i == 0 ? c >= r : (i == 4 ? c <= r : true));
      st[i][e] = valid ? st[i][e] : -3.0e38f;
      mx = fmaxf(mx, st[i][e]);
    }
  mx = fmaxf(mx, shx(mx, 32, lane));
  float den = 0.f;
#pragma unroll
  for (int i = 0; i < 5; ++i)
#pragma unroll
    for (int e = 0; e < 16; ++e) {
      const float pe = (st[i][e] > -1.0e38f) ? __expf(st[i][e] - mx) : 0.f;
      st[i][e] = pe; den += pe;
    }
  den += shx(den, 32, lane);
  f32x16 ot[2];
#pragma unroll
  for (int dt = 0; dt < 2; ++dt)
#pragma unroll
    for (int e = 0; e < 16; ++e) ot[dt][e] = 0.f;
#pragma unroll
  for (int i = 0; i < 5; ++i)
#pragma unroll
    for (int s2 = 0; s2 < 2; ++s2) if (nb > 0 || w + i >= 4) {
      u32x4 pp;
      pp[0] = pk2(st[i][8 * s2 + 0], st[i][8 * s2 + 1]); pp[1] = pk2(st[i][8 * s2 + 2], st[i][8 * s2 + 3]);
      pp[2] = pk2(st[i][8 * s2 + 4], st[i][8 * s2 + 5]); pp[3] = pk2(st[i][8 * s2 + 6], st[i][8 * s2 + 7]);
      const bf16x8 pf = __builtin_bit_cast(bf16x8, pp);
#pragma unroll
      for (int dt = 0; dt < 2; ++dt) {
        const bf16_t* vp = VT + (32 * dt + r) * 264 + 32 * (w + i) + 16 * s2 + 4 * hf;
        const u32x2 lo = *(const u32x2*)vp, hi = *(const u32x2*)(vp + 8);
        u32x4 vv; vv[0] = lo[0]; vv[1] = lo[1]; vv[2] = hi[0]; vv[3] = hi[1];
        ot[dt] = MFMA32(__builtin_bit_cast(bf16x8, vv), pf, ot[dt]);
      }
    }
  const float inv = __builtin_amdgcn_rcpf(den);
  const size_t tok = (size_t)b * SEQ + tq;
#pragma unroll
  for (int dt = 0; dt < 2; ++dt)
#pragma unroll
    for (int h8 = 0; h8 < 2; ++h8) {
      float o[8];
#pragma unroll
      for (int e = 0; e < 8; ++e) o[e] = ot[dt][8 * h8 + e] * inv;
      *(u32x4*)(WSB(p, og) + tok * 768 + qcol + 32 * dt + 16 * hf + 8 * h8) = pack8(o);
    }
  if (hf == 0) WSF(p, lse)[tok * 12 + g * 4 + hh] = mx + __logf(den);
  __syncthreads();
}

DI int lnd(int v) { asm volatile("" : "+s"(v)); return v; }
DI void dn_f1_item(const Params& p, int l, int chunk, char* lds) {
  const int tid = opaque_tid(), lane = tid & 63, w = tid >> 6, fr = lane & 15, fq = lane >> 4;
  const int n = chunk & 31, bh = chunk >> 5, h = bh & 7, b = bh >> 3;
  const int t0 = n * 64;
  const size_t rowbase = (size_t)b * SEQ;
  bf16_t* Qn = (bf16_t*)lds;
  bf16_t* Kn = (bf16_t*)(lds + 17408);
  bf16_t* KB = (bf16_t*)(lds + 2 * 17408);
  bf16_t* Vs = (bf16_t*)(lds + 3 * 17408);
  float* gcs = (float*)(lds + 4 * 17408);
  float* betas = gcs + 64;
  float* egc = gcs + 128;
  float* Am = (float*)lds;
  if (w == 0) {
    const size_t row = rowbase + t0 + lane;
    const float a = WSF(p, ab)[row * 16 + h], bb = WSF(p, ab)[row * 16 + 8 + h];
    const float xx = a + p.dt_bias[l * 8 + h];
    const float sp = xx > 20.f ? xx : log1pf(__expf(xx));
    float s = -__expf(p.a_log[l * 8 + h]) * sp;
#pragma unroll
    for (int off = 1; off < 64; off <<= 1) { const float t = shup(s, off, lane); if (lane >= off) s += t; }
    gcs[lane] = s; betas[lane] = sigmoidf_(bb); egc[lane] = __expf(s);
    if (lane == 63) WSF(p, dGL)[chunk] = __expf(s);
  }
  __syncthreads();
  const float gclast = gcs[63];
  const int cg8 = (tid & 15) * 8, rg = tid >> 4;
#pragma unroll 1
  for (int seg = 0; seg < 3; ++seg) {
    u32x4 rows[7];
#pragma unroll
    for (int r = 0; r < 7; ++r) {
      const int tt = t0 + 4 * rg - 3 + r;
      rows[r] = (u32x4){0u, 0u, 0u, 0u};
      if (tt >= 0) rows[r] = *(const u32x4*)(WSB(p, zdn) + ((size_t)(((b * 8 + h) * 3 + seg) * 2048 + tt)) * 128 + cg8);
    }
    float cw[4][8];
#pragma unroll
    for (int tap = 0; tap < 4; ++tap) {
      const float* cp = p.conv_w + ((size_t)l * 4 + tap) * 3072 + seg * 1024 + h * 128 + cg8;
      const f32x4 c0 = *(const f32x4*)cp, c1 = *(const f32x4*)(cp + 4);
      cw[tap][0] = c0[0]; cw[tap][1] = c0[1]; cw[tap][2] = c0[2]; cw[tap][3] = c0[3];
      cw[tap][4] = c1[0]; cw[tap][5] = c1[1]; cw[tap][6] = c1[2]; cw[tap][7] = c1[3];
    }
#pragma unroll
    for (int jt = 0; jt < 4; ++jt) {
      const int i = 4 * rg + jt;
      float val[8];
#pragma unroll
      for (int e = 0; e < 8; ++e) val[e] = 0.f;
#pragma unroll
      for (int tap = 0; tap < 4; ++tap) {
        float xv[8]; unpack8(rows[jt + tap], xv);
#pragma unroll
        for (int e = 0; e < 8; ++e) val[e] += cw[tap][e] * xv[e];
      }
      float ss = 0.f;
#pragma unroll
      for (int e = 0; e < 8; ++e) { val[e] = siluf_(val[e]); ss += val[e] * val[e]; }
      ss += shx(ss, 1, lane); ss += shx(ss, 2, lane); ss += shx(ss, 4, lane); ss += shx(ss, 8, lane);
      const float rn = rsqrtf(ss + EPS);
      if (seg == 0) {
        const float eg = egc[i];
        float qv[8], qd[8];
#pragma unroll
        for (int e = 0; e < 8; ++e) { qv[e] = val[e] * rn * 0.08838834764831845f; qd[e] = qv[e] * eg; }
        *(u32x4*)(Qn + i * 136 + cg8) = pack8(qv);
        *(u32x4*)(WSB(p, dQD) + ((size_t)lnd(chunk) * 64 + i) * 128 + cg8) = pack8(qd);
      } else if (seg == 1) {
        const float bt = betas[i];
        float kv[8], kb[8];
#pragma unroll
        for (int e = 0; e < 8; ++e) { kv[e] = val[e] * rn; kb[e] = kv[e] * bt; }
        *(u32x4*)(Kn + i * 136 + cg8) = pack8(kv);
        *(u32x4*)(KB + i * 136 + cg8) = pack8(kb);
      } else {
        *(u32x4*)(Vs + i * 136 + cg8) = pack8(val);
      }
    }
  }
  __syncthreads();
  {
    const int dcol = tid >> 1, half = tid & 1;
    u32x4 o4[4];
#pragma unroll
    for (int q = 0; q < 4; ++q)
#pragma unroll
      for (int e = 0; e < 4; ++e) {
        const int i0 = 32 * half + 8 * q + 2 * e;
        const float k0 = bf2f(Kn[i0 * 136 + dcol]) * __expf(gclast - gcs[i0]);
        const float k1 = bf2f(Kn[(i0 + 1) * 136 + dcol]) * __expf(gclast - gcs[i0 + 1]);
        o4[q][e] = pk2(k0, k1);
      }
    u32x4* dst = (u32x4*)(WSB(p, dKDT) + ((size_t)lnd(chunk) * 128 + dcol) * 64 + 32 * half);
#pragma unroll
    for (int q = 0; q < 4; ++q) dst[q] = o4[q];
  }
  f32x4 kk[4], qk[4];
#pragma unroll
  for (int nn = 0; nn < 4; ++nn) { kk[nn] = (f32x4){0.f, 0.f, 0.f, 0.f}; qk[nn] = (f32x4){0.f, 0.f, 0.f, 0.f}; }
#pragma unroll
  for (int s = 0; s < 4; ++s) {
    const bf16x8 akb = *(const bf16x8*)(KB + (16 * w + fr) * 136 + 32 * s + 8 * fq);
    const bf16x8 aq = *(const bf16x8*)(Qn + (16 * w + fr) * 136 + 32 * s + 8 * fq);
#pragma unroll
    for (int nn = 0; nn < 4; ++nn) {
      const bf16x8 bk = *(const bf16x8*)(Kn + (16 * nn + fr) * 136 + 32 * s + 8 * fq);
      kk[nn] = MFMA16(akb, bk, kk[nn]);
      qk[nn] = MFMA16(aq, bk, qk[nn]);
    }
  }
  __syncthreads();
#pragma unroll
  for (int nn = 0; nn < 4; ++nn)
#pragma unroll
    for (int j = 0; j < 4; ++j) {
      const int i = 16 * w + 4 * fq + j, jj = 16 * nn + fr;
      const float dec = __expf(fminf(gcs[i] - gcs[jj], 0.f));
      Am[i * 64 + jj] = (jj < i) ? kk[nn][j] * dec : 0.f;
      Kn[i * 72 + jj] = f2bf((jj <= i) ? qk[nn][j] * dec : 0.f);
    }
  __syncthreads();
#pragma unroll
  for (int ps = 0; ps < 2; ++ps) {
    const int id = tid + 256 * ps, i = id >> 3, c8 = (id & 7) * 8;
    *(u32x4*)(WSB(p, dAI) + ((size_t)lnd(chunk) * 64 + i) * 64 + c8) = *(const u32x4*)(Kn + i * 72 + c8);
  }
  {
    const int c = tid & 127; const bool isW = tid >= 128;
    const bf16_t* rsrc = isW ? KB : Vs;
    const float* msrc = isW ? egc : betas;
    float x[64];
#pragma unroll
    for (int i = 0; i < 64; ++i) x[i] = 0.f;
#pragma unroll
    for (int i = 0; i < 64; ++i) {
      const float rhs = bf2f(rsrc[i * 136 + c]) * msrc[i];
      float s0 = 0.f, s1 = 0.f, s2 = 0.f, s3 = 0.f;
#pragma unroll
      for (int j4 = 0; j4 < (i + 3) / 4; ++j4) {
        const f32x4 a = *(const f32x4*)(Am + i * 64 + 4 * j4);
        s0 += a[0] * x[4 * j4]; s1 += a[1] * x[4 * j4 + 1]; s2 += a[2] * x[4 * j4 + 2]; s3 += a[3] * x[4 * j4 + 3];
      }
      x[i] = rhs - ((s0 + s1) + (s2 + s3));
    }
    if (!isW) {
      u32x4* dst = (u32x4*)(WSB(p, dUT) + ((size_t)lnd(chunk) * 128 + c) * 64);
#pragma unroll
      for (int q = 0; q < 8; ++q) {
        u32x4 o; o[0] = pk2(x[8 * q], x[8 * q + 1]); o[1] = pk2(x[8 * q + 2], x[8 * q + 3]); o[2] = pk2(x[8 * q + 4], x[8 * q + 5]); o[3] = pk2(x[8 * q + 6], x[8 * q + 7]);
        dst[q] = o;
      }
    }
    __syncthreads();
    if (isW) {
#pragma unroll
      for (int i = 0; i < 64; ++i) Kn[i * 136 + c] = f2bf(x[i]);
    }
  }
  __syncthreads();
#pragma unroll
  for (int ps = 0; ps < 4; ++ps) {
    const int id = tid + 256 * ps, i = id >> 4, c8 = (id & 15) * 8;
    *(u32x4*)(WSB(p, dW) + ((size_t)lnd(chunk) * 64 + i) * 128 + c8) = *(const u32x4*)(Kn + i * 136 + c8);
  }
  __syncthreads();
}

#define LDS_BARRIER() do { asm volatile("s_waitcnt lgkmcnt(0)" ::: "memory"); __builtin_amdgcn_s_barrier(); asm volatile("" ::: "memory"); } while (0)
DI void dn_f2_item(const Params& p, int item, char* lds) {
  const int tid = opaque_tid(), lane = tid & 63, w = tid >> 6, fr = lane & 15, fq = lane >> 4;
  const int vs = item & 3, bh = item >> 2, h = bh & 7, b = bh >> 3;
  bf16_t* ST = (bf16_t*)lds;
  bf16_t* VT = (bf16_t*)(lds + 32 * 272);
  bf16_t* OT = (bf16_t*)(lds + 32 * 272 + 32 * 144);
  for (int i = tid; i < 32 * 136; i += 256) ST[i] = 0;
  f32x4 accS[2][2];
#pragma unroll
  for (int nn = 0; nn < 2; ++nn)
#pragma unroll
    for (int m = 0; m < 2; ++m) accS[nn][m] = (f32x4){0.f, 0.f, 0.f, 0.f};
  __syncthreads();
  bf16x8 naw[4], naq[4], naa[2], nak[2][2]; u32x2 nuu[2]; float ngl;
#define F2_LOAD(n_)                                                                                                     \
  {                                                                                                                     \
    const size_t chunk_ = (size_t)bh * 32 + (n_);                                                                       \
    const bf16_t* Wc = WSB(p, dW) + chunk_ * 8192; const bf16_t* QDc = WSB(p, dQD) + chunk_ * 8192;                     \
    const bf16_t* AIc = WSB(p, dAI) + chunk_ * 4096; const bf16_t* KDTc = WSB(p, dKDT) + chunk_ * 8192;                 \
    const bf16_t* UTc = WSB(p, dUT) + chunk_ * 8192;                                                                    \
    _Pragma("unroll") for (int s = 0; s < 4; ++s) {                                                                     \
      naw[s] = *(const bf16x8*)(Wc + (16 * w + fr) * 128 + 32 * s + 8 * fq);                                            \
      naq[s] = *(const bf16x8*)(QDc + (16 * w + fr) * 128 + 32 * s + 8 * fq);                                           \
    }                                                                                                                   \
    _Pragma("unroll") for (int s = 0; s < 2; ++s) {                                                                     \
      naa[s] = *(const bf16x8*)(AIc + (16 * w + fr) * 64 + 32 * s + 8 * fq);                                            \
      _Pragma("unroll") for (int nn = 0; nn < 2; ++nn) nak[s][nn] = *(const bf16x8*)(KDTc + (32 * w + 16 * nn + fr) * 64 + 32 * s + 8 * fq); \
    }                                                                                                                   \
    _Pragma("unroll") for (int m = 0; m < 2; ++m) nuu[m] = *(const u32x2*)(UTc + (vs * 32 + 16 * m + fr) * 64 + 16 * w + 4 * fq); \
    ngl = WSF(p, dGL)[chunk_];                                                                                          \
  }
  F2_LOAD(0);
  for (int n = 0; n < 32; ++n) {
    bf16x8 aw[4], aq[4], aa[2], ak[2][2]; u32x2 uu[2];
#pragma unroll
    for (int s = 0; s < 4; ++s) { aw[s] = naw[s]; aq[s] = naq[s]; }
#pragma unroll
    for (int s = 0; s < 2; ++s) { aa[s] = naa[s]; ak[s][0] = nak[s][0]; ak[s][1] = nak[s][1]; uu[s] = nuu[s]; }
    const float gl = ngl;
    if (n + 1 < 32) F2_LOAD(n + 1);
    f32x4 ws[2], qs[2];
#pragma unroll
    for (int m = 0; m < 2; ++m) { ws[m] = (f32x4){0.f, 0.f, 0.f, 0.f}; qs[m] = (f32x4){0.f, 0.f, 0.f, 0.f}; }
#pragma unroll
    for (int s = 0; s < 4; ++s) {
#pragma unroll
      for (int m = 0; m < 2; ++m) {
        const bf16x8 bs = *(const bf16x8*)(ST + (16 * m + fr) * 136 + 32 * s + 8 * fq);
        ws[m] = MFMA16(aw[s], bs, ws[m]);
        qs[m] = MFMA16(aq[s], bs, qs[m]);
      }
    }
#pragma unroll
    for (int m = 0; m < 2; ++m) {
      const float v0 = bflo(uu[m][0]) - ws[m][0], v1 = bfhi(uu[m][0]) - ws[m][1], v2 = bflo(uu[m][1]) - ws[m][2], v3 = bfhi(uu[m][1]) - ws[m][3];
      u32x2 o; o[0] = pk2(v0, v1); o[1] = pk2(v2, v3);
      *(u32x2*)(VT + (16 * m + fr) * 72 + 16 * w + 4 * fq) = o;
    }
    LDS_BARRIER();
    bf16x8 bv[2][2];
#pragma unroll
    for (int s = 0; s < 2; ++s)
#pragma unroll
      for (int m = 0; m < 2; ++m) bv[s][m] = *(const bf16x8*)(VT + (16 * m + fr) * 72 + 32 * s + 8 * fq);
#pragma unroll
    for (int s = 0; s < 2; ++s)
#pragma unroll
      for (int m = 0; m < 2; ++m) qs[m] = MFMA16(aa[s], bv[s][m], qs[m]);
#pragma unroll
    for (int m = 0; m < 2; ++m)
#pragma unroll
      for (int j = 0; j < 4; ++j) OT[(16 * w + 4 * fq + j) * 40 + 16 * m + fr] = f2bf(qs[m][j]);
#pragma unroll
    for (int nn = 0; nn < 2; ++nn)
#pragma unroll
      for (int m = 0; m < 2; ++m) accS[nn][m] = accS[nn][m] * gl;
#pragma unroll
    for (int s = 0; s < 2; ++s)
#pragma unroll
      for (int nn = 0; nn < 2; ++nn)
#pragma unroll
        for (int m = 0; m < 2; ++m) accS[nn][m] = MFMA16(ak[s][nn], bv[s][m], accS[nn][m]);
#pragma unroll
    for (int nn = 0; nn < 2; ++nn)
#pragma unroll
      for (int m = 0; m < 2; ++m) {
        u32x2 o; o[0] = pk2(accS[nn][m][0], accS[nn][m][1]); o[1] = pk2(accS[nn][m][2], accS[nn][m][3]);
        *(u32x2*)(ST + (16 * m + fr) * 136 + 32 * w + 16 * nn + 4 * fq) = o;
      }
    LDS_BARRIER();
    {
      const int tk = tid >> 2, c8 = (tid & 3) * 8;
      *(u32x4*)(WSB(p, oraw) + ((size_t)b * SEQ + n * 64 + tk) * DM + h * 128 + vs * 32 + c8) = *(const u32x4*)(OT + tk * 40 + c8);
    }
  }
#undef F2_LOAD
}

DI void elem_phase(const Params& p, int l) {
  const int tid = opaque_tid(), lane = tid & 63;
  const size_t stride = (size_t)VGRID * 256;
  for (size_t idx = (size_t)opaque_bid() * 256 + tid; idx < (size_t)MTOK * 32; idx += stride) {
    const size_t tok = idx >> 5; const int ch = (int)(idx & 31), hh = ch >> 3, d0 = (ch & 7) * 8;
    const float l0 = WSF(p, lse)[tok * 12 + hh], l1 = WSF(p, lse)[tok * 12 + 4 + hh], l2 = WSF(p, lse)[tok * 12 + 8 + hh];
    const float mx = fmaxf(l0, fmaxf(l1, l2));
    const float e0 = __expf(l0 - mx), e1 = __expf(l1 - mx), e2 = __expf(l2 - mx);
    const float inv = __builtin_amdgcn_rcpf(e0 + e1 + e2);
    const float wg[3] = {e0 * inv, e1 * inv, e2 * inv};
    float y[8];
#pragma unroll
    for (int e = 0; e < 8; ++e) y[e] = 0.f;
#pragma unroll
    for (int g = 0; g < 3; ++g) {
      const u32x4 raw = *(const u32x4*)(WSB(p, og) + tok * 768 + g * 256 + hh * 64 + d0);
      float v[8]; unpack8(raw, v);
#pragma unroll
      for (int e = 0; e < 8; ++e) y[e] += wg[g] * v[e];
    }
    *(u32x4*)(WSB(p, yatt) + tok * 256 + hh * 64 + d0) = pack8(y);
  }
  for (size_t idx = (size_t)opaque_bid() * 256 + tid; idx < (size_t)MTOK * 128; idx += stride) {
    const size_t tok = idx >> 7; const int col = (int)(idx & 127) * 8;
    const u32x4 raw = *(const u32x4*)(WSB(p, oraw) + tok * DM + col);
    float v[8]; unpack8(raw, v);
    float ss = 0.f;
#pragma unroll
    for (int e = 0; e < 8; ++e) ss += v[e] * v[e];
    ss += shx(ss, 1, lane); ss += shx(ss, 2, lane); ss += shx(ss, 4, lane); ss += shx(ss, 8, lane);
    const float rstd = rsqrtf(ss * (1.f / 128.f) + EPS);
    const u32x4 graw = *(const u32x4*)(WSB(p, z) + tok * ZLD + Z_DNGATE + col);
    float gz[8]; unpack8(graw, gz);
    const float* gn = p.dn_norm + l * 128 + (col & 127);
    float y[8];
#pragma unroll
    for (int e = 0; e < 8; ++e) y[e] = v[e] * rstd * gn[e] * siluf_(gz[e]);
    *(u32x4*)(WSB(p, odn) + tok * DM + col) = pack8(y);
  }
}


#define XB_TMO      128
#define XB_XCNT(j)  (256  + 64 * (j))
#define XB_XSUB(j)  (1280 + 64 * (j))
#define XB_XGEN(j)  (2304 + 64 * (j))
#define XB_TOP      3328
#define XB_TOPGEN   3392
#define XCD_BAR_WORDS 3456
#define XB_SPIN_CAP (1u << 22)
#define LAS __attribute__((address_space(3)))
DI unsigned xb_ld(unsigned* p)              { return __hip_atomic_load(p, __ATOMIC_RELAXED, __HIP_MEMORY_SCOPE_AGENT); }
DI unsigned xb_add(unsigned* p, unsigned v) { return __hip_atomic_fetch_add(p, v, __ATOMIC_RELAXED, __HIP_MEMORY_SCOPE_AGENT); }
DI unsigned xb_xcc_id() { return (unsigned)__builtin_amdgcn_s_getreg((3 << 11) | 20) & 0xFu; }
#define XB_SPIN(cond, bar) do { unsigned _sp = 0; while (cond) { __builtin_amdgcn_s_sleep(1); \
    if ((++_sp & 255u) == 0u) { if (xb_ld(&(bar)[XB_TMO])) break; if (_sp > XB_SPIN_CAP) { atomicAdd(&(bar)[XB_TMO], 1u); break; } } } } while (0)
struct XcdBarrier { unsigned* bar; unsigned x; volatile LAS unsigned* st; };
DI XcdBarrier xcd_barrier_post(unsigned* bar, volatile LAS unsigned* st) {
  XcdBarrier b; b.bar = bar; b.x = xb_xcc_id(); b.st = st;
  if (threadIdx.x == 0) (void)xb_add(&bar[XB_XCNT(b.x)], 1u);
  return b;
}
DI void xcd_barrier_complete(unsigned* bar, unsigned x, unsigned& nloc, unsigned& nx) {
  const unsigned G = gridDim.x * gridDim.y * gridDim.z;
  unsigned sum, cnt, mine, sp = 0u;
  for (;;) {
    sum = 0u; cnt = 0u; mine = 0u;
#pragma unroll
    for (unsigned j = 0; j < 16; ++j) { const unsigned c = xb_ld(&bar[XB_XCNT(j)]); sum += c; cnt += (c > 0u) ? 1u : 0u; mine = (j == x) ? c : mine; }
    if (sum == G) break;
    __builtin_amdgcn_s_sleep(1);
    if ((++sp & 255u) == 0u) { if (xb_ld(&bar[XB_TMO])) break; if (sp > XB_SPIN_CAP) { atomicAdd(&bar[XB_TMO], 1u); break; } }
  }
  nloc = mine > 0u ? mine : 1u; nx = cnt > 0u ? cnt : 1u;
}
DI void xcd_barrier_impl(const XcdBarrier& b) {
  asm volatile("s_waitcnt vmcnt(0)" ::: "memory");
  __syncthreads();
  if (threadIdx.x == 0) {
    unsigned* bar = b.bar; asm volatile("" : "+s"(bar));
    __builtin_amdgcn_s_waitcnt(0);
    const unsigned nloc = b.st[0], nx = b.st[1];
    const unsigned old = xb_add(&bar[XB_XSUB(b.x)], 1u);
    const unsigned gen = old / nloc;
    if (old + 1u == (gen + 1u) * nloc) {
      __builtin_amdgcn_fence(__ATOMIC_RELEASE, "agent");
      asm volatile("s_waitcnt vmcnt(0)" ::: "memory");
      const unsigned og = xb_add(&bar[XB_TOP], 1u);
      const unsigned tg = og / nx;
      if (og + 1u == (tg + 1u) * nx) xb_add(&bar[XB_TOPGEN], 1u);
      else XB_SPIN(xb_ld(&bar[XB_TOPGEN]) == tg, bar);
      __builtin_amdgcn_fence(__ATOMIC_ACQUIRE, "agent");
      xb_add(&bar[XB_XGEN(b.x)], 1u);
      asm volatile("s_waitcnt vmcnt(0)" ::: "memory");
    } else {
      XB_SPIN(xb_ld(&bar[XB_XGEN(b.x)]) == gen, bar);
      __builtin_amdgcn_fence(__ATOMIC_ACQUIRE, "agent");
      asm volatile("s_waitcnt vmcnt(0)" ::: "memory");
    }
  }
  __syncthreads();
}

DI void xcd_barrier_census(char* ws, char* lds) {
  if (threadIdx.x == 0) {
    unsigned nloc, nx; xcd_barrier_complete((unsigned*)(ws + O_bar), xb_xcc_id(), nloc, nx);
    volatile LAS unsigned* st = (volatile LAS unsigned*)(lds + LDS_BYTES); st[0] = nloc; st[1] = nx;
  }
  __syncthreads();
}
DI void xcd_barrier_ws(char* ws, char* lds) {
  XcdBarrier b; b.bar = (unsigned*)(ws + O_bar); b.x = xb_xcc_id(); b.st = (volatile LAS unsigned*)(lds + LDS_BYTES);
  xcd_barrier_impl(b);
}
__global__ void __launch_bounds__(512, 2) fwd_megakernel(Params p) {
  __shared__ __attribute__((aligned(16))) char lds[LDS_BYTES + 16];
  cg::grid_group grid = cg::this_grid();
  if (threadIdx.x == 0) { *(volatile LAS unsigned*)(lds + LDS_BYTES) = 0u; *(volatile LAS unsigned*)(lds + LDS_BYTES + 4) = 0u; }
  __syncthreads();
  (void)xcd_barrier_post((unsigned*)(p.ws + O_bar), (volatile LAS unsigned*)(lds + LDS_BYTES));
  phase0(p, vlds(lds));
  convert_layer(p, 0, vlds(lds), opaque_bid(), VGRID);
  grid.sync();
  xcd_barrier_census(p.ws, lds);
  for (int l = 0; l < DEPTH; ++l) {
    const float* modl = WSF(p, mod) + (size_t)l * 8 * 9216;
    norm_phase(p, l == 0 ? p.x : p.out, p.norm_ff1 + l * DM, modl + 0 * DM, modl + 1 * DM);
    xcd_barrier_ws(p.ws, lds);
    gemm_up_phase(p, WSW(p, W_up1, l), lds);
    xcd_barrier_ws(p.ws, lds);
    gemm_res_phase(p, l == 0 ? p.x : p.out, WSB(p, hidden), DFF, WSW(p, W_down1, l), modl + 2 * DM, 0.5f, lds);
    xcd_barrier_ws(p.ws, lds);
    norm_phase(p, p.out, p.norm_mix + l * DM, modl + 3 * DM, modl + 4 * DM);
    xcd_barrier_ws(p.ws, lds);
    gemm_in_phase(p, WSW(p, W_in, l), lds);
    xcd_barrier_ws(p.ws, lds);
    {
      char* vl = vlds(lds);
      for (int it = opaque_bid(); it < 2048 + 512; it += VGRID) {
        if (it < 2048) dn_f1_item(p, l, it, vl); else attn_item(p, l, it - 2048, vl);
      }
    }
    xcd_barrier_ws(p.ws, lds);
    {
      char* vl = vlds(lds);
      const int vb = opaque_bid();
      if (vb < 256) dn_f2_item(p, vb, vl);
      else {
        for (int it = 512 + vb - 256; it < 1536; it += VGRID - 256) attn_item(p, l, it, vl);
        if (l + 1 < DEPTH) convert_layer(p, l + 1, vl, vb - 256, VGRID - 256);
      }
    }
    xcd_barrier_ws(p.ws, lds);
    elem_phase(p, l);
    xcd_barrier_ws(p.ws, lds);
    gemm_proj_phase(p, WSW(p, W_pa, l), WSW(p, W_pd, l), lds);
    xcd_barrier_ws(p.ws, lds);
    gemm_res_phase(p, p.out, WSB(p, mrg), DM, WSW(p, W_out, l), modl + 5 * DM, 1.0f, lds);
    xcd_barrier_ws(p.ws, lds);
    norm_phase(p, p.out, p.norm_ff2 + l * DM, modl + 6 * DM, modl + 7 * DM);
    xcd_barrier_ws(p.ws, lds);
    gemm_up_phase(p, WSW(p, W_up2, l), lds);
    xcd_barrier_ws(p.ws, lds);
    gemm_res_phase(p, p.out, WSB(p, hidden), DFF, WSW(p, W_down2, l), modl + 8 * DM, 0.5f, lds);
    xcd_barrier_ws(p.ws, lds);
  }
}

extern "C" void kernel_launch(void* const* d_in, const int* in_sizes, int n_in, void* d_out, int out_size, void* d_ws, size_t ws_size, hipStream_t stream) {
  static int grid_blocks = 0;
  if (!grid_blocks) {
    int dev = 0, cus = 0, per_cu = 0;
    hipGetDevice(&dev);
    hipDeviceGetAttribute(&cus, hipDeviceAttributeMultiprocessorCount, dev);
    hipOccupancyMaxActiveBlocksPerMultiprocessor(&per_cu, fwd_megakernel, 512, 0);
    if (per_cu > 1) per_cu = 1;
    grid_blocks = cus * per_cu;
    if (grid_blocks % 8) grid_blocks -= grid_blocks % 8;
  }
  Params p{};
  const float* const* in = (const float* const*)d_in;
  p.x = in[0]; p.c = in[1]; p.ada_w = in[2]; p.ada_b = in[3]; p.norm_ff1 = in[4]; p.w_up1 = in[5]; p.w_down1 = in[6]; p.norm_mix = in[7];
  p.w_in = in[8]; p.q_norm = in[9]; p.k_norm = in[10]; p.conv_w = in[11]; p.a_log = in[12]; p.dt_bias = in[13]; p.dn_norm = in[14];
  p.w_pa = in[15]; p.w_pd = in[16]; p.w_out = in[17]; p.norm_ff2 = in[18]; p.w_up2 = in[19]; p.w_down2 = in[20];
  p.out = (float*)d_out;
  p.ws = (char*)d_ws;
  if (WS_TOTAL > ws_size) { fprintf(stderr, "kernel_launch: workspace too small (%zu needed, %zu given)\n", (size_t)WS_TOTAL, ws_size); return; }
  if (hipMemsetAsync(p.ws + O_bar, 0, (size_t)3456 * 4, stream) != hipSuccess) fprintf(stderr, "kernel_launch: barrier memset failed\n");
  void* args[] = {&p};
  hipError_t e = hipLaunchCooperativeKernel((void*)fwd_megakernel, dim3(grid_blocks), dim3(512), args, 0, stream);
  if (e != hipSuccess) fprintf(stderr, "cooperative launch failed: %s (grid %d)\n", hipGetErrorString(e), grid_blocks);
}
```

```cpp
#include <hip/hip_runtime.h>
#include <hip/hip_cooperative_groups.h>
#include <cstdio>
#include <cstdint>
namespace cg = cooperative_groups;

typedef unsigned short bf16_t;
typedef short bf16x8 __attribute__((ext_vector_type(8)));
typedef short s16x4 __attribute__((ext_vector_type(4)));
typedef float f32x4 __attribute__((ext_vector_type(4)));
typedef float f32x16 __attribute__((ext_vector_type(16)));
typedef unsigned u32x4 __attribute__((ext_vector_type(4)));
typedef unsigned u32x2 __attribute__((ext_vector_type(2)));

#define DI __device__ __forceinline__
#define MFMA16(a, b, c) __builtin_amdgcn_mfma_f32_16x16x32_bf16((a), (b), (c), 0, 0, 0)
#define MFMA32(a, b, c) __builtin_amdgcn_mfma_f32_32x32x16_bf16((a), (b), (c), 0, 0, 0)

constexpr int DM = 1024, NB = 8, SEQ = 2048, MTOK = NB * SEQ, DFF = 2816, DEPTH = 4;
constexpr int ZLD = 3072;
constexpr int NINP = 8704;
constexpr int Z_DNGATE = 0, Z_MERGE = 1024;
constexpr int LDS_BYTES = 147456;
constexpr int VLDS = 73728;
constexpr int LROW = 144;
constexpr int TILE_BYTES = 256 * LROW;
constexpr int STAGE_BYTES = 2 * TILE_BYTES;
constexpr float EPS = 1e-6f;

struct Params {
  const float *x, *c, *ada_w, *ada_b, *norm_ff1, *w_up1, *w_down1, *norm_mix, *w_in, *q_norm, *k_norm, *conv_w, *a_log, *dt_bias,
      *dn_norm, *w_pa, *w_pd, *w_out, *norm_ff2, *w_up2, *w_down2;
  float* out;
  char* ws;
};
constexpr size_t al256(size_t b) { return (b + 255) & ~(size_t)255; }
constexpr size_t O_W_up1 = 0;
constexpr size_t O_W_down1 = O_W_up1 + al256((size_t)2 * DFF * DM * 2);
constexpr size_t O_W_in = O_W_down1 + al256((size_t)DM * DFF * 2);
constexpr size_t O_W_pa = O_W_in + al256((size_t)NINP * DM * 2);
constexpr size_t O_W_pd = O_W_pa + al256((size_t)DM * 256 * 2);
constexpr size_t O_W_out = O_W_pd + al256((size_t)DM * DM * 2);
constexpr size_t O_W_up2 = O_W_out + al256((size_t)DM * DM * 2);
constexpr size_t O_W_down2 = O_W_up2 + al256((size_t)2 * DFF * DM * 2);
constexpr size_t WSET_BYTES = O_W_down2 + al256((size_t)DM * DFF * 2);
constexpr size_t O_h = 2 * WSET_BYTES;
constexpr size_t O_z = O_h + al256((size_t)MTOK * DM * 2);
constexpr size_t O_zatt = O_z + al256((size_t)MTOK * ZLD * 2);
constexpr size_t O_zdn = O_zatt + al256((size_t)MTOK * 2304 * 2);
constexpr size_t O_hidden = O_zatt;
constexpr size_t O_og = O_zdn + al256((size_t)MTOK * 3072 * 2);
constexpr size_t O_yatt = O_og + al256((size_t)MTOK * 768 * 2);
constexpr size_t O_dW = O_yatt + al256((size_t)MTOK * 256 * 2);
constexpr size_t O_dUT = O_dW + al256((size_t)MTOK * DM * 2);
constexpr size_t O_mrg = O_dUT;
constexpr size_t O_dQD = O_dUT + al256((size_t)MTOK * DM * 2);
constexpr size_t O_dKDT = O_dQD + al256((size_t)MTOK * DM * 2);
constexpr size_t O_dAI = O_dKDT + al256((size_t)MTOK * DM * 2);
constexpr size_t O_oraw = O_dAI + al256((size_t)2048 * 4096 * 2);
constexpr size_t O_odn = O_dW;
constexpr size_t O_ab = O_oraw + al256((size_t)MTOK * DM * 2);
constexpr size_t O_mod = O_ab + al256((size_t)MTOK * 16 * 4);
constexpr size_t O_lse = O_mod + al256((size_t)DEPTH * 8 * 9216 * 4);
constexpr size_t O_dGL = O_lse + al256((size_t)MTOK * 12 * 4);
constexpr size_t O_bar = O_dGL + al256((size_t)2048 * 4);
constexpr size_t WS_TOTAL = O_bar + al256((size_t)3456 * 4);
#define WSB(p, name) ((bf16_t*)((p).ws + O_##name))
#define WSW(p, name, l_) ((bf16_t*)((p).ws + O_##name + (size_t)((l_) & 1) * WSET_BYTES))
#define WSF(p, name) ((float*)((p).ws + O_##name))

DI int opaque_tid() { int t = threadIdx.x; asm volatile("" : "+v"(t)); return t & 255; }
DI int real_tid() { int t = threadIdx.x; asm volatile("" : "+v"(t)); return t; }
DI int opaque_bid() { int h = threadIdx.x; asm volatile("" : "+v"(h)); int t = blockIdx.x; asm volatile("" : "+s"(t)); return t * 2 + __builtin_amdgcn_readfirstlane(h >> 8); }
DI int real_bid() { int t = blockIdx.x; asm volatile("" : "+s"(t)); return t; }
#define VGRID ((int)gridDim.x * 2)
DI char* vlds(char* lds) { unsigned t = threadIdx.x; asm volatile("" : "+v"(t)); unsigned off = (t >> 8) * VLDS; asm volatile("" : "+v"(off)); return lds + off; }
typedef float f32x2 __attribute__((ext_vector_type(2)));
typedef __bf16 hwbf16x2 __attribute__((ext_vector_type(2)));
DI unsigned pk2(float lo, float hi) { const f32x2 v = {lo, hi}; return __builtin_bit_cast(unsigned, __builtin_convertvector(v, hwbf16x2)); }
DI unsigned short f2bf(float x) { return (unsigned short)(pk2(x, 0.f) & 0xffffu); }
DI float bf2f(unsigned short v) { return __uint_as_float(((unsigned)v) << 16); }
DI float bflo(unsigned u) { return __uint_as_float(u << 16); }
DI float bfhi(unsigned u) { return __uint_as_float(u & 0xffff0000u); }
DI float shx(float v, int mask, int lane) { return __int_as_float(__builtin_amdgcn_ds_bpermute((lane ^ mask) << 2, __float_as_int(v))); }
DI float shup(float v, int off, int lane) { return __int_as_float(__builtin_amdgcn_ds_bpermute((lane - off) << 2, __float_as_int(v))); }
#define DPPF(v_, ctrl_) __int_as_float(__builtin_amdgcn_update_dpp(0, __float_as_int(v_), (ctrl_), 0xF, 0xF, true))
DI float sum16(float v) { v += DPPF(v, 0xB1); v += DPPF(v, 0x4E); v += DPPF(v, 0x141); v += DPPF(v, 0x140); return v; }
DI float sigmoidf_(float x) { return __builtin_amdgcn_rcpf(1.f + __expf(-x)); }
DI float siluf_(float x) { return x * __builtin_amdgcn_rcpf(1.f + __expf(-x)); }
DI void unpack8(const u32x4& r, float (&v)[8]) {
  v[0] = bflo(r[0]); v[1] = bfhi(r[0]); v[2] = bflo(r[1]); v[3] = bfhi(r[1]);
  v[4] = bflo(r[2]); v[5] = bfhi(r[2]); v[6] = bflo(r[3]); v[7] = bfhi(r[3]);
}
DI u32x4 pack8(const float (&v)[8]) { u32x4 r; r[0] = pk2(v[0], v[1]); r[1] = pk2(v[2], v[3]); r[2] = pk2(v[4], v[5]); r[3] = pk2(v[6], v[7]); return r; }

template <int MH> DI void gemm_core_simple(const bf16_t* __restrict__ A, int lda, const bf16_t* __restrict__ Bt, int ldb, int K, f32x4 (&acc)[MH][4], char* lds) {
  const int tid = real_tid(), lane = tid & 63, wid = tid >> 6, wr = wid >> 2, wc = wid & 3, fr = lane & 15, fq = lane >> 4;
  const int sl = lane ^ ((lane >> 5) << 1);
  const int R0 = (wid >> 1) * 16 + (sl >> 2), C0 = (wid & 1) * 32 + (sl & 3) * 8;
  const bf16_t* gA = A + (size_t)R0 * lda + C0;
  const bf16_t* gB = Bt + (size_t)R0 * ldb + C0;
  const size_t sA = (size_t)64 * lda, sB = (size_t)64 * ldb;
  unsigned st_off = (unsigned)tid * 16u;
  const unsigned rd_off = (unsigned)((fr * 64 + fq * 16) ^ ((fr >> 3) << 5));
  unsigned rd_a = (unsigned)(wr * (MH * 2048)) + rd_off;
  unsigned rd_b = 32768u + (unsigned)(wc * 4096) + rd_off;
  asm volatile("" : "+v"(st_off), "+v"(rd_a), "+v"(rd_b));
  const int nk = K >> 6;
#define GSTAGE(sbase_, k0_)                                                                                                        \
  {                                                                                                                                \
    _Pragma("unroll") for (int j = 0; j < 4; ++j) {                                                                                \
      if (j < MH / 2) __builtin_amdgcn_global_load_lds((const unsigned*)(gA + j * sA + (k0_)), (unsigned*)(lds + ((sbase_) + j * 8192 + st_off)), 16, 0, 0);          \
      __builtin_amdgcn_global_load_lds((const unsigned*)(gB + j * sB + (k0_)), (unsigned*)(lds + ((sbase_) + 32768 + j * 8192 + st_off)), 16, 0, 0);  \
    }                                                                                                                              \
  }
  GSTAGE(0u, 0);
  asm volatile("s_waitcnt vmcnt(0)" ::: "memory");
  __syncthreads();
#pragma unroll 1
  for (int kt = 0; kt < nk; ++kt) {
    const unsigned sbase = (unsigned)(kt & 1) << 16;
    if (kt + 1 < nk) GSTAGE(65536u - sbase, (kt + 1) * 64);
    const char* pa = lds + (rd_a + sbase);
    const char* pb = lds + (rd_b + sbase);
    bf16x8 af[2 * MH], b0[4], b1[4];
    constexpr int B1S = MH >= 5 ? MH - 5 : 0;
#define RDA(g_) af[g_] = *(const bf16x8*)(pa + ((g_) % MH) * 2048 + ((g_) / MH) * 1024)
#define RDB(ks_, n_) *(const bf16x8*)(pb + ((n_) >> 1) * 16384 + ((n_) & 1) * 2048 + (ks_) * 1024)
    b0[0] = RDB(0, 0); b0[1] = RDB(0, 1); b0[2] = RDB(0, 2); b0[3] = RDB(0, 3);
    RDA(0); RDA(1); RDA(2);
    __builtin_amdgcn_sched_barrier(0);
#pragma unroll
    for (int g = 0; g < 2 * MH; ++g) {
      if (g + 3 < 2 * MH) RDA(g + 3);
      if (g >= B1S && g < B1S + 4) b1[g - B1S] = RDB(1, g - B1S);
      __builtin_amdgcn_sched_barrier(0);
      if (g < MH) {
#pragma unroll
        for (int n = 0; n < 4; ++n) acc[g % MH][n] = MFMA16(b0[n], af[g], acc[g % MH][n]);
      } else {
#pragma unroll
        for (int n = 0; n < 4; ++n) acc[g % MH][n] = MFMA16(b1[n], af[g], acc[g % MH][n]);
      }
      __builtin_amdgcn_sched_barrier(0);
    }
#undef RDA
#undef RDB
    asm volatile("s_waitcnt vmcnt(0)" ::: "memory");
    __syncthreads();
  }
#undef GSTAGE
}

DI void gemm_core(const bf16_t* __restrict__ A, int lda, const bf16_t* __restrict__ Bt, int ldb, int K, f32x4 (&acc)[8][4], char* lds) {
  const int tid = real_tid(), lane = tid & 63, wid = tid >> 6, wr = wid >> 2, wc = wid & 3, fr = lane & 15, fq = lane >> 4;
  const int sl = lane ^ ((lane >> 5) << 1);
  const int R0 = (wid >> 1) * 16 + (sl >> 2), C0 = (wid & 1) * 32 + (sl & 3) * 8;
  const bf16_t* gA = A + (size_t)R0 * lda + C0;
  const bf16_t* gB = Bt + (size_t)R0 * ldb + C0;
  const size_t sA = (size_t)64 * lda, sB = (size_t)64 * ldb;
  const unsigned rd_off = (unsigned)((fr * 64 + fq * 16) ^ ((fr >> 3) << 5));
  unsigned st0 = (unsigned)tid * 16u, st1 = st0 + 65536u;
  unsigned ra0 = (unsigned)(wr * 8192) + rd_off, ra1 = ra0 + 65536u;
  unsigned rb0 = 32768u + (unsigned)(wc * 4096) + rd_off, rb1 = rb0 + 65536u;
  asm volatile("" : "+v"(st0), "+v"(st1), "+v"(ra0), "+v"(ra1), "+v"(rb0), "+v"(rb1));
  const int nt = K >> 6;
  bf16x8 At[4][2], B0[2][2], B1[2][2];
#define STG_A(b_, h_, kt_) { const bf16_t* g_ = gA + (size_t)((h_) * 128) * lda + (size_t)(kt_) * 64; char* d_ = lds + (((b_) ? st1 : st0) + (h_) * 16384); \
    __builtin_amdgcn_global_load_lds((const unsigned*)g_, (unsigned*)d_, 16, 0, 0); __builtin_amdgcn_global_load_lds((const unsigned*)(g_ + sA), (unsigned*)(d_ + 8192), 16, 0, 0); }
#define STG_B(b_, h_, kt_) { const bf16_t* g_ = gB + (size_t)((h_) * 128) * ldb + (size_t)(kt_) * 64; char* d_ = lds + (((b_) ? st1 : st0) + 32768 + (h_) * 16384); \
    __builtin_amdgcn_global_load_lds((const unsigned*)g_, (unsigned*)d_, 16, 0, 0); __builtin_amdgcn_global_load_lds((const unsigned*)(g_ + sB), (unsigned*)(d_ + 8192), 16, 0, 0); }
#define LDA(b_, h_) { const char* s_ = lds + (((b_) ? ra1 : ra0) + (h_) * 16384); \
    _Pragma("unroll") for (int m = 0; m < 4; ++m) _Pragma("unroll") for (int k = 0; k < 2; ++k) At[m][k] = *(const bf16x8*)(s_ + m * 2048 + k * 1024); }
#define LDB(dst_, b_, h_) { const char* s_ = lds + (((b_) ? rb1 : rb0) + (h_) * 16384); \
    _Pragma("unroll") for (int n = 0; n < 2; ++n) _Pragma("unroll") for (int k = 0; k < 2; ++k) dst_[n][k] = *(const bf16x8*)(s_ + n * 2048 + k * 1024); }
#define MMA(ai_, bj_, Bx_) { __builtin_amdgcn_s_setprio(1); \
    _Pragma("unroll") for (int m = 0; m < 4; ++m) _Pragma("unroll") for (int n = 0; n < 2; ++n) _Pragma("unroll") for (int k = 0; k < 2; ++k) \
      acc[(ai_) * 4 + m][(bj_) * 2 + n] = MFMA16(Bx_[n][k], At[m][k], acc[(ai_) * 4 + m][(bj_) * 2 + n]); \
    __builtin_amdgcn_s_setprio(0); }
#define WAIT_V(n_) asm volatile("s_waitcnt vmcnt(" #n_ ")" ::: "memory")
#define WAIT_L(n_) asm volatile("s_waitcnt lgkmcnt(" #n_ ")" ::: "memory")
#define BAR __builtin_amdgcn_s_barrier()
#define SCHED __builtin_amdgcn_sched_barrier(0)
  WAIT_V(0);
  STG_B(0, 0, 0); STG_A(0, 0, 0); STG_B(0, 1, 0); STG_A(0, 1, 0);
  if (wr == 1) BAR;
  WAIT_V(4); BAR;
  STG_B(1, 0, 1); STG_A(1, 0, 1); STG_B(1, 1, 1);
  WAIT_V(6); BAR;
#pragma unroll 1
  for (int t = 0; t < nt - 2; t += 2) {
    LDB(B0, 0, 0); SCHED; LDA(0, 0); STG_A(1, 1, t + 1);
    WAIT_L(8); BAR; WAIT_L(0); MMA(0, 0, B0); BAR; SCHED;
    LDB(B1, 0, 1); STG_B(0, 0, t + 2);
    BAR; WAIT_L(0); MMA(0, 1, B1); BAR;
    LDA(0, 1); STG_A(0, 0, t + 2);
    BAR; WAIT_L(0); MMA(1, 0, B0); BAR; SCHED;
    STG_B(0, 1, t + 2);
    WAIT_V(6); BAR; MMA(1, 1, B1); BAR;
    LDB(B0, 1, 0); SCHED; LDA(1, 0); STG_A(0, 1, t + 2);
    WAIT_L(8); BAR; WAIT_L(0); MMA(0, 0, B0); BAR; SCHED;
    LDB(B1, 1, 1); STG_B(1, 0, t + 3);
    BAR; WAIT_L(0); MMA(0, 1, B1); BAR;
    LDA(1, 1); STG_A(1, 0, t + 3);
    BAR; WAIT_L(0); MMA(1, 0, B0); BAR; SCHED;
    STG_B(1, 1, t + 3);
    WAIT_V(6); BAR; MMA(1, 1, B1); BAR;
  }
  { LDB(B0, 0, 0); LDA(0, 0); STG_A(1, 1, nt - 1);
    BAR; WAIT_L(0); MMA(0, 0, B0); BAR;
    LDB(B1, 0, 1); BAR; WAIT_L(0); MMA(0, 1, B1); BAR;
    LDA(0, 1); WAIT_V(4); BAR; WAIT_L(0); MMA(1, 0, B0); MMA(1, 1, B1); BAR; }
  { LDB(B0, 1, 0); LDA(1, 0); WAIT_V(2); BAR; WAIT_L(0); MMA(0, 0, B0); BAR;
    LDB(B1, 1, 1); WAIT_V(0); BAR; WAIT_L(0); MMA(0, 1, B1); BAR;
    LDA(1, 1); BAR; WAIT_L(0); MMA(1, 0, B0); MMA(1, 1, B1); BAR; }
  if (wr == 0) BAR;
#undef STG_A
#undef STG_B
#undef LDA
#undef LDB
#undef MMA
#undef WAIT_V
#undef WAIT_L
#undef BAR
#undef SCHED
}

DI void tile_decode(int t, int& mt, int& nt) {
  const int xcd = t & 7, local = t >> 3;
  mt = 8 * xcd + (local & 7); nt = local >> 3;
}
template <int MH> DI void zero_acc(f32x4 (&acc)[MH][4]) {
#pragma unroll
  for (int m = 0; m < MH; ++m)
#pragma unroll
    for (int n = 0; n < 4; ++n) acc[m][n] = (f32x4){0.f, 0.f, 0.f, 0.f};
}
#define GEMM_IDS const int tid = real_tid(), lane = tid & 63, wid = tid >> 6, wr = wid >> 2, wc = wid & 3, fr = lane & 15, fq = lane >> 4
#define GEMM_IDS_AGAIN const int tid = real_tid(), lane = tid & 63, wid = tid >> 6, wr = wid >> 2, wc = wid & 3, fr = lane & 15, fq = lane >> 4; (void)lane; (void)wr; (void)wc
#define EROW(m) ((size_t)mt * 256 + ((m) >> 2) * 128 + wr * 64 + ((m) & 3) * 16 + fr)
#define ECOL8(bj) (nt * 256 + (bj) * 128 + wc * 32 + fq * 8)

template <int MH> DI void up_epilogue(const Params& p, const f32x4 (&acc)[MH][4], int mt, int half, int nt, int wr, int wc, int fr, int fq) {
#pragma unroll
  for (int m = 0; m < MH; ++m) {
    const size_t row = (size_t)mt * 256 + (MH == 8 ? (m >> 2) : half) * 128 + wr * 64 + (m & 3) * 16 + fr;
    const int hc = nt * 128 + wc * 32 + fq * 8;
    float o[8];
#pragma unroll
    for (int n = 0; n < 2; ++n)
#pragma unroll
      for (int j = 0; j < 4; ++j) { const float g = acc[m][n][j], u = acc[m][n + 2][j]; o[4 * n + j] = siluf_(g) * u; }
    *(u32x4*)(WSB(p, hidden) + row * DFF + hc) = pack8(o);
  }
}
DI void tail_decode(int bid, int nfull, int& mt, int& nt, int& half) { tile_decode(nfull + ((bid >> 4) << 3) + (bid & 7), mt, nt); half = (bid >> 3) & 1; }

DI void gemm_up_phase(const Params& p, const bf16_t* Bt, char* lds) {
  GEMM_IDS; (void)lane;
  constexpr int NT = 22, NFULL = (64 * NT / 256) * 256;
  for (int t = real_bid(); t < 64 * NT; t += gridDim.x) {
    int mt, nt; tile_decode(t, mt, nt);
    f32x4 acc[8][4]; zero_acc(acc);
    gemm_core(WSB(p, h) + (size_t)mt * 256 * DM, DM, Bt + (size_t)nt * 256 * DM, DM, DM, acc, lds);
    GEMM_IDS_AGAIN;
    up_epilogue<8>(p, acc, mt, 0, nt, wr, wc, fr, fq);
  }
}

DI void gemm_res_phase(const Params& p, const float* xin, const bf16_t* A, int K, const bf16_t* Bt, const float* gate, float coef, char* lds) {
  GEMM_IDS; (void)lane;
  constexpr int NT = 4;
  for (int t = real_bid(); t < 64 * NT; t += gridDim.x) {
    int mt, nt; tile_decode(t, mt, nt);
    f32x4 acc[8][4]; zero_acc(acc);
    gemm_core(A + (size_t)mt * 256 * K, K, Bt + (size_t)nt * 256 * K, K, K, acc, lds);
    GEMM_IDS_AGAIN;
    const int b = mt >> 3;
#pragma unroll
    for (int bj = 0; bj < 2; ++bj) {
      const int col = ECOL8(bj);
      const f32x4 g0 = *(const f32x4*)(gate + (size_t)b * 9216 + col), g1 = *(const f32x4*)(gate + (size_t)b * 9216 + col + 4);
#pragma unroll
      for (int m = 0; m < 8; ++m) {
        const size_t xo = EROW(m) * DM + col;
        f32x4 x0 = *(const f32x4*)(xin + xo), x1 = *(const f32x4*)(xin + xo + 4);
        x0 = x0 + (g0 * acc[m][2 * bj]) * coef; x1 = x1 + (g1 * acc[m][2 * bj + 1]) * coef;
        *(f32x4*)(p.out + xo) = x0; *(f32x4*)(p.out + xo + 4) = x1;
        if (m & 1) __builtin_amdgcn_sched_barrier(0);
      }
    }
  }
}

template <int MH> DI void in_epilogue(const Params& p, const f32x4 (&acc)[MH][4], int mt, int half, int nt, int wr, int wc, int fr, int fq) {
#define IN_ROW(m) ((size_t)mt * 256 + (MH == 8 ? ((m) >> 2) : half) * 128 + wr * 64 + ((m) & 3) * 16 + fr)
#define IN_PK(m, bj) ((u32x4){pk2(acc[m][2 * (bj)][0], acc[m][2 * (bj)][1]), pk2(acc[m][2 * (bj)][2], acc[m][2 * (bj)][3]), pk2(acc[m][2 * (bj) + 1][0], acc[m][2 * (bj) + 1][1]), pk2(acc[m][2 * (bj) + 1][2], acc[m][2 * (bj) + 1][3])})
  if (nt < 9) {
#pragma unroll
    for (int bj = 0; bj < 2; ++bj) {
      const int col = ECOL8(bj), sq = col / 768, rem = col - sq * 768, g = rem >> 8, hh = (rem >> 6) & 3, dd = rem & 63;
      const int sh = (g == 0) ? 0 : (g == 1 ? 2 : 4);
#pragma unroll
      for (int m = 0; m < MH; ++m) {
        const size_t row = IN_ROW(m);
        const int b = (int)(row >> 11), t = (int)(row & 2047);
        const int ridx = ((t & ((1 << sh) - 1)) << (11 - sh)) + (t >> sh);
        *(u32x4*)(WSB(p, zatt) + ((size_t)((((b * 3 + sq) * 3 + g) * 4 + hh) * 2048 + ridx)) * 64 + dd) = IN_PK(m, bj);
      }
    }
  } else if (nt < 21) {
#pragma unroll
    for (int bj = 0; bj < 2; ++bj) {
      const int c = ECOL8(bj) - 2304, seg = c >> 10, hd = (c >> 7) & 7, cc = c & 127;
#pragma unroll
      for (int m = 0; m < MH; ++m) {
        const size_t row = IN_ROW(m);
        const int b = (int)(row >> 11), t = (int)(row & 2047);
        *(u32x4*)(WSB(p, zdn) + ((size_t)(((b * 8 + hd) * 3 + seg) * 2048 + t)) * 128 + cc) = IN_PK(m, bj);
      }
    }
  } else if (nt < 33) {
#pragma unroll
    for (int m = 0; m < MH; ++m) {
      const size_t row = IN_ROW(m);
#pragma unroll
      for (int bj = 0; bj < 2; ++bj) *(u32x4*)(WSB(p, z) + row * ZLD + (ECOL8(bj) - 5376)) = IN_PK(m, bj);
    }
  } else if (wc == 0 && fq < 2) {
#pragma unroll
    for (int m = 0; m < MH; ++m) {
      float* ap = WSF(p, ab) + IN_ROW(m) * 16 + fq * 8;
      *(f32x4*)ap = acc[m][0]; *(f32x4*)(ap + 4) = acc[m][1];
    }
  }
#undef IN_ROW
#undef IN_PK
}
DI void gemm_in_phase(const Params& p, const bf16_t* Win, char* lds) {
  GEMM_IDS; (void)lane;
  constexpr int NT = 34, NFULL = (64 * NT / 256) * 256;
  for (int t = real_bid(); t < 64 * NT; t += gridDim.x) {
    int mt, nt; tile_decode(t, mt, nt);
    f32x4 acc[8][4]; zero_acc(acc);
    gemm_core(WSB(p, h) + (size_t)mt * 256 * DM, DM, Win + (size_t)nt * 256 * DM, DM, DM, acc, lds);
    GEMM_IDS_AGAIN;
    in_epilogue<8>(p, acc, mt, 0, nt, wr, wc, fr, fq);
  }
}

DI void gemm_proj_phase(const Params& p, const bf16_t* Wpa, const bf16_t* Wpd, char* lds) {
  GEMM_IDS; (void)lane;
  constexpr int NT = 4;
  for (int t = real_bid(); t < 64 * NT; t += gridDim.x) {
    int mt, nt; tile_decode(t, mt, nt);
    f32x4 acc[8][4]; zero_acc(acc);
    gemm_core(WSB(p, yatt) + (size_t)mt * 256 * 256, 256, Wpa + (size_t)nt * 256 * 256, 256, 256, acc, lds);
    GEMM_IDS_AGAIN;
#pragma unroll
    for (int m = 0; m < 8; ++m) {
      const size_t row = EROW(m);
#pragma unroll
      for (int bj = 0; bj < 2; ++bj) {
        const int col = ECOL8(bj);
        const u32x4 gz = *(const u32x4*)(WSB(p, z) + row * ZLD + Z_MERGE + col);
        float gt[8], o[8]; unpack8(gz, gt);
#pragma unroll
        for (int e = 0; e < 8; ++e) o[e] = sigmoidf_(gt[e]) * acc[m][2 * bj + (e >> 2)][e & 3];
        *(u32x4*)(WSB(p, mrg) + row * DM + col) = pack8(o);
      }
      __builtin_amdgcn_sched_barrier(0);
    }
  }
  for (int t = real_bid(); t < 64 * NT; t += gridDim.x) {
    int mt, nt; tile_decode(t, mt, nt);
    f32x4 acc[8][4]; zero_acc(acc);
    gemm_core(WSB(p, odn) + (size_t)mt * 256 * DM, DM, Wpd + (size_t)nt * 256 * DM, DM, DM, acc, lds);
    GEMM_IDS_AGAIN;
#pragma unroll
    for (int m = 0; m < 8; ++m) {
      const size_t row = EROW(m);
#pragma unroll
      for (int bj = 0; bj < 2; ++bj) {
        const int col = ECOL8(bj);
        const u32x4 gz = *(const u32x4*)(WSB(p, z) + row * ZLD + Z_MERGE + DM + col);
        const u32x4 pv = *(const u32x4*)(WSB(p, mrg) + row * DM + col);
        float gt[8], pr[8], o[8]; unpack8(gz, gt); unpack8(pv, pr);
#pragma unroll
        for (int e = 0; e < 8; ++e) o[e] = pr[e] + sigmoidf_(gt[e]) * acc[m][2 * bj + (e >> 2)][e & 3];
        *(u32x4*)(WSB(p, mrg) + row * DM + col) = pack8(o);
      }
      __builtin_amdgcn_sched_barrier(0);
    }
  }
}

DI void convert_matrix(const float* __restrict__ src, int ldsrc, bf16_t* __restrict__ dst, int K, int ncoltiles, int kind, char* lds, int start, int stride) {
  float* tl = (float*)lds;
  const int tid = opaque_tid();
  const int nkt = K >> 6;
  const int nitems = ncoltiles * nkt;
  for (int it = start; it < nitems; it += stride) {
    const int ct = it / nkt, kt = it - ct * nkt;
    int srccol0 = ct * 64, nvalid = 64;
    if (kind == 1) { const int T = ct >> 2, q = ct & 3; srccol0 = (q >> 1) * DFF + T * 128 + (q & 1) * 64; }
    else if (kind == 2) {
      if (ct < 100) srccol0 = ct * 64;
      else if (ct < 132) srccol0 = 6416 + (ct - 100) * 64;
      else if (ct == 132) { srccol0 = 6400; nvalid = 16; }
      else { srccol0 = 0; nvalid = 0; }
    }
    const int r = tid >> 4, c4 = (tid & 15) * 4;
#pragma unroll
    for (int ps = 0; ps < 4; ++ps) {
      const int kk = r + 16 * ps;
      f32x4 v = (f32x4){0.f, 0.f, 0.f, 0.f};
      if (c4 < nvalid) v = *(const f32x4*)(src + (size_t)(kt * 64 + kk) * ldsrc + srccol0 + c4);
      tl[kk * 65 + c4 + 0] = v[0]; tl[kk * 65 + c4 + 1] = v[1]; tl[kk * 65 + c4 + 2] = v[2]; tl[kk * 65 + c4 + 3] = v[3];
    }
    __syncthreads();
#pragma unroll
    for (int ps = 0; ps < 2; ++ps) {
      const int n = (tid >> 3) + 32 * ps, k8 = (tid & 7) * 8;
      float v[8];
      const int nl = (n & 32) + 8 * ((n & 15) >> 2) + 4 * ((n >> 4) & 1) + (n & 3);
#pragma unroll
      for (int e = 0; e < 8; ++e) v[e] = tl[(k8 + e) * 65 + nl];
      *(u32x4*)(dst + (size_t)(ct * 64 + n) * K + kt * 64 + k8) = pack8(v);
    }
    __syncthreads();
  }
}

DI void convert_layer(const Params& p, int l, char* lds, int start, int stride) {
  convert_matrix(p.w_up1 + (size_t)l * DM * 2 * DFF, 2 * DFF, WSW(p, W_up1, l), DM, 88, 1, lds, start, stride);
  convert_matrix(p.w_down1 + (size_t)l * DFF * DM, DM, WSW(p, W_down1, l), DFF, 16, 0, lds, start, stride);
  convert_matrix(p.w_in + (size_t)l * DM * 8464, 8464, WSW(p, W_in, l), DM, 136, 2, lds, start, stride);
  convert_matrix(p.w_pa + (size_t)l * 256 * DM, DM, WSW(p, W_pa, l), 256, 16, 0, lds, start, stride);
  convert_matrix(p.w_pd + (size_t)l * DM * DM, DM, WSW(p, W_pd, l), DM, 16, 0, lds, start, stride);
  convert_matrix(p.w_out + (size_t)l * DM * DM, DM, WSW(p, W_out, l), DM, 16, 0, lds, start, stride);
  convert_matrix(p.w_up2 + (size_t)l * DM * 2 * DFF, 2 * DFF, WSW(p, W_up2, l), DM, 88, 1, lds, start, stride);
  convert_matrix(p.w_down2 + (size_t)l * DFF * DM, DM, WSW(p, W_down2, l), DFF, 16, 0, lds, start, stride);
}

DI void norm_phase(const Params& p, const float* xin, const float* g, const float* shift, const float* scale  ) {
  const int tid = opaque_tid(), lane = tid & 63, wid = tid >> 6;
  const int nw = VGRID * 4;
  for (int row = opaque_bid() * 4 + wid; row < MTOK; row += nw) {
    const int b = row >> 11;
    const float* xp = xin + (size_t)row * DM;
    f32x4 v[2][2]; float ss = 0.f;
#pragma unroll
    for (int i = 0; i < 2; ++i)
#pragma unroll
      for (int hq = 0; hq < 2; ++hq) {
        v[i][hq] = *(const f32x4*)(xp + i * 512 + lane * 8 + hq * 4);
        ss += v[i][hq][0] * v[i][hq][0] + v[i][hq][1] * v[i][hq][1] + v[i][hq][2] * v[i][hq][2] + v[i][hq][3] * v[i][hq][3];
      }
    ss = sum16(ss); ss += shx(ss, 16, lane); ss += shx(ss, 32, lane);
    const float rstd = __builtin_amdgcn_rsqf(ss * (1.f / DM) + EPS);
#pragma unroll
    for (int i = 0; i < 2; ++i) {
      const int col = i * 512 + lane * 8;
      float o[8];
#pragma unroll
      for (int hq = 0; hq < 2; ++hq) {
        const f32x4 gv = *(const f32x4*)(g + col + hq * 4), sc = *(const f32x4*)(scale + (size_t)b * 9216 + col + hq * 4), sh = *(const f32x4*)(shift + (size_t)b * 9216 + col + hq * 4);
#pragma unroll
        for (int j = 0; j < 4; ++j) o[hq * 4 + j] = v[i][hq][j] * rstd * gv[j] * (1.f + sc[j]) + sh[j];
      }
      *(u32x4*)(WSB(p, h) + (size_t)row * DM + col) = pack8(o);
    }
  }
}

DI void phase0(const Params& p, char* lds) {
  float* cact = (float*)lds;
  float* red = (float*)(lds + 32768);
  const int tid = opaque_tid(), lane = tid & 63, wid = tid >> 6;
  for (int i = tid; i < NB * DM; i += 256) cact[i] = siluf_(p.c[i]);
  __syncthreads();
  for (int it = opaque_bid(); it < 576; it += VGRID) {
    const int l = it / 144, cb = it - l * 144;
    float acc[8];
#pragma unroll
    for (int b = 0; b < 8; ++b) acc[b] = 0.f;
    const float* wp = p.ada_w + (size_t)l * DM * 9216 + cb * 64 + lane;
    const int kbeg = wid * 256;
#pragma unroll 1
    for (int k = kbeg; k < kbeg + 256; k += 8) {
      float wv[8];
#pragma unroll
      for (int u = 0; u < 8; ++u) wv[u] = wp[(size_t)(k + u) * 9216];
#pragma unroll
      for (int b = 0; b < 8; ++b) {
        const f32x4 c0 = *(const f32x4*)(cact + b * DM + k), c1 = *(const f32x4*)(cact + b * DM + k + 4);
        acc[b] += c0[0] * wv[0] + c0[1] * wv[1] + c0[2] * wv[2] + c0[3] * wv[3] + c1[0] * wv[4] + c1[1] * wv[5] + c1[2] * wv[6] + c1[3] * wv[7];
      }
    }
#pragma unroll
    for (int b = 0; b < 8; ++b) red[(wid * 8 + b) * 64 + lane] = acc[b];
    __syncthreads();
#pragma unroll
    for (int h2 = 0; h2 < 2; ++h2) {
      const int b = (tid >> 6) + 4 * h2, c = tid & 63;
      const float sum = red[(0 * 8 + b) * 64 + c] + red[(1 * 8 + b) * 64 + c] + red[(2 * 8 + b) * 64 + c] + red[(3 * 8 + b) * 64 + c];
      WSF(p, mod)[((size_t)l * 8 + b) * 9216 + cb * 64 + c] = sum + p.ada_b[(size_t)l * 9216 + cb * 64 + c];
    }
    __syncthreads();
  }
}

DI void attn_item(const Params& p, int l, int item, char* lds) {
  const int tid = opaque_tid(), lane = tid & 63, w = tid >> 6, r = lane & 31, hf = lane >> 5;
  const int blk16 = item & 15, hh = (item >> 4) & 3, rest = item >> 6, g = rest % 3, b = rest / 3;
  const int d = (g == 0) ? 1 : (g == 1 ? 4 : 16);
  const int nbk = 16 / d, res = blk16 / nbk, nb = blk16 - res * nbk;
  const int qcol = g * 256 + hh * 64;
  const int Lsub = 2048 / d;
  const bf16_t* zq = WSB(p, zatt) + ((size_t)((((b * 3 + 0) * 3 + g) * 4 + hh) * 2048 + res * Lsub)) * 64;
  const bf16_t* zk = WSB(p, zatt) + ((size_t)((((b * 3 + 1) * 3 + g) * 4 + hh) * 2048 + res * Lsub)) * 64;
  const bf16_t* zv = WSB(p, zatt) + ((size_t)((((b * 3 + 2) * 3 + g) * 4 + hh) * 2048 + res * Lsub)) * 64;
  bf16_t* VT = (bf16_t*)lds;
  float* nrm = (float*)(lds + 64 * 528);
  if (tid < 128) nrm[tid] = (tid < 64) ? p.q_norm[l * 64 + tid] : p.k_norm[l * 64 + tid - 64];
  const int qi = 32 * w + r;
  const int tq = (128 * nb + qi) * d + res;
  u32x4 vraw[8], qraw[4], kraw[5][4];
  {
    const int lk = 128 * (nb - 1) + tid, lkc = lk < 0 ? 0 : lk;
    const u32x4* src = (const u32x4*)(zv + (size_t)lkc * 64);
#pragma unroll
    for (int i = 0; i < 8; ++i) vraw[i] = src[i];
    const bf16_t* qp = zq + (size_t)(128 * nb + qi) * 64 + 8 * hf;
#pragma unroll
    for (int s = 0; s < 4; ++s) qraw[s] = *(const u32x4*)(qp + 16 * s);
#pragma unroll
    for (int i = 0; i < 2; ++i) {
      const int lkk = 128 * (nb - 1) + 32 * (w + i) + r, lkkc = lkk < 0 ? 0 : lkk;
      const bf16_t* kp = zk + (size_t)lkkc * 64 + 8 * hf;
#pragma unroll
      for (int s = 0; s < 4; ++s) kraw[i][s] = *(const u32x4*)(kp + 16 * s);
    }
  }
  __builtin_amdgcn_sched_barrier(0);
  {
    const int key = tid;
#pragma unroll
    for (int i = 0; i < 8; ++i)
#pragma unroll
      for (int e = 0; e < 4; ++e) {
        constexpr int d0 = 0;
        const int da = 8 * i + 2 * e + d0, db = da + 1;
        VT[(32 * (da >> 5) + 8 * ((da >> 2) & 3) + 4 * ((da >> 4) & 1) + (da & 3)) * 264 + key] = (bf16_t)(vraw[i][e] & 0xffffu);
        VT[(32 * (db >> 5) + 8 * ((db >> 2) & 3) + 4 * ((db >> 4) & 1) + (db & 3)) * 264 + key] = (bf16_t)(vraw[i][e] >> 16);
      }
  }
  __syncthreads();
  bf16x8 qf[4];
  {
    float qv[4][8]; float ss = 0.f;
#pragma unroll
    for (int s = 0; s < 4; ++s) {
      unpack8(qraw[s], qv[s]);
#pragma unroll
      for (int j = 0; j < 8; ++j) ss += qv[s][j] * qv[s][j];
    }
    ss += shx(ss, 32, lane);
    const float rstd = __builtin_amdgcn_rsqf(ss * (1.f / 64.f) + EPS) * 0.125f;
#pragma unroll
    for (int s = 0; s < 4; ++s) {
      const float* gn = nrm + 16 * s + 8 * hf;
      float o[8];
#pragma unroll
      for (int j = 0; j < 8; ++j) o[j] = qv[s][j] * rstd * gn[j];
      qf[s] = __builtin_bit_cast(bf16x8, pack8(o));
    }
  }
  f32x16 st[5];
#pragma unroll
  for (int i = 0; i < 5; ++i) {
    if (i + 2 < 5 && (nb > 0 || w + i + 2 >= 4)) {
      const int lkk = 128 * (nb - 1) + 32 * (w + i + 2) + r, lkkc = lkk < 0 ? 0 : lkk;
      const bf16_t* kp = zk + (size_t)lkkc * 64 + 8 * hf;
#pragma unroll
      for (int s = 0; s < 4; ++s) kraw[i + 2][s] = *(const u32x4*)(kp + 16 * s);
    }
    __builtin_amdgcn_sched_barrier(0);
#pragma unroll
    for (int e = 0; e < 16; ++e) st[i][e] = 0.f;
    if (nb > 0 || w + i >= 4) {
      float kv[4][8]; float ss = 0.f;
#pragma unroll
      for (int s = 0; s < 4; ++s) {
        unpack8(kraw[i][s], kv[s]);
#pragma unroll
        for (int j = 0; j < 8; ++j) ss += kv[s][j] * kv[s][j];
      }
      ss += shx(ss, 32, lane);
      const float rstd = __builtin_amdgcn_rsqf(ss * (1.f / 64.f) + EPS);
#pragma unroll
      for (int s = 0; s < 4; ++s) {
        const float* gn = nrm + 64 + 16 * s + 8 * hf;
        float o[8];
#pragma unroll
        for (int j = 0; j < 8; ++j) o[j] = kv[s][j] * rstd * gn[j];
        const bf16x8 kf = __builtin_bit_cast(bf16x8, pack8(o));
        st[i] = MFMA32(kf, qf[s], st[i]);
      }
    }
  }
  float mx = -3.0e38f;
#pragma unroll
  for (int i = 0; i < 5; ++i)
#pragma unroll
    for (int e = 0; e < 16; ++e) {
      const int c = (e & 3) + 8 * (e >> 2) + 4 * hf;
      const bool valid = (nb > 0 || w + i >= 4) && (i == 0 ? c >= r : (i == 4 ? c <= r : true));
      st[i][e] = valid ? st[i][e] : -3.0e38f;
      mx = fmaxf(mx, st[i][e]);
    }
  mx = fmaxf(mx, shx(mx, 32, lane));
  float den = 0.f;
#pragma unroll
  for (int i = 0; i < 5; ++i)
#pragma unroll
    for (int e = 0; e < 16; ++e) {
      const float pe = (st[i][e] > -1.0e38f) ? __expf(st[i][e] - mx) : 0.f;
      st[i][e] = pe; den += pe;
    }
  den += shx(den, 32, lane);
  f32x16 ot[2];
#pragma unroll
  for (int dt = 0; dt < 2; ++dt)
#pragma unroll
    for (int e = 0; e < 16; ++e) ot[dt][e] = 0.f;
#pragma unroll
  for (int i = 0; i < 5; ++i)
#pragma unroll
    for (int s2 = 0; s2 < 2; ++s2) if (nb > 0 || w + i >= 4) {
      u32x4 pp;
      pp[0] = pk2(st[i][8 * s2 + 0], st[i][8 * s2 + 1]); pp[1] = pk2(st[i][8 * s2 + 2], st[i][8 * s2 + 3]);
      pp[2] = pk2(st[i][8 * s2 + 4], st[i][8 * s2 + 5]); pp[3] = pk2(st[i][8 * s2 + 6], st[i][8 * s2 + 7]);
      const bf16x8 pf = __builtin_bit_cast(bf16x8, pp);
#pragma unroll
      for (int dt = 0; dt < 2; ++dt) {
        const bf16_t* vp = VT + (32 * dt + r) * 264 + 32 * (w + i) + 16 * s2 + 4 * hf;
        const u32x2 lo = *(const u32x2*)vp, hi = *(const u32x2*)(vp + 8);
        u32x4 vv; vv[0] = lo[0]; vv[1] = lo[1]; vv[2] = hi[0]; vv[3] = hi[1];
        ot[dt] = MFMA32(__builtin_bit_cast(bf16x8, vv), pf, ot[dt]);
      }
    }
  const float inv = __builtin_amdgcn_rcpf(den);
  const size_t tok = (size_t)b * SEQ + tq;
#pragma unroll
  for (int dt = 0; dt < 2; ++dt)
#pragma unroll
    for (int h8 = 0; h8 < 2; ++h8) {
      float o[8];
#pragma unroll
      for (int e = 0; e < 8; ++e) o[e] = ot[dt][8 * h8 + e] * inv;
      *(u32x4*)(WSB(p, og) + tok * 768 + qcol + 32 * dt + 16 * hf + 8 * h8) = pack8(o);
    }
  if (hf == 0) WSF(p, lse)[tok * 12 + g * 4 + hh] = mx + __logf(den);
  __syncthreads();
}

DI int lnd(int v) { asm volatile("" : "+s"(v)); return v; }
DI void dn_f1_item(const Params& p, int l, int chunk, char* lds) {
  const int tid = opaque_tid(), lane = tid & 63, w = tid >> 6, fr = lane & 15, fq = lane >> 4;
  const int n = chunk & 31, bh = chunk >> 5, h = bh & 7, b = bh >> 3;
  const int t0 = n * 64;
  const size_t rowbase = (size_t)b * SEQ;
  bf16_t* Qn = (bf16_t*)lds;
  bf16_t* Kn = (bf16_t*)(lds + 17408);
  bf16_t* KB = (bf16_t*)(lds + 2 * 17408);
  bf16_t* Vs = (bf16_t*)(lds + 3 * 17408);
  float* gcs = (float*)(lds + 4 * 17408);
  float* betas = gcs + 64;
  float* egc = gcs + 128;
  float* Am = (float*)lds;
  if (w == 0) {
    const size_t row = rowbase + t0 + lane;
    const float a = WSF(p, ab)[row * 16 + h], bb = WSF(p, ab)[row * 16 + 8 + h];
    const float xx = a + p.dt_bias[l * 8 + h];
    const float sp = xx > 20.f ? xx : log1pf(__expf(xx));
    float s = -__expf(p.a_log[l * 8 + h]) * sp;
#pragma unroll
    for (int off = 1; off < 64; off <<= 1) { const float t = shup(s, off, lane); if (lane >= off) s += t; }
    gcs[lane] = s; betas[lane] = sigmoidf_(bb); egc[lane] = __expf(s);
    if (lane == 63) WSF(p, dGL)[chunk] = __expf(s);
  }
  __syncthreads();
  const float gclast = gcs[63];
  const int cg8 = (tid & 15) * 8, rg = tid >> 4;
#pragma unroll 1
  for (int seg = 0; seg < 3; ++seg) {
    u32x4 rows[7];
#pragma unroll
    for (int r = 0; r < 7; ++r) {
      const int tt = t0 + 4 * rg - 3 + r;
      rows[r] = (u32x4){0u, 0u, 0u, 0u};
      if (tt >= 0) rows[r] = *(const u32x4*)(WSB(p, zdn) + ((size_t)(((b * 8 + h) * 3 + seg) * 2048 + tt)) * 128 + cg8);
    }
    float cw[4][8];
#pragma unroll
    for (int tap = 0; tap < 4; ++tap) {
      const float* cp = p.conv_w + ((size_t)l * 4 + tap) * 3072 + seg * 1024 + h * 128 + cg8;
      const f32x4 c0 = *(const f32x4*)cp, c1 = *(const f32x4*)(cp + 4);
      cw[tap][0] = c0[0]; cw[tap][1] = c0[1]; cw[tap][2] = c0[2]; cw[tap][3] = c0[3];
      cw[tap][4] = c1[0]; cw[tap][5] = c1[1]; cw[tap][6] = c1[2]; cw[tap][7] = c1[3];
    }
#pragma unroll
    for (int jt = 0; jt < 4; ++jt) {
      const int i = 4 * rg + jt;
      float val[8];
#pragma unroll
      for (int e = 0; e < 8; ++e) val[e] = 0.f;
#pragma unroll
      for (int tap = 0; tap < 4; ++tap) {
        float xv[8]; unpack8(rows[jt + tap], xv);
#pragma unroll
        for (int e = 0; e < 8; ++e) val[e] += cw[tap][e] * xv[e];
      }
      float ss = 0.f;
#pragma unroll
      for (int e = 0; e < 8; ++e) { val[e] = siluf_(val[e]); ss += val[e] * val[e]; }
      ss = sum16(ss);
      const float rn = __builtin_amdgcn_rsqf(ss + EPS);
      if (seg == 0) {
        const float eg = egc[i];
        float qv[8], qd[8];
#pragma unroll
        for (int e = 0; e < 8; ++e) { qv[e] = val[e] * rn * 0.08838834764831845f; qd[e] = qv[e] * eg; }
        *(u32x4*)(Qn + i * 136 + cg8) = pack8(qv);
        *(u32x4*)(WSB(p, dQD) + ((size_t)lnd(chunk) * 64 + i) * 128 + cg8) = pack8(qd);
      } else if (seg == 1) {
        const float bt = betas[i];
        float kv[8], kb[8];
#pragma unroll
        for (int e = 0; e < 8; ++e) { kv[e] = val[e] * rn; kb[e] = kv[e] * bt; }
        *(u32x4*)(Kn + i * 136 + cg8) = pack8(kv);
        *(u32x4*)(KB + i * 136 + cg8) = pack8(kb);
      } else {
        *(u32x4*)(Vs + i * 136 + cg8) = pack8(val);
      }
    }
  }
  __syncthreads();
  {
    const int dcol = tid >> 1, half = tid & 1;
    u32x4 o4[4];
#pragma unroll
    for (int q = 0; q < 4; ++q)
#pragma unroll
      for (int e = 0; e < 4; ++e) {
        const int i0 = 32 * half + 8 * q + 2 * e;
        const float k0 = bf2f(Kn[i0 * 136 + dcol]) * __expf(gclast - gcs[i0]);
        const float k1 = bf2f(Kn[(i0 + 1) * 136 + dcol]) * __expf(gclast - gcs[i0 + 1]);
        o4[q][e] = pk2(k0, k1);
      }
    u32x4* dst = (u32x4*)(WSB(p, dKDT) + ((size_t)lnd(chunk) * 128 + dcol) * 64 + 32 * half);
#pragma unroll
    for (int q = 0; q < 4; ++q) dst[q] = o4[q];
  }
  f32x4 kk[4], qk[4];
#pragma unroll
  for (int nn = 0; nn < 4; ++nn) { kk[nn] = (f32x4){0.f, 0.f, 0.f, 0.f}; qk[nn] = (f32x4){0.f, 0.f, 0.f, 0.f}; }
#pragma unroll
  for (int s = 0; s < 4; ++s) {
    const bf16x8 akb = *(const bf16x8*)(KB + (16 * w + fr) * 136 + 32 * s + 8 * fq);
    const bf16x8 aq = *(const bf16x8*)(Qn + (16 * w + fr) * 136 + 32 * s + 8 * fq);
#pragma unroll
    for (int nn = 0; nn < 4; ++nn) {
      const bf16x8 bk = *(const bf16x8*)(Kn + (16 * nn + fr) * 136 + 32 * s + 8 * fq);
      kk[nn] = MFMA16(akb, bk, kk[nn]);
      qk[nn] = MFMA16(aq, bk, qk[nn]);
    }
  }
  __syncthreads();
#pragma unroll
  for (int nn = 0; nn < 4; ++nn)
#pragma unroll
    for (int j = 0; j < 4; ++j) {
      const int i = 16 * w + 4 * fq + j, jj = 16 * nn + fr;
      const float dec = __expf(fminf(gcs[i] - gcs[jj], 0.f));
      Am[i * 64 + jj] = (jj < i) ? kk[nn][j] * dec : 0.f;
      Kn[i * 72 + jj] = f2bf((jj <= i) ? qk[nn][j] * dec : 0.f);
    }
  __syncthreads();
#pragma unroll
  for (int ps = 0; ps < 2; ++ps) {
    const int id = tid + 256 * ps, i = id >> 3, c8 = (id & 7) * 8;
    *(u32x4*)(WSB(p, dAI) + ((size_t)lnd(chunk) * 64 + i) * 64 + c8) = *(const u32x4*)(Kn + i * 72 + c8);
  }
  {
    const int c = tid & 127; const bool isW = tid >= 128;
    const bf16_t* rsrc = isW ? KB : Vs;
    const float* msrc = isW ? egc : betas;
    float x[64];
#pragma unroll
    for (int i = 0; i < 64; ++i) x[i] = 0.f;
#pragma unroll
    for (int i = 0; i < 64; ++i) {
      const float rhs = bf2f(rsrc[i * 136 + c]) * msrc[i];
      float s0 = 0.f, s1 = 0.f, s2 = 0.f, s3 = 0.f;
#pragma unroll
      for (int j4 = 0; j4 < (i + 3) / 4; ++j4) {
        const f32x4 a = *(const f32x4*)(Am + i * 64 + 4 * j4);
        s0 += a[0] * x[4 * j4]; s1 += a[1] * x[4 * j4 + 1]; s2 += a[2] * x[4 * j4 + 2]; s3 += a[3] * x[4 * j4 + 3];
      }
      x[i] = rhs - ((s0 + s1) + (s2 + s3));
    }
    if (!isW) {
      u32x4* dst = (u32x4*)(WSB(p, dUT) + ((size_t)lnd(chunk) * 128 + c) * 64);
#pragma unroll
      for (int q = 0; q < 8; ++q) {
        u32x4 o; o[0] = pk2(x[8 * q], x[8 * q + 1]); o[1] = pk2(x[8 * q + 2], x[8 * q + 3]); o[2] = pk2(x[8 * q + 4], x[8 * q + 5]); o[3] = pk2(x[8 * q + 6], x[8 * q + 7]);
        dst[q] = o;
      }
    }
    __syncthreads();
    if (isW) {
#pragma unroll
      for (int i = 0; i < 64; ++i) Kn[i * 136 + c] = f2bf(x[i]);
    }
  }
  __syncthreads();
#pragma unroll
  for (int ps = 0; ps < 4; ++ps) {
    const int id = tid + 256 * ps, i = id >> 4, c8 = (id & 15) * 8;
    *(u32x4*)(WSB(p, dW) + ((size_t)lnd(chunk) * 64 + i) * 128 + c8) = *(const u32x4*)(Kn + i * 136 + c8);
  }
  __syncthreads();
}

#define LDS_BARRIER() do { asm volatile("s_waitcnt lgkmcnt(0)" ::: "memory"); __builtin_amdgcn_s_barrier(); asm volatile("" ::: "memory"); } while (0)
DI void dn_f2_item(const Params& p, int item, char* lds) {
  const int tid = opaque_tid(), lane = tid & 63, w = tid >> 6, fr = lane & 15, fq = lane >> 4;
  const int vs = item & 3, bh = item >> 2, h = bh & 7, b = bh >> 3;
  bf16_t* ST = (bf16_t*)lds;
  bf16_t* VT = (bf16_t*)(lds + 32 * 272);
  bf16_t* OT = (bf16_t*)(lds + 32 * 272 + 32 * 144);
  for (int i = tid; i < 32 * 136; i += 256) ST[i] = 0;
  f32x4 accS[2][2];
#pragma unroll
  for (int nn = 0; nn < 2; ++nn)
#pragma unroll
    for (int m = 0; m < 2; ++m) accS[nn][m] = (f32x4){0.f, 0.f, 0.f, 0.f};
  __syncthreads();
  bf16x8 naw[4], naq[4], naa[2], nak[2][2]; u32x2 nuu[2]; float ngl;
#define F2_LOAD(n_)                                                                                                     \
  {                                                                                                                     \
    const size_t chunk_ = (size_t)bh * 32 + (n_);                                                                       \
    const bf16_t* Wc = WSB(p, dW) + chunk_ * 8192; const bf16_t* QDc = WSB(p, dQD) + chunk_ * 8192;                     \
    const bf16_t* AIc = WSB(p, dAI) + chunk_ * 4096; const bf16_t* KDTc = WSB(p, dKDT) + chunk_ * 8192;                 \
    const bf16_t* UTc = WSB(p, dUT) + chunk_ * 8192;                                                                    \
    _Pragma("unroll") for (int s = 0; s < 4; ++s) {                                                                     \
      naw[s] = *(const bf16x8*)(Wc + (16 * w + fr) * 128 + 32 * s + 8 * fq);                                            \
      naq[s] = *(const bf16x8*)(QDc + (16 * w + fr) * 128 + 32 * s + 8 * fq);                                           \
    }                                                                                                                   \
    _Pragma("unroll") for (int s = 0; s < 2; ++s) {                                                                     \
      naa[s] = *(const bf16x8*)(AIc + (16 * w + fr) * 64 + 32 * s + 8 * fq);                                            \
      _Pragma("unroll") for (int nn = 0; nn < 2; ++nn) nak[s][nn] = *(const bf16x8*)(KDTc + (32 * w + 16 * nn + fr) * 64 + 32 * s + 8 * fq); \
    }                                                                                                                   \
    _Pragma("unroll") for (int m = 0; m < 2; ++m) nuu[m] = *(const u32x2*)(UTc + (vs * 32 + 16 * m + fr) * 64 + 16 * w + 4 * fq); \
    ngl = WSF(p, dGL)[chunk_];                                                                                          \
  }
  F2_LOAD(0);
  for (int n = 0; n < 32; ++n) {
    bf16x8 aw[4], aq[4], aa[2], ak[2][2]; u32x2 uu[2];
#pragma unroll
    for (int s = 0; s < 4; ++s) { aw[s] = naw[s]; aq[s] = naq[s]; }
#pragma unroll
    for (int s = 0; s < 2; ++s) { aa[s] = naa[s]; ak[s][0] = nak[s][0]; ak[s][1] = nak[s][1]; uu[s] = nuu[s]; }
    const float gl = ngl;
    if (n + 1 < 32) F2_LOAD(n + 1);
    f32x4 ws[2], qs[2];
#pragma unroll
    for (int m = 0; m < 2; ++m) { ws[m] = (f32x4){0.f, 0.f, 0.f, 0.f}; qs[m] = (f32x4){0.f, 0.f, 0.f, 0.f}; }
#pragma unroll
    for (int s = 0; s < 4; ++s) {
#pragma unroll
      for (int m = 0; m < 2; ++m) {
        const bf16x8 bs = *(const bf16x8*)(ST + (16 * m + fr) * 136 + 32 * s + 8 * fq);
        ws[m] = MFMA16(aw[s], bs, ws[m]);
        qs[m] = MFMA16(aq[s], bs, qs[m]);
      }
    }
#pragma unroll
    for (int m = 0; m < 2; ++m) {
      const float v0 = bflo(uu[m][0]) - ws[m][0], v1 = bfhi(uu[m][0]) - ws[m][1], v2 = bflo(uu[m][1]) - ws[m][2], v3 = bfhi(uu[m][1]) - ws[m][3];
      u32x2 o; o[0] = pk2(v0, v1); o[1] = pk2(v2, v3);
      *(u32x2*)(VT + (16 * m + fr) * 72 + 16 * w + 4 * fq) = o;
    }
    LDS_BARRIER();
    bf16x8 bv[2][2];
#pragma unroll
    for (int s = 0; s < 2; ++s)
#pragma unroll
      for (int m = 0; m < 2; ++m) bv[s][m] = *(const bf16x8*)(VT + (16 * m + fr) * 72 + 32 * s + 8 * fq);
#pragma unroll
    for (int s = 0; s < 2; ++s)
#pragma unroll
      for (int m = 0; m < 2; ++m) qs[m] = MFMA16(aa[s], bv[s][m], qs[m]);
#pragma unroll
    for (int m = 0; m < 2; ++m)
#pragma unroll
      for (int j = 0; j < 4; ++j) OT[(16 * w + 4 * fq + j) * 40 + 16 * m + fr] = f2bf(qs[m][j]);
#pragma unroll
    for (int nn = 0; nn < 2; ++nn)
#pragma unroll
      for (int m = 0; m < 2; ++m) accS[nn][m] = accS[nn][m] * gl;
#pragma unroll
    for (int s = 0; s < 2; ++s)
#pragma unroll
      for (int nn = 0; nn < 2; ++nn)
#pragma unroll
        for (int m = 0; m < 2; ++m) accS[nn][m] = MFMA16(ak[s][nn], bv[s][m], accS[nn][m]);
#pragma unroll
    for (int nn = 0; nn < 2; ++nn)
#pragma unroll
      for (int m = 0; m < 2; ++m) {
        u32x2 o; o[0] = pk2(accS[nn][m][0], accS[nn][m][1]); o[1] = pk2(accS[nn][m][2], accS[nn][m][3]);
        *(u32x2*)(ST + (16 * m + fr) * 136 + 32 * w + 16 * nn + 4 * fq) = o;
      }
    LDS_BARRIER();
    {
      const int tk = tid >> 2, c8 = (tid & 3) * 8;
      *(u32x4*)(WSB(p, oraw) + ((size_t)b * SEQ + n * 64 + tk) * DM + h * 128 + vs * 32 + c8) = *(const u32x4*)(OT + tk * 40 + c8);
    }
  }
#undef F2_LOAD
}

DI void elem_phase(const Params& p, int l) {
  const int tid = opaque_tid(), lane = tid & 63;
  const size_t stride = (size_t)VGRID * 256;
  for (size_t idx = (size_t)opaque_bid() * 256 + tid; idx < (size_t)MTOK * 32; idx += stride) {
    const size_t tok = idx >> 5; const int ch = (int)(idx & 31), hh = ch >> 3, d0 = (ch & 7) * 8;
    const float l0 = WSF(p, lse)[tok * 12 + hh], l1 = WSF(p, lse)[tok * 12 + 4 + hh], l2 = WSF(p, lse)[tok * 12 + 8 + hh];
    const float mx = fmaxf(l0, fmaxf(l1, l2));
    const float e0 = __expf(l0 - mx), e1 = __expf(l1 - mx), e2 = __expf(l2 - mx);
    const float inv = __builtin_amdgcn_rcpf(e0 + e1 + e2);
    const float wg[3] = {e0 * inv, e1 * inv, e2 * inv};
    float y[8];
#pragma unroll
    for (int e = 0; e < 8; ++e) y[e] = 0.f;
#pragma unroll
    for (int g = 0; g < 3; ++g) {
      const u32x4 raw = *(const u32x4*)(WSB(p, og) + tok * 768 + g * 256 + hh * 64 + d0);
      float v[8]; unpack8(raw, v);
#pragma unroll
      for (int e = 0; e < 8; ++e) y[e] += wg[g] * v[e];
    }
    *(u32x4*)(WSB(p, yatt) + tok * 256 + hh * 64 + d0) = pack8(y);
  }
  for (size_t idx = (size_t)opaque_bid() * 256 + tid; idx < (size_t)MTOK * 128; idx += stride) {
    const size_t tok = idx >> 7; const int col = (int)(idx & 127) * 8;
    const u32x4 raw = *(const u32x4*)(WSB(p, oraw) + tok * DM + col);
    float v[8]; unpack8(raw, v);
    float ss = 0.f;
#pragma unroll
    for (int e = 0; e < 8; ++e) ss += v[e] * v[e];
    ss = sum16(ss);
    const float rstd = __builtin_amdgcn_rsqf(ss * (1.f / 128.f) + EPS);
    const u32x4 graw = *(const u32x4*)(WSB(p, z) + tok * ZLD + Z_DNGATE + col);
    float gz[8]; unpack8(graw, gz);
    const float* gn = p.dn_norm + l * 128 + (col & 127);
    float y[8];
#pragma unroll
    for (int e = 0; e < 8; ++e) y[e] = v[e] * rstd * gn[e] * siluf_(gz[e]);
    *(u32x4*)(WSB(p, odn) + tok * DM + col) = pack8(y);
  }
}


#define XB_TMO      128
#define XB_XCNT(j)  (256  + 64 * (j))
#define XB_XSUB(j)  (1280 + 64 * (j))
#define XB_XGEN(j)  (2304 + 64 * (j))
#define XB_TOP      3328
#define XB_TOPGEN   3392
#define XCD_BAR_WORDS 3456
#define XB_SPIN_CAP (1u << 22)
#define LAS __attribute__((address_space(3)))
DI unsigned xb_ld(unsigned* p)              { return __hip_atomic_load(p, __ATOMIC_RELAXED, __HIP_MEMORY_SCOPE_AGENT); }
DI unsigned xb_add(unsigned* p, unsigned v) { return __hip_atomic_fetch_add(p, v, __ATOMIC_RELAXED, __HIP_MEMORY_SCOPE_AGENT); }
DI unsigned xb_xcc_id() { return (unsigned)__builtin_amdgcn_s_getreg((3 << 11) | 20) & 0xFu; }
#define XB_SPIN(cond, bar) do { unsigned _sp = 0; while (cond) { __builtin_amdgcn_s_sleep(1); \
    if ((++_sp & 255u) == 0u) { if (xb_ld(&(bar)[XB_TMO])) break; if (_sp > XB_SPIN_CAP) { atomicAdd(&(bar)[XB_TMO], 1u); break; } } } } while (0)
struct XcdBarrier { unsigned* bar; unsigned x; volatile LAS unsigned* st; };
DI XcdBarrier xcd_barrier_post(unsigned* bar, volatile LAS unsigned* st) {
  XcdBarrier b; b.bar = bar; b.x = xb_xcc_id(); b.st = st;
  if (threadIdx.x == 0) (void)xb_add(&bar[XB_XCNT(b.x)], 1u);
  return b;
}
DI void xcd_barrier_complete(unsigned* bar, unsigned x, unsigned& nloc, unsigned& nx) {
  const unsigned G = gridDim.x * gridDim.y * gridDim.z;
  unsigned sum, cnt, mine, sp = 0u;
  for (;;) {
    sum = 0u; cnt = 0u; mine = 0u;
#pragma unroll
    for (unsigned j = 0; j < 16; ++j) { const unsigned c = xb_ld(&bar[XB_XCNT(j)]); sum += c; cnt += (c > 0u) ? 1u : 0u; mine = (j == x) ? c : mine; }
    if (sum == G) break;
    __builtin_amdgcn_s_sleep(1);
    if ((++sp & 255u) == 0u) { if (xb_ld(&bar[XB_TMO])) break; if (sp > XB_SPIN_CAP) { atomicAdd(&bar[XB_TMO], 1u); break; } }
  }
  nloc = mine > 0u ? mine : 1u; nx = cnt > 0u ? cnt : 1u;
}
DI void xcd_barrier_impl(const XcdBarrier& b) {
  asm volatile("s_waitcnt vmcnt(0)" ::: "memory");
  __syncthreads();
  if (threadIdx.x == 0) {
    unsigned* bar = b.bar; asm volatile("" : "+s"(bar));
    __builtin_amdgcn_s_waitcnt(0);
    const unsigned nloc = b.st[0], nx = b.st[1];
    const unsigned old = xb_add(&bar[XB_XSUB(b.x)], 1u);
    const unsigned gen = old / nloc;
    if (old + 1u == (gen + 1u) * nloc) {
      __builtin_amdgcn_fence(__ATOMIC_RELEASE, "agent");
      asm volatile("s_waitcnt vmcnt(0)" ::: "memory");
      const unsigned og = xb_add(&bar[XB_TOP], 1u);
      const unsigned tg = og / nx;
      if (og + 1u == (tg + 1u) * nx) xb_add(&bar[XB_TOPGEN], 1u);
      else XB_SPIN(xb_ld(&bar[XB_TOPGEN]) == tg, bar);
      __builtin_amdgcn_fence(__ATOMIC_ACQUIRE, "agent");
      xb_add(&bar[XB_XGEN(b.x)], 1u);
      asm volatile("s_waitcnt vmcnt(0)" ::: "memory");
    } else {
      XB_SPIN(xb_ld(&bar[XB_XGEN(b.x)]) == gen, bar);
      __builtin_amdgcn_fence(__ATOMIC_ACQUIRE, "agent");
      asm volatile("s_waitcnt vmcnt(0)" ::: "memory");
    }
  }
  __syncthreads();
}

DI void xcd_barrier_census(char* ws, char* lds) {
  if (threadIdx.x == 0) {
    unsigned nloc, nx; xcd_barrier_complete((unsigned*)(ws + O_bar), xb_xcc_id(), nloc, nx);
    volatile LAS unsigned* st = (volatile LAS unsigned*)(lds + LDS_BYTES); st[0] = nloc; st[1] = nx;
  }
  __syncthreads();
}
DI void xcd_barrier_ws(char* ws, char* lds) {
  XcdBarrier b; b.bar = (unsigned*)(ws + O_bar); b.x = xb_xcc_id(); b.st = (volatile LAS unsigned*)(lds + LDS_BYTES);
  xcd_barrier_impl(b);
}
__global__ void __launch_bounds__(512, 2) fwd_megakernel(Params p) {
  __shared__ __attribute__((aligned(16))) char lds[LDS_BYTES + 16];
  cg::grid_group grid = cg::this_grid();
  if (threadIdx.x == 0) { *(volatile LAS unsigned*)(lds + LDS_BYTES) = 0u; *(volatile LAS unsigned*)(lds + LDS_BYTES + 4) = 0u; }
  __syncthreads();
  (void)xcd_barrier_post((unsigned*)(p.ws + O_bar), (volatile LAS unsigned*)(lds + LDS_BYTES));
  phase0(p, vlds(lds));
  convert_layer(p, 0, vlds(lds), opaque_bid(), VGRID);
  grid.sync();
  xcd_barrier_census(p.ws, lds);
  for (int l = 0; l < DEPTH; ++l) {
    const float* modl = WSF(p, mod) + (size_t)l * 8 * 9216;
    norm_phase(p, l == 0 ? p.x : p.out, p.norm_ff1 + l * DM, modl + 0 * DM, modl + 1 * DM);
    xcd_barrier_ws(p.ws, lds);
    gemm_up_phase(p, WSW(p, W_up1, l), lds);
    xcd_barrier_ws(p.ws, lds);
    gemm_res_phase(p, l == 0 ? p.x : p.out, WSB(p, hidden), DFF, WSW(p, W_down1, l), modl + 2 * DM, 0.5f, lds);
    xcd_barrier_ws(p.ws, lds);
    norm_phase(p, p.out, p.norm_mix + l * DM, modl + 3 * DM, modl + 4 * DM);
    xcd_barrier_ws(p.ws, lds);
    gemm_in_phase(p, WSW(p, W_in, l), lds);
    xcd_barrier_ws(p.ws, lds);
    {
      char* vl = vlds(lds);
      for (int it = opaque_bid(); it < 2048 + 512; it += VGRID) {
        if (it < 2048) dn_f1_item(p, l, it, vl); else attn_item(p, l, it - 2048, vl);
      }
    }
    xcd_barrier_ws(p.ws, lds);
    {
      char* vl = vlds(lds);
      const int vb = opaque_bid();
      if (vb < 256) dn_f2_item(p, vb, vl);
      else {
        for (int it = 512 + vb - 256; it < 1536; it += VGRID - 256) attn_item(p, l, it, vl);
        if (l + 1 < DEPTH) convert_layer(p, l + 1, vl, vb - 256, VGRID - 256);
      }
    }
    xcd_barrier_ws(p.ws, lds);
    elem_phase(p, l);
    xcd_barrier_ws(p.ws, lds);
    gemm_proj_phase(p, WSW(p, W_pa, l), WSW(p, W_pd, l), lds);
    xcd_barrier_ws(p.ws, lds);
    gemm_res_phase(p, p.out, WSB(p, mrg), DM, WSW(p, W_out, l), modl + 5 * DM, 1.0f, lds);
    xcd_barrier_ws(p.ws, lds);
    norm_phase(p, p.out, p.norm_ff2 + l * DM, modl + 6 * DM, modl + 7 * DM);
    xcd_barrier_ws(p.ws, lds);
    gemm_up_phase(p, WSW(p, W_up2, l), lds);
    xcd_barrier_ws(p.ws, lds);
    gemm_res_phase(p, p.out, WSB(p, hidden), DFF, WSW(p, W_down2, l), modl + 8 * DM, 0.5f, lds);
    xcd_barrier_ws(p.ws, lds);
  }
}

extern "C" void kernel_launch(void* const* d_in, const int* in_sizes, int n_in, void* d_out, int out_size, void* d_ws, size_t ws_size, hipStream_t stream) {
  static int grid_blocks = 0;
  if (!grid_blocks) {
    int dev = 0, cus = 0, per_cu = 0;
    hipGetDevice(&dev);
    hipDeviceGetAttribute(&cus, hipDeviceAttributeMultiprocessorCount, dev);
    hipOccupancyMaxActiveBlocksPerMultiprocessor(&per_cu, fwd_megakernel, 512, 0);
    if (per_cu > 1) per_cu = 1;
    grid_blocks = cus * per_cu;
    if (grid_blocks % 8) grid_blocks -= grid_blocks % 8;
  }
  Params p{};
  const float* const* in = (const float* const*)d_in;
  p.x = in[0]; p.c = in[1]; p.ada_w = in[2]; p.ada_b = in[3]; p.norm_ff1 = in[4]; p.w_up1 = in[5]; p.w_down1 = in[6]; p.norm_mix = in[7];
  p.w_in = in[8]; p.q_norm = in[9]; p.k_norm = in[10]; p.conv_w = in[11]; p.a_log = in[12]; p.dt_bias = in[13]; p.dn_norm = in[14];
  p.w_pa = in[15]; p.w_pd = in[16]; p.w_out = in[17]; p.norm_ff2 = in[18]; p.w_up2 = in[19]; p.w_down2 = in[20];
  p.out = (float*)d_out;
  p.ws = (char*)d_ws;
  if (WS_TOTAL > ws_size) { fprintf(stderr, "kernel_launch: workspace too small (%zu needed, %zu given)\n", (size_t)WS_TOTAL, ws_size); return; }
  if (hipMemsetAsync(p.ws + O_bar, 0, (size_t)3456 * 4, stream) != hipSuccess) fprintf(stderr, "kernel_launch: barrier memset failed\n");
  void* args[] = {&p};
  hipError_t e = hipLaunchCooperativeKernel((void*)fwd_megakernel, dim3(grid_blocks), dim3(512), args, 0, stream);
  if (e != hipSuccess) fprintf(stderr, "cooperative launch failed: %s (grid %d)\n", hipGetErrorString(e), grid_blocks);
}
```

```cpp
#include <hip/hip_runtime.h>
#include <hip/hip_cooperative_groups.h>
#include <cstdio>
#include <cstdint>
namespace cg = cooperative_groups;

typedef unsigned short bf16_t;
typedef short bf16x8 __attribute__((ext_vector_type(8)));
typedef short s16x4 __attribute__((ext_vector_type(4)));
typedef float f32x4 __attribute__((ext_vector_type(4)));
typedef float f32x16 __attribute__((ext_vector_type(16)));
typedef unsigned u32x4 __attribute__((ext_vector_type(4)));
typedef unsigned u32x2 __attribute__((ext_vector_type(2)));

#define DI __device__ __forceinline__
#define MFMA16(a, b, c) __builtin_amdgcn_mfma_f32_16x16x32_bf16((a), (b), (c), 0, 0, 0)
#define MFMA32(a, b, c) __builtin_amdgcn_mfma_f32_32x32x16_bf16((a), (b), (c), 0, 0, 0)

constexpr int DM = 1024, NB = 8, SEQ = 2048, MTOK = NB * SEQ, DFF = 2816, DEPTH = 4;
constexpr int ZLD = 3072;
constexpr int NINP = 8704;
constexpr int Z_DNGATE = 0, Z_MERGE = 1024;
constexpr int LDS_BYTES = 147456;
constexpr int VLDS = 73728;
constexpr int LROW = 144;
constexpr int TILE_BYTES = 256 * LROW;
constexpr int STAGE_BYTES = 2 * TILE_BYTES;
constexpr float EPS = 1e-6f;

struct Params {
  const float *x, *c, *ada_w, *ada_b, *norm_ff1, *w_up1, *w_down1, *norm_mix, *w_in, *q_norm, *k_norm, *conv_w, *a_log, *dt_bias,
      *dn_norm, *w_pa, *w_pd, *w_out, *norm_ff2, *w_up2, *w_down2;
  float* out;
  char* ws;
};
constexpr size_t al256(size_t b) { return (b + 255) & ~(size_t)255; }
constexpr size_t O_W_up1 = 0;
constexpr size_t O_W_down1 = O_W_up1 + al256((size_t)2 * DFF * DM * 2);
constexpr size_t O_W_in = O_W_down1 + al256((size_t)DM * DFF * 2);
constexpr size_t O_W_pa = O_W_in + al256((size_t)NINP * DM * 2);
constexpr size_t O_W_pd = O_W_pa + al256((size_t)DM * 256 * 2);
constexpr size_t O_W_out = O_W_pd + al256((size_t)DM * DM * 2);
constexpr size_t O_W_up2 = O_W_out + al256((size_t)DM * DM * 2);
constexpr size_t O_W_down2 = O_W_up2 + al256((size_t)2 * DFF * DM * 2);
constexpr size_t WSET_BYTES = O_W_down2 + al256((size_t)DM * DFF * 2);
constexpr size_t O_h = 2 * WSET_BYTES;
constexpr size_t O_z = O_h + al256((size_t)MTOK * DM * 2);
constexpr size_t O_zatt = O_z + al256((size_t)MTOK * ZLD * 2);
constexpr size_t O_zdn = O_zatt + al256((size_t)MTOK * 2304 * 2);
constexpr size_t O_hidden = O_zatt;
constexpr size_t O_og = O_zdn + al256((size_t)MTOK * 3072 * 2);
constexpr size_t O_yatt = O_og + al256((size_t)MTOK * 768 * 2);
constexpr size_t O_dW = O_yatt + al256((size_t)MTOK * 256 * 2);
constexpr size_t O_dUT = O_dW + al256((size_t)MTOK * DM * 2);
constexpr size_t O_mrg = O_dUT;
constexpr size_t O_dQD = O_dUT + al256((size_t)MTOK * DM * 2);
constexpr size_t O_dKDT = O_dQD + al256((size_t)MTOK * DM * 2);
constexpr size_t O_dAI = O_dKDT + al256((size_t)MTOK * DM * 2);
constexpr size_t O_oraw = O_dAI + al256((size_t)2048 * 4096 * 2);
constexpr size_t O_odn = O_dW;
constexpr size_t O_ab = O_oraw + al256((size_t)MTOK * DM * 2);
constexpr size_t O_mod = O_ab + al256((size_t)MTOK * 16 * 4);
constexpr size_t O_lse = O_mod + al256((size_t)DEPTH * 8 * 9216 * 4);
constexpr size_t O_dGL = O_lse + al256((size_t)MTOK * 12 * 4);
constexpr size_t O_bar = O_dGL + al256((size_t)2048 * 4);
constexpr size_t WS_TOTAL = O_bar + al256((size_t)3456 * 4);
#define WSB(p, name) ((bf16_t*)((p).ws + O_##name))
#define WSW(p, name, l_) ((bf16_t*)((p).ws + O_##name + (size_t)((l_) & 1) * WSET_BYTES))
#define WSF(p, name) ((float*)((p).ws + O_##name))

DI int opaque_tid() { int t = threadIdx.x; asm volatile("" : "+v"(t)); return t & 255; }
DI int real_tid() { int t = threadIdx.x; asm volatile("" : "+v"(t)); return t; }
DI int opaque_bid() { int h = threadIdx.x; asm volatile("" : "+v"(h)); int t = blockIdx.x; asm volatile("" : "+s"(t)); return t * 2 + __builtin_amdgcn_readfirstlane(h >> 8); }
DI int real_bid() { int t = blockIdx.x; asm volatile("" : "+s"(t)); return t; }
#define VGRID ((int)gridDim.x * 2)
DI char* vlds(char* lds) { unsigned t = threadIdx.x; asm volatile("" : "+v"(t)); unsigned off = (t >> 8) * VLDS; asm volatile("" : "+v"(off)); return lds + off; }
typedef float f32x2 __attribute__((ext_vector_type(2)));
typedef __bf16 hwbf16x2 __attribute__((ext_vector_type(2)));
DI unsigned pk2(float lo, float hi) { const f32x2 v = {lo, hi}; return __builtin_bit_cast(unsigned, __builtin_convertvector(v, hwbf16x2)); }
DI unsigned short f2bf(float x) { return (unsigned short)(pk2(x, 0.f) & 0xffffu); }
DI float bf2f(unsigned short v) { return __uint_as_float(((unsigned)v) << 16); }
DI float bflo(unsigned u) { return __uint_as_float(u << 16); }
DI float bfhi(unsigned u) { return __uint_as_float(u & 0xffff0000u); }
DI float shx(float v, int mask, int lane) { return __int_as_float(__builtin_amdgcn_ds_bpermute((lane ^ mask) << 2, __float_as_int(v))); }
DI float shup(float v, int off, int lane) { return __int_as_float(__builtin_amdgcn_ds_bpermute((lane - off) << 2, __float_as_int(v))); }
#define DPPF(v_, ctrl_) __int_as_float(__builtin_amdgcn_update_dpp(0, __float_as_int(v_), (ctrl_), 0xF, 0xF, true))
DI float sum16(float v) { v += DPPF(v, 0xB1); v += DPPF(v, 0x4E); v += DPPF(v, 0x141); v += DPPF(v, 0x140); return v; }
DI float sigmoidf_(float x) { return __builtin_amdgcn_rcpf(1.f + __expf(-x)); }
DI float siluf_(float x) { return x * __builtin_amdgcn_rcpf(1.f + __expf(-x)); }
DI void unpack8(const u32x4& r, float (&v)[8]) {
  v[0] = bflo(r[0]); v[1] = bfhi(r[0]); v[2] = bflo(r[1]); v[3] = bfhi(r[1]);
  v[4] = bflo(r[2]); v[5] = bfhi(r[2]); v[6] = bflo(r[3]); v[7] = bfhi(r[3]);
}
DI u32x4 pack8(const float (&v)[8]) { u32x4 r; r[0] = pk2(v[0], v[1]); r[1] = pk2(v[2], v[3]); r[2] = pk2(v[4], v[5]); r[3] = pk2(v[6], v[7]); return r; }

template <int MH> DI void gemm_core_simple(const bf16_t* __restrict__ A, int lda, const bf16_t* __restrict__ Bt, int ldb, int K, f32x4 (&acc)[MH][4], char* lds) {
  const int tid = real_tid(), lane = tid & 63, wid = tid >> 6, wr = wid >> 2, wc = wid & 3, fr = lane & 15, fq = lane >> 4;
  const int sl = lane ^ ((lane >> 5) << 1);
  const int R0 = (wid >> 1) * 16 + (sl >> 2), C0 = (wid & 1) * 32 + (sl & 3) * 8;
  const bf16_t* gA = A + (size_t)R0 * lda + C0;
  const bf16_t* gB = Bt + (size_t)R0 * ldb + C0;
  const size_t sA = (size_t)64 * lda, sB = (size_t)64 * ldb;
  unsigned st_off = (unsigned)tid * 16u;
  const unsigned rd_off = (unsigned)((fr * 64 + fq * 16) ^ ((fr >> 3) << 5));
  unsigned rd_a = (unsigned)(wr * (MH * 2048)) + rd_off;
  unsigned rd_b = 32768u + (unsigned)(wc * 4096) + rd_off;
  asm volatile("" : "+v"(st_off), "+v"(rd_a), "+v"(rd_b));
  const int nk = K >> 6;
#define GSTAGE(sbase_, k0_)                                                                                                        \
  {                                                                                                                                \
    _Pragma("unroll") for (int j = 0; j < 4; ++j) {                                                                                \
      if (j < MH / 2) __builtin_amdgcn_global_load_lds((const unsigned*)(gA + j * sA + (k0_)), (unsigned*)(lds + ((sbase_) + j * 8192 + st_off)), 16, 0, 0);          \
      __builtin_amdgcn_global_load_lds((const unsigned*)(gB + j * sB + (k0_)), (unsigned*)(lds + ((sbase_) + 32768 + j * 8192 + st_off)), 16, 0, 0);  \
    }                                                                                                                              \
  }
  GSTAGE(0u, 0);
  asm volatile("s_waitcnt vmcnt(0)" ::: "memory");
  __syncthreads();
#pragma unroll 1
  for (int kt = 0; kt < nk; ++kt) {
    const unsigned sbase = (unsigned)(kt & 1) << 16;
    if (kt + 1 < nk) GSTAGE(65536u - sbase, (kt + 1) * 64);
    const char* pa = lds + (rd_a + sbase);
    const char* pb = lds + (rd_b + sbase);
    bf16x8 af[2 * MH], b0[4], b1[4];
    constexpr int B1S = MH >= 5 ? MH - 5 : 0;
#define RDA(g_) af[g_] = *(const bf16x8*)(pa + ((g_) % MH) * 2048 + ((g_) / MH) * 1024)
#define RDB(ks_, n_) *(const bf16x8*)(pb + ((n_) >> 1) * 16384 + ((n_) & 1) * 2048 + (ks_) * 1024)
    b0[0] = RDB(0, 0); b0[1] = RDB(0, 1); b0[2] = RDB(0, 2); b0[3] = RDB(0, 3);
    RDA(0); RDA(1); RDA(2);
    __builtin_amdgcn_sched_barrier(0);
#pragma unroll
    for (int g = 0; g < 2 * MH; ++g) {
      if (g + 3 < 2 * MH) RDA(g + 3);
      if (g >= B1S && g < B1S + 4) b1[g - B1S] = RDB(1, g - B1S);
      __builtin_amdgcn_sched_barrier(0);
      if (g < MH) {
#pragma unroll
        for (int n = 0; n < 4; ++n) acc[g % MH][n] = MFMA16(b0[n], af[g], acc[g % MH][n]);
      } else {
#pragma unroll
        for (int n = 0; n < 4; ++n) acc[g % MH][n] = MFMA16(b1[n], af[g], acc[g % MH][n]);
      }
      __builtin_amdgcn_sched_barrier(0);
    }
#undef RDA
#undef RDB
    asm volatile("s_waitcnt vmcnt(0)" ::: "memory");
    __syncthreads();
  }
#undef GSTAGE
}

DI void gemm_core(const bf16_t* __restrict__ A, int lda, const bf16_t* __restrict__ Bt, int ldb, int K, f32x4 (&acc)[8][4], char* lds) {
  const int tid = real_tid(), lane = tid & 63, wid = tid >> 6, wr = wid >> 2, wc = wid & 3, fr = lane & 15, fq = lane >> 4;
  const int sl = lane ^ ((lane >> 5) << 1);
  const int R0 = (wid >> 1) * 16 + (sl >> 2), C0 = (wid & 1) * 32 + (sl & 3) * 8;
  const bf16_t* gA = A + (size_t)R0 * lda + C0;
  const bf16_t* gB = Bt + (size_t)R0 * ldb + C0;
  const size_t sA = (size_t)64 * lda, sB = (size_t)64 * ldb;
  const unsigned rd_off = (unsigned)((fr * 64 + fq * 16) ^ ((fr >> 3) << 5));
  unsigned st0 = (unsigned)tid * 16u, st1 = st0 + 65536u;
  unsigned ra0 = (unsigned)(wr * 8192) + rd_off, ra1 = ra0 + 65536u;
  unsigned rb0 = 32768u + (unsigned)(wc * 4096) + rd_off, rb1 = rb0 + 65536u;
  asm volatile("" : "+v"(st0), "+v"(st1), "+v"(ra0), "+v"(ra1), "+v"(rb0), "+v"(rb1));
  const int nt = K >> 6;
  bf16x8 At[4][2], B0[2][2], B1[2][2];
#define STG_A(b_, h_, kt_) { const bf16_t* g_ = gA + (size_t)((h_) * 128) * lda + (size_t)(kt_) * 64; char* d_ = lds + (((b_) ? st1 : st0) + (h_) * 16384); \
    __builtin_amdgcn_global_load_lds((const unsigned*)g_, (unsigned*)d_, 16, 0, 0); __builtin_amdgcn_global_load_lds((const unsigned*)(g_ + sA), (unsigned*)(d_ + 8192), 16, 0, 0); }
#define STG_B(b_, h_, kt_) { const bf16_t* g_ = gB + (size_t)((h_) * 128) * ldb + (size_t)(kt_) * 64; char* d_ = lds + (((b_) ? st1 : st0) + 32768 + (h_) * 16384); \
    __builtin_amdgcn_global_load_lds((const unsigned*)g_, (unsigned*)d_, 16, 0, 0); __builtin_amdgcn_global_load_lds((const unsigned*)(g_ + sB), (unsigned*)(d_ + 8192), 16, 0, 0); }
#define LDA(b_, h_) { const char* s_ = lds + (((b_) ? ra1 : ra0) + (h_) * 16384); \
    _Pragma("unroll") for (int m = 0; m < 4; ++m) _Pragma("unroll") for (int k = 0; k < 2; ++k) At[m][k] = *(const bf16x8*)(s_ + m * 2048 + k * 1024); }
#define LDB(dst_, b_, h_) { const char* s_ = lds + (((b_) ? rb1 : rb0) + (h_) * 16384); \
    _Pragma("unroll") for (int n = 0; n < 2; ++n) _Pragma("unroll") for (int k = 0; k < 2; ++k) dst_[n][k] = *(const bf16x8*)(s_ + n * 2048 + k * 1024); }
#define MMA(ai_, bj_, Bx_) { __builtin_amdgcn_s_setprio(3); \
    _Pragma("unroll") for (int m = 0; m < 4; ++m) _Pragma("unroll") for (int n = 0; n < 2; ++n) _Pragma("unroll") for (int k = 0; k < 2; ++k) \
      acc[(ai_) * 4 + m][(bj_) * 2 + n] = MFMA16(Bx_[n][k], At[m][k], acc[(ai_) * 4 + m][(bj_) * 2 + n]); \
    __builtin_amdgcn_s_setprio(0); }
#define WAIT_V(n_) asm volatile("s_waitcnt vmcnt(" #n_ ")" ::: "memory")
#define WAIT_L(n_) asm volatile("s_waitcnt lgkmcnt(" #n_ ")" ::: "memory")
#define BAR __builtin_amdgcn_s_barrier()
#define SCHED __builtin_amdgcn_sched_barrier(0)
  WAIT_V(0);
  STG_B(0, 0, 0); STG_A(0, 0, 0); STG_B(0, 1, 0); STG_A(0, 1, 0);
  if (wr == 1) BAR;
  WAIT_V(4); BAR;
  STG_B(1, 0, 1); STG_A(1, 0, 1); STG_B(1, 1, 1);
  WAIT_V(6); BAR;
#pragma unroll 1
  for (int t = 0; t < nt - 2; t += 2) {
    LDB(B0, 0, 0); SCHED; LDA(0, 0); STG_A(1, 1, t + 1);
    WAIT_L(8); BAR; WAIT_L(0); MMA(0, 0, B0); BAR; SCHED;
    LDB(B1, 0, 1); STG_B(0, 0, t + 2);
    BAR; WAIT_L(0); MMA(0, 1, B1); BAR;
    LDA(0, 1); STG_A(0, 0, t + 2);
    BAR; WAIT_L(0); MMA(1, 0, B0); BAR; SCHED;
    STG_B(0, 1, t + 2);
    WAIT_V(6); BAR; MMA(1, 1, B1); BAR;
    LDB(B0, 1, 0); SCHED; LDA(1, 0); STG_A(0, 1, t + 2);
    WAIT_L(8); BAR; WAIT_L(0); MMA(0, 0, B0); BAR; SCHED;
    LDB(B1, 1, 1); STG_B(1, 0, t + 3);
    BAR; WAIT_L(0); MMA(0, 1, B1); BAR;
    LDA(1, 1); STG_A(1, 0, t + 3);
    BAR; WAIT_L(0); MMA(1, 0, B0); BAR; SCHED;
    STG_B(1, 1, t + 3);
    WAIT_V(6); BAR; MMA(1, 1, B1); BAR;
  }
  { LDB(B0, 0, 0); LDA(0, 0); STG_A(1, 1, nt - 1);
    BAR; WAIT_L(0); MMA(0, 0, B0); BAR;
    LDB(B1, 0, 1); BAR; WAIT_L(0); MMA(0, 1, B1); BAR;
    LDA(0, 1); WAIT_V(4); BAR; WAIT_L(0); MMA(1, 0, B0); MMA(1, 1, B1); BAR; }
  { LDB(B0, 1, 0); LDA(1, 0); WAIT_V(2); BAR; WAIT_L(0); MMA(0, 0, B0); BAR;
    LDB(B1, 1, 1); WAIT_V(0); BAR; WAIT_L(0); MMA(0, 1, B1); BAR;
    LDA(1, 1); BAR; WAIT_L(0); MMA(1, 0, B0); MMA(1, 1, B1); BAR; }
  if (wr == 0) BAR;
#undef STG_A
#undef STG_B
#undef LDA
#undef LDB
#undef MMA
#undef WAIT_V
#undef WAIT_L
#undef BAR
#undef SCHED
}

DI void tile_decode(int t, int& mt, int& nt) {
  const int xcd = t & 7, local = t >> 3;
  mt = 8 * xcd + (local & 7); nt = local >> 3;
}
template <int MH> DI void zero_acc(f32x4 (&acc)[MH][4]) {
#pragma unroll
  for (int m = 0; m < MH; ++m)
#pragma unroll
    for (int n = 0; n < 4; ++n) acc[m][n] = (f32x4){0.f, 0.f, 0.f, 0.f};
}
#define GEMM_IDS const int tid = real_tid(), lane = tid & 63, wid = tid >> 6, wr = wid >> 2, wc = wid & 3, fr = lane & 15, fq = lane >> 4
#define GEMM_IDS_AGAIN const int tid = real_tid(), lane = tid & 63, wid = tid >> 6, wr = wid >> 2, wc = wid & 3, fr = lane & 15, fq = lane >> 4; (void)lane; (void)wr; (void)wc
#define EROW(m) ((size_t)mt * 256 + ((m) >> 2) * 128 + wr * 64 + ((m) & 3) * 16 + fr)
#define ECOL8(bj) (nt * 256 + (bj) * 128 + wc * 32 + fq * 8)

template <int MH> DI void up_epilogue(const Params& p, const f32x4 (&acc)[MH][4], int mt, int half, int nt, int wr, int wc, int fr, int fq) {
#pragma unroll
  for (int m = 0; m < MH; ++m) {
    const size_t row = (size_t)mt * 256 + (MH == 8 ? (m >> 2) : half) * 128 + wr * 64 + (m & 3) * 16 + fr;
    const int hc = nt * 128 + wc * 32 + fq * 8;
    float o[8];
#pragma unroll
    for (int n = 0; n < 2; ++n)
#pragma unroll
      for (int j = 0; j < 4; ++j) { const float g = acc[m][n][j], u = acc[m][n + 2][j]; o[4 * n + j] = siluf_(g) * u; }
    *(u32x4*)(WSB(p, hidden) + row * DFF + hc) = pack8(o);
  }
}
DI void tail_decode(int bid, int nfull, int& mt, int& nt, int& half) { tile_decode(nfull + ((bid >> 4) << 3) + (bid & 7), mt, nt); half = (bid >> 3) & 1; }

DI void gemm_up_phase(const Params& p, const bf16_t* Bt, char* lds) {
  GEMM_IDS; (void)lane;
  constexpr int NT = 22, NFULL = (64 * NT / 256) * 256;
  for (int t = real_bid(); t < 64 * NT; t += gridDim.x) {
    int mt, nt; tile_decode(t, mt, nt);
    f32x4 acc[8][4]; zero_acc(acc);
    gemm_core(WSB(p, h) + (size_t)mt * 256 * DM, DM, Bt + (size_t)nt * 256 * DM, DM, DM, acc, lds);
    GEMM_IDS_AGAIN;
    up_epilogue<8>(p, acc, mt, 0, nt, wr, wc, fr, fq);
  }
}

DI void gemm_res_phase(const Params& p, const float* xin, const bf16_t* A, int K, const bf16_t* Bt, const float* gate, float coef, char* lds) {
  GEMM_IDS; (void)lane;
  constexpr int NT = 4;
  for (int t = real_bid(); t < 64 * NT; t += gridDim.x) {
    int mt, nt; tile_decode(t, mt, nt);
    f32x4 acc[8][4]; zero_acc(acc);
    gemm_core(A + (size_t)mt * 256 * K, K, Bt + (size_t)nt * 256 * K, K, K, acc, lds);
    GEMM_IDS_AGAIN;
    const int b = mt >> 3;
#pragma unroll
    for (int bj = 0; bj < 2; ++bj) {
      const int col = ECOL8(bj);
      const f32x4 g0 = *(const f32x4*)(gate + (size_t)b * 9216 + col), g1 = *(const f32x4*)(gate + (size_t)b * 9216 + col + 4);
#pragma unroll
      for (int m = 0; m < 8; ++m) {
        const size_t xo = EROW(m) * DM + col;
        f32x4 x0 = *(const f32x4*)(xin + xo), x1 = *(const f32x4*)(xin + xo + 4);
        x0 = x0 + (g0 * acc[m][2 * bj]) * coef; x1 = x1 + (g1 * acc[m][2 * bj + 1]) * coef;
        *(f32x4*)(p.out + xo) = x0; *(f32x4*)(p.out + xo + 4) = x1;
        if (m & 1) __builtin_amdgcn_sched_barrier(0);
      }
    }
  }
}

template <int MH> DI void in_epilogue(const Params& p, const f32x4 (&acc)[MH][4], int mt, int half, int nt, int wr, int wc, int fr, int fq) {
#define IN_ROW(m) ((size_t)mt * 256 + (MH == 8 ? ((m) >> 2) : half) * 128 + wr * 64 + ((m) & 3) * 16 + fr)
#define IN_PK(m, bj) ((u32x4){pk2(acc[m][2 * (bj)][0], acc[m][2 * (bj)][1]), pk2(acc[m][2 * (bj)][2], acc[m][2 * (bj)][3]), pk2(acc[m][2 * (bj) + 1][0], acc[m][2 * (bj) + 1][1]), pk2(acc[m][2 * (bj) + 1][2], acc[m][2 * (bj) + 1][3])})
  if (nt < 9) {
#pragma unroll
    for (int bj = 0; bj < 2; ++bj) {
      const int col = ECOL8(bj), sq = col / 768, rem = col - sq * 768, g = rem >> 8, hh = (rem >> 6) & 3, dd = rem & 63;
      const int sh = (g == 0) ? 0 : (g == 1 ? 2 : 4);
#pragma unroll
      for (int m = 0; m < MH; ++m) {
        const size_t row = IN_ROW(m);
        const int b = (int)(row >> 11), t = (int)(row & 2047);
        const int ridx = ((t & ((1 << sh) - 1)) << (11 - sh)) + (t >> sh);
        *(u32x4*)(WSB(p, zatt) + ((size_t)((((b * 3 + sq) * 3 + g) * 4 + hh) * 2048 + ridx)) * 64 + dd) = IN_PK(m, bj);
      }
    }
  } else if (nt < 21) {
#pragma unroll
    for (int bj = 0; bj < 2; ++bj) {
      const int c = ECOL8(bj) - 2304, seg = c >> 10, hd = (c >> 7) & 7, cc = c & 127;
#pragma unroll
      for (int m = 0; m < MH; ++m) {
        const size_t row = IN_ROW(m);
        const int b = (int)(row >> 11), t = (int)(row & 2047);
        *(u32x4*)(WSB(p, zdn) + ((size_t)(((b * 8 + hd) * 3 + seg) * 2048 + t)) * 128 + cc) = IN_PK(m, bj);
      }
    }
  } else if (nt < 33) {
#pragma unroll
    for (int m = 0; m < MH; ++m) {
      const size_t row = IN_ROW(m);
#pragma unroll
      for (int bj = 0; bj < 2; ++bj) *(u32x4*)(WSB(p, z) + row * ZLD + (ECOL8(bj) - 5376)) = IN_PK(m, bj);
    }
  } else if (wc == 0 && fq < 2) {
#pragma unroll
    for (int m = 0; m < MH; ++m) {
      float* ap = WSF(p, ab) + IN_ROW(m) * 16 + fq * 8;
      *(f32x4*)ap = acc[m][0]; *(f32x4*)(ap + 4) = acc[m][1];
    }
  }
#undef IN_ROW
#undef IN_PK
}
DI void gemm_in_phase(const Params& p, const bf16_t* Win, char* lds) {
  GEMM_IDS; (void)lane;
  constexpr int NT = 34, NFULL = (64 * NT / 256) * 256;
  for (int t = real_bid(); t < 64 * NT; t += gridDim.x) {
    int mt, nt; tile_decode(t, mt, nt);
    f32x4 acc[8][4]; zero_acc(acc);
    gemm_core(WSB(p, h) + (size_t)mt * 256 * DM, DM, Win + (size_t)nt * 256 * DM, DM, DM, acc, lds);
    GEMM_IDS_AGAIN;
    in_epilogue<8>(p, acc, mt, 0, nt, wr, wc, fr, fq);
  }
}

DI void gemm_proj_phase(const Params& p, const bf16_t* Wpa, const bf16_t* Wpd, char* lds) {
  GEMM_IDS; (void)lane;
  constexpr int NT = 4;
  for (int t = real_bid(); t < 64 * NT; t += gridDim.x) {
    int mt, nt; tile_decode(t, mt, nt);
    f32x4 acc[8][4]; zero_acc(acc);
    gemm_core(WSB(p, yatt) + (size_t)mt * 256 * 256, 256, Wpa + (size_t)nt * 256 * 256, 256, 256, acc, lds);
    GEMM_IDS_AGAIN;
#pragma unroll
    for (int m = 0; m < 8; ++m) {
      const size_t row = EROW(m);
#pragma unroll
      for (int bj = 0; bj < 2; ++bj) {
        const int col = ECOL8(bj);
        const u32x4 gz = *(const u32x4*)(WSB(p, z) + row * ZLD + Z_MERGE + col);
        float gt[8], o[8]; unpack8(gz, gt);
#pragma unroll
        for (int e = 0; e < 8; ++e) o[e] = sigmoidf_(gt[e]) * acc[m][2 * bj + (e >> 2)][e & 3];
        *(u32x4*)(WSB(p, mrg) + row * DM + col) = pack8(o);
      }
      __builtin_amdgcn_sched_barrier(0);
    }
  }
  for (int t = real_bid(); t < 64 * NT; t += gridDim.x) {
    int mt, nt; tile_decode(t, mt, nt);
    f32x4 acc[8][4]; zero_acc(acc);
    gemm_core(WSB(p, odn) + (size_t)mt * 256 * DM, DM, Wpd + (size_t)nt * 256 * DM, DM, DM, acc, lds);
    GEMM_IDS_AGAIN;
#pragma unroll
    for (int m = 0; m < 8; ++m) {
      const size_t row = EROW(m);
#pragma unroll
      for (int bj = 0; bj < 2; ++bj) {
        const int col = ECOL8(bj);
        const u32x4 gz = *(const u32x4*)(WSB(p, z) + row * ZLD + Z_MERGE + DM + col);
        const u32x4 pv = *(const u32x4*)(WSB(p, mrg) + row * DM + col);
        float gt[8], pr[8], o[8]; unpack8(gz, gt); unpack8(pv, pr);
#pragma unroll
        for (int e = 0; e < 8; ++e) o[e] = pr[e] + sigmoidf_(gt[e]) * acc[m][2 * bj + (e >> 2)][e & 3];
        *(u32x4*)(WSB(p, mrg) + row * DM + col) = pack8(o);
      }
      __builtin_amdgcn_sched_barrier(0);
    }
  }
}

DI void convert_matrix(const float* __restrict__ src, int ldsrc, bf16_t* __restrict__ dst, int K, int ncoltiles, int kind, char* lds, int start, int stride) {
  float* tl = (float*)lds;
  const int tid = opaque_tid();
  const int nkt = K >> 6;
  const int nitems = ncoltiles * nkt;
  for (int it = start; it < nitems; it += stride) {
    const int ct = it / nkt, kt = it - ct * nkt;
    int srccol0 = ct * 64, nvalid = 64;
    if (kind == 1) { const int T = ct >> 2, q = ct & 3; srccol0 = (q >> 1) * DFF + T * 128 + (q & 1) * 64; }
    else if (kind == 2) {
      if (ct < 100) srccol0 = ct * 64;
      else if (ct < 132) srccol0 = 6416 + (ct - 100) * 64;
      else if (ct == 132) { srccol0 = 6400; nvalid = 16; }
      else { srccol0 = 0; nvalid = 0; }
    }
    const int r = tid >> 4, c4 = (tid & 15) * 4;
#pragma unroll
    for (int ps = 0; ps < 4; ++ps) {
      const int kk = r + 16 * ps;
      f32x4 v = (f32x4){0.f, 0.f, 0.f, 0.f};
      if (c4 < nvalid) v = *(const f32x4*)(src + (size_t)(kt * 64 + kk) * ldsrc + srccol0 + c4);
      tl[kk * 65 + c4 + 0] = v[0]; tl[kk * 65 + c4 + 1] = v[1]; tl[kk * 65 + c4 + 2] = v[2]; tl[kk * 65 + c4 + 3] = v[3];
    }
    __syncthreads();
#pragma unroll
    for (int ps = 0; ps < 2; ++ps) {
      const int n = (tid >> 3) + 32 * ps, k8 = (tid & 7) * 8;
      float v[8];
      const int nl = (n & 32) + 8 * ((n & 15) >> 2) + 4 * ((n >> 4) & 1) + (n & 3);
#pragma unroll
      for (int e = 0; e < 8; ++e) v[e] = tl[(k8 + e) * 65 + nl];
      *(u32x4*)(dst + (size_t)(ct * 64 + n) * K + kt * 64 + k8) = pack8(v);
    }
    __syncthreads();
  }
}

DI void convert_layer(const Params& p, int l, char* lds, int start, int stride) {
  convert_matrix(p.w_up1 + (size_t)l * DM * 2 * DFF, 2 * DFF, WSW(p, W_up1, l), DM, 88, 1, lds, start, stride);
  convert_matrix(p.w_down1 + (size_t)l * DFF * DM, DM, WSW(p, W_down1, l), DFF, 16, 0, lds, start, stride);
  convert_matrix(p.w_in + (size_t)l * DM * 8464, 8464, WSW(p, W_in, l), DM, 136, 2, lds, start, stride);
  convert_matrix(p.w_pa + (size_t)l * 256 * DM, DM, WSW(p, W_pa, l), 256, 16, 0, lds, start, stride);
  convert_matrix(p.w_pd + (size_t)l * DM * DM, DM, WSW(p, W_pd, l), DM, 16, 0, lds, start, stride);
  convert_matrix(p.w_out + (size_t)l * DM * DM, DM, WSW(p, W_out, l), DM, 16, 0, lds, start, stride);
  convert_matrix(p.w_up2 + (size_t)l * DM * 2 * DFF, 2 * DFF, WSW(p, W_up2, l), DM, 88, 1, lds, start, stride);
  convert_matrix(p.w_down2 + (size_t)l * DFF * DM, DM, WSW(p, W_down2, l), DFF, 16, 0, lds, start, stride);
}

DI void norm_phase(const Params& p, const float* xin, const float* g, const float* shift, const float* scale  ) {
  const int tid = opaque_tid(), lane = tid & 63, wid = tid >> 6;
  const int nw = VGRID * 4;
  for (int row = opaque_bid() * 4 + wid; row < MTOK; row += nw) {
    const int b = row >> 11;
    const float* xp = xin + (size_t)row * DM;
    f32x4 v[2][2]; float ss = 0.f;
#pragma unroll
    for (int i = 0; i < 2; ++i)
#pragma unroll
      for (int hq = 0; hq < 2; ++hq) {
        v[i][hq] = *(const f32x4*)(xp + i * 512 + lane * 8 + hq * 4);
        ss += v[i][hq][0] * v[i][hq][0] + v[i][hq][1] * v[i][hq][1] + v[i][hq][2] * v[i][hq][2] + v[i][hq][3] * v[i][hq][3];
      }
    ss = sum16(ss); ss += shx(ss, 16, lane); ss += shx(ss, 32, lane);
    const float rstd = __builtin_amdgcn_rsqf(ss * (1.f / DM) + EPS);
#pragma unroll
    for (int i = 0; i < 2; ++i) {
      const int col = i * 512 + lane * 8;
      float o[8];
#pragma unroll
      for (int hq = 0; hq < 2; ++hq) {
        const f32x4 gv = *(const f32x4*)(g + col + hq * 4), sc = *(const f32x4*)(scale + (size_t)b * 9216 + col + hq * 4), sh = *(const f32x4*)(shift + (size_t)b * 9216 + col + hq * 4);
#pragma unroll
        for (int j = 0; j < 4; ++j) o[hq * 4 + j] = v[i][hq][j] * rstd * gv[j] * (1.f + sc[j]) + sh[j];
      }
      *(u32x4*)(WSB(p, h) + (size_t)row * DM + col) = pack8(o);
    }
  }
}

DI void phase0(const Params& p, char* lds) {
  float* cact = (float*)lds;
  float* red = (float*)(lds + 32768);
  const int tid = opaque_tid(), lane = tid & 63, wid = tid >> 6;
  for (int i = tid; i < NB * DM; i += 256) cact[i] = siluf_(p.c[i]);
  __syncthreads();
  for (int it = opaque_bid(); it < 576; it += VGRID) {
    const int l = it / 144, cb = it - l * 144;
    float acc[8];
#pragma unroll
    for (int b = 0; b < 8; ++b) acc[b] = 0.f;
    const float* wp = p.ada_w + (size_t)l * DM * 9216 + cb * 64 + lane;
    const int kbeg = wid * 256;
#pragma unroll 1
    for (int k = kbeg; k < kbeg + 256; k += 8) {
      float wv[8];
#pragma unroll
      for (int u = 0; u < 8; ++u) wv[u] = wp[(size_t)(k + u) * 9216];
#pragma unroll
      for (int b = 0; b < 8; ++b) {
        const f32x4 c0 = *(const f32x4*)(cact + b * DM + k), c1 = *(const f32x4*)(cact + b * DM + k + 4);
        acc[b] += c0[0] * wv[0] + c0[1] * wv[1] + c0[2] * wv[2] + c0[3] * wv[3] + c1[0] * wv[4] + c1[1] * wv[5] + c1[2] * wv[6] + c1[3] * wv[7];
      }
    }
#pragma unroll
    for (int b = 0; b < 8; ++b) red[(wid * 8 + b) * 64 + lane] = acc[b];
    __syncthreads();
#pragma unroll
    for (int h2 = 0; h2 < 2; ++h2) {
      const int b = (tid >> 6) + 4 * h2, c = tid & 63;
      const float sum = red[(0 * 8 + b) * 64 + c] + red[(1 * 8 + b) * 64 + c] + red[(2 * 8 + b) * 64 + c] + red[(3 * 8 + b) * 64 + c];
      WSF(p, mod)[((size_t)l * 8 + b) * 9216 + cb * 64 + c] = sum + p.ada_b[(size_t)l * 9216 + cb * 64 + c];
    }
    __syncthreads();
  }
}

DI void attn_item(const Params& p, int l, int item, char* lds) {
  const int tid = opaque_tid(), lane = tid & 63, w = tid >> 6, r = lane & 31, hf = lane >> 5;
  const int blk16 = item & 15, hh = (item >> 4) & 3, rest = item >> 6, g = rest % 3, b = rest / 3;
  const int d = (g == 0) ? 1 : (g == 1 ? 4 : 16);
  const int nbk = 16 / d, res = blk16 / nbk, nb = blk16 - res * nbk;
  const int qcol = g * 256 + hh * 64;
  const int Lsub = 2048 / d;
  const bf16_t* zq = WSB(p, zatt) + ((size_t)((((b * 3 + 0) * 3 + g) * 4 + hh) * 2048 + res * Lsub)) * 64;
  const bf16_t* zk = WSB(p, zatt) + ((size_t)((((b * 3 + 1) * 3 + g) * 4 + hh) * 2048 + res * Lsub)) * 64;
  const bf16_t* zv = WSB(p, zatt) + ((size_t)((((b * 3 + 2) * 3 + g) * 4 + hh) * 2048 + res * Lsub)) * 64;
  bf16_t* VT = (bf16_t*)lds;
  float* nrm = (float*)(lds + 64 * 528);
  if (tid < 128) nrm[tid] = (tid < 64) ? p.q_norm[l * 64 + tid] : p.k_norm[l * 64 + tid - 64];
  const int qi = 32 * w + r;
  const int tq = (128 * nb + qi) * d + res;
  u32x4 vraw[8], qraw[4], kraw[5][4];
  {
    const int lk = 128 * (nb - 1) + tid, lkc = lk < 0 ? 0 : lk;
    const u32x4* src = (const u32x4*)(zv + (size_t)lkc * 64);
#pragma unroll
    for (int i = 0; i < 8; ++i) vraw[i] = src[i];
    const bf16_t* qp = zq + (size_t)(128 * nb + qi) * 64 + 8 * hf;
#pragma unroll
    for (int s = 0; s < 4; ++s) qraw[s] = *(const u32x4*)(qp + 16 * s);
#pragma unroll
    for (int i = 0; i < 2; ++i) {
      const int lkk = 128 * (nb - 1) + 32 * (w + i) + r, lkkc = lkk < 0 ? 0 : lkk;
      const bf16_t* kp = zk + (size_t)lkkc * 64 + 8 * hf;
#pragma unroll
      for (int s = 0; s < 4; ++s) kraw[i][s] = *(const u32x4*)(kp + 16 * s);
    }
  }
  __builtin_amdgcn_sched_barrier(0);
  {
    const int key = tid;
#pragma unroll
    for (int i = 0; i < 8; ++i)
#pragma unroll
      for (int e = 0; e < 4; ++e) {
        constexpr int d0 = 0;
        const int da = 8 * i + 2 * e + d0, db = da + 1;
        VT[(32 * (da >> 5) + 8 * ((da >> 2) & 3) + 4 * ((da >> 4) & 1) + (da & 3)) * 264 + key] = (bf16_t)(vraw[i][e] & 0xffffu);
        VT[(32 * (db >> 5) + 8 * ((db >> 2) & 3) + 4 * ((db >> 4) & 1) + (db & 3)) * 264 + key] = (bf16_t)(vraw[i][e] >> 16);
      }
  }
  __syncthreads();
  bf16x8 qf[4];
  {
    float qv[4][8]; float ss = 0.f;
#pragma unroll
    for (int s = 0; s < 4; ++s) {
      unpack8(qraw[s], qv[s]);
#pragma unroll
      for (int j = 0; j < 8; ++j) ss += qv[s][j] * qv[s][j];
    }
    ss += shx(ss, 32, lane);
    const float rstd = __builtin_amdgcn_rsqf(ss * (1.f / 64.f) + EPS) * 0.125f;
#pragma unroll
    for (int s = 0; s < 4; ++s) {
      const float* gn = nrm + 16 * s + 8 * hf;
      float o[8];
#pragma unroll
      for (int j = 0; j < 8; ++j) o[j] = qv[s][j] * rstd * gn[j];
      qf[s] = __builtin_bit_cast(bf16x8, pack8(o));
    }
  }
  f32x16 st[5];
#pragma unroll
  for (int i = 0; i < 5; ++i) {
    if (i + 2 < 5 && (nb > 0 || w + i + 2 >= 4)) {
      const int lkk = 128 * (nb - 1) + 32 * (w + i + 2) + r, lkkc = lkk < 0 ? 0 : lkk;
      const bf16_t* kp = zk + (size_t)lkkc * 64 + 8 * hf;
#pragma unroll
      for (int s = 0; s < 4; ++s) kraw[i + 2][s] = *(const u32x4*)(kp + 16 * s);
    }
    __builtin_amdgcn_sched_barrier(0);
#pragma unroll
    for (int e = 0; e < 16; ++e) st[i][e] = 0.f;
    if (nb > 0 || w + i >= 4) {
      float kv[4][8]; float ss = 0.f;
#pragma unroll
      for (int s = 0; s < 4; ++s) {
        unpack8(kraw[i][s], kv[s]);
#pragma unroll
        for (int j = 0; j < 8; ++j) ss += kv[s][j] * kv[s][j];
      }
      ss += shx(ss, 32, lane);
      const float rstd = __builtin_amdgcn_rsqf(ss * (1.f / 64.f) + EPS);
#pragma unroll
      for (int s = 0; s < 4; ++s) {
        const float* gn = nrm + 64 + 16 * s + 8 * hf;
        float o[8];
#pragma unroll
        for (int j = 0; j < 8; ++j) o[j] = kv[s][j] * rstd * gn[j];
        const bf16x8 kf = __builtin_bit_cast(bf16x8, pack8(o));
        st[i] = MFMA32(kf, qf[s], st[i]);
      }
    }
  }
  float mx = -3.0e38f;
#pragma unroll
  for (int i = 0; i < 5; ++i)
#pragma unroll
    for (int e = 0; e < 16; ++e) {
      const int c = (e & 3) + 8 * (e >> 2) + 4 * hf;
      const bool valid = (nb > 0 || w + i >= 4) && (i == 0 ? c >= r : (i == 4 ? c <= r : true));
      st[i][e] = valid ? st[i][e] : -3.0e38f;
      mx = fmaxf(mx, st[i][e]);
    }
  mx = fmaxf(mx, shx(mx, 32, lane));
  float den = 0.f;
#pragma unroll
  for (int i = 0; i < 5; ++i)
#pragma unroll
    for (int e = 0; e < 16; ++e) {
      const float pe = (st[i][e] > -1.0e38f) ? __expf(st[i][e] - mx) : 0.f;
      st[i][e] = pe; den += pe;
    }
  den += shx(den, 32, lane);
  f32x16 ot[2];
#pragma unroll
  for (int dt = 0; dt < 2; ++dt)
#pragma unroll
    for (int e = 0; e < 16; ++e) ot[dt][e] = 0.f;
#pragma unroll
  for (int i = 0; i < 5; ++i)
#pragma unroll
    for (int s2 = 0; s2 < 2; ++s2) if (nb > 0 || w + i >= 4) {
      u32x4 pp;
      pp[0] = pk2(st[i][8 * s2 + 0], st[i][8 * s2 + 1]); pp[1] = pk2(st[i][8 * s2 + 2], st[i][8 * s2 + 3]);
      pp[2] = pk2(st[i][8 * s2 + 4], st[i][8 * s2 + 5]); pp[3] = pk2(st[i][8 * s2 + 6], st[i][8 * s2 + 7]);
      const bf16x8 pf = __builtin_bit_cast(bf16x8, pp);
#pragma unroll
      for (int dt = 0; dt < 2; ++dt) {
        const bf16_t* vp = VT + (32 * dt + r) * 264 + 32 * (w + i) + 16 * s2 + 4 * hf;
        const u32x2 lo = *(const u32x2*)vp, hi = *(const u32x2*)(vp + 8);
        u32x4 vv; vv[0] = lo[0]; vv[1] = lo[1]; vv[2] = hi[0]; vv[3] = hi[1];
        ot[dt] = MFMA32(__builtin_bit_cast(bf16x8, vv), pf, ot[dt]);
      }
    }
  const float inv = __builtin_amdgcn_rcpf(den);
  const size_t tok = (size_t)b * SEQ + tq;
#pragma unroll
  for (int dt = 0; dt < 2; ++dt)
#pragma unroll
    for (int h8 = 0; h8 < 2; ++h8) {
      float o[8];
#pragma unroll
      for (int e = 0; e < 8; ++e) o[e] = ot[dt][8 * h8 + e] * inv;
      *(u32x4*)(WSB(p, og) + tok * 768 + qcol + 32 * dt + 16 * hf + 8 * h8) = pack8(o);
    }
  if (hf == 0) WSF(p, lse)[tok * 12 + g * 4 + hh] = mx + __logf(den);
  __syncthreads();
}

DI int lnd(int v) { asm volatile("" : "+s"(v)); return v; }
DI void dn_f1_item(const Params& p, int l, int chunk, char* lds) {
  const int tid = opaque_tid(), lane = tid & 63, w = tid >> 6, fr = lane & 15, fq = lane >> 4;
  const int n = chunk & 31, bh = chunk >> 5, h = bh & 7, b = bh >> 3;
  const int t0 = n * 64;
  const size_t rowbase = (size_t)b * SEQ;
  bf16_t* Qn = (bf16_t*)lds;
  bf16_t* Kn = (bf16_t*)(lds + 17408);
  bf16_t* KB = (bf16_t*)(lds + 2 * 17408);
  bf16_t* Vs = (bf16_t*)(lds + 3 * 17408);
  float* gcs = (float*)(lds + 4 * 17408);
  float* betas = gcs + 64;
  float* egc = gcs + 128;
  float* Am = (float*)lds;
  if (w == 0) {
    const size_t row = rowbase + t0 + lane;
    const float a = WSF(p, ab)[row * 16 + h], bb = WSF(p, ab)[row * 16 + 8 + h];
    const float xx = a + p.dt_bias[l * 8 + h];
    const float sp = xx > 20.f ? xx : log1pf(__expf(xx));
    float s = -__expf(p.a_log[l * 8 + h]) * sp;
#pragma unroll
    for (int off = 1; off < 64; off <<= 1) { const float t = shup(s, off, lane); if (lane >= off) s += t; }
    gcs[lane] = s; betas[lane] = sigmoidf_(bb); egc[lane] = __expf(s);
    if (lane == 63) WSF(p, dGL)[chunk] = __expf(s);
  }
  __syncthreads();
  const float gclast = gcs[63];
  const int cg8 = (tid & 15) * 8, rg = tid >> 4;
#pragma unroll 1
  for (int seg = 0; seg < 3; ++seg) {
    u32x4 rows[7];
#pragma unroll
    for (int r = 0; r < 7; ++r) {
      const int tt = t0 + 4 * rg - 3 + r;
      rows[r] = (u32x4){0u, 0u, 0u, 0u};
      if (tt >= 0) rows[r] = *(const u32x4*)(WSB(p, zdn) + ((size_t)(((b * 8 + h) * 3 + seg) * 2048 + tt)) * 128 + cg8);
    }
    float cw[4][8];
#pragma unroll
    for (int tap = 0; tap < 4; ++tap) {
      const float* cp = p.conv_w + ((size_t)l * 4 + tap) * 3072 + seg * 1024 + h * 128 + cg8;
      const f32x4 c0 = *(const f32x4*)cp, c1 = *(const f32x4*)(cp + 4);
      cw[tap][0] = c0[0]; cw[tap][1] = c0[1]; cw[tap][2] = c0[2]; cw[tap][3] = c0[3];
      cw[tap][4] = c1[0]; cw[tap][5] = c1[1]; cw[tap][6] = c1[2]; cw[tap][7] = c1[3];
    }
#pragma unroll
    for (int jt = 0; jt < 4; ++jt) {
      const int i = 4 * rg + jt;
      float val[8];
#pragma unroll
      for (int e = 0; e < 8; ++e) val[e] = 0.f;
#pragma unroll
      for (int tap = 0; tap < 4; ++tap) {
        float xv[8]; unpack8(rows[jt + tap], xv);
#pragma unroll
        for (int e = 0; e < 8; ++e) val[e] += cw[tap][e] * xv[e];
      }
      float ss = 0.f;
#pragma unroll
      for (int e = 0; e < 8; ++e) { val[e] = siluf_(val[e]); ss += val[e] * val[e]; }
      ss = sum16(ss);
      const float rn = __builtin_amdgcn_rsqf(ss + EPS);
      if (seg == 0) {
        const float eg = egc[i];
        float qv[8], qd[8];
#pragma unroll
        for (int e = 0; e < 8; ++e) { qv[e] = val[e] * rn * 0.08838834764831845f; qd[e] = qv[e] * eg; }
        *(u32x4*)(Qn + i * 136 + cg8) = pack8(qv);
        *(u32x4*)(WSB(p, dQD) + ((size_t)lnd(chunk) * 64 + i) * 128 + cg8) = pack8(qd);
      } else if (seg == 1) {
        const float bt = betas[i];
        float kv[8], kb[8];
#pragma unroll
        for (int e = 0; e < 8; ++e) { kv[e] = val[e] * rn; kb[e] = kv[e] * bt; }
        *(u32x4*)(Kn + i * 136 + cg8) = pack8(kv);
        *(u32x4*)(KB + i * 136 + cg8) = pack8(kb);
      } else {
        *(u32x4*)(Vs + i * 136 + cg8) = pack8(val);
      }
    }
  }
  __syncthreads();
  {
    const int dcol = tid >> 1, half = tid & 1;
    u32x4 o4[4];
#pragma unroll
    for (int q = 0; q < 4; ++q)
#pragma unroll
      for (int e = 0; e < 4; ++e) {
        const int i0 = 32 * half + 8 * q + 2 * e;
        const float k0 = bf2f(Kn[i0 * 136 + dcol]) * __expf(gclast - gcs[i0]);
        const float k1 = bf2f(Kn[(i0 + 1) * 136 + dcol]) * __expf(gclast - gcs[i0 + 1]);
        o4[q][e] = pk2(k0, k1);
      }
    u32x4* dst = (u32x4*)(WSB(p, dKDT) + ((size_t)lnd(chunk) * 128 + dcol) * 64 + 32 * half);
#pragma unroll
    for (int q = 0; q < 4; ++q) dst[q] = o4[q];
  }
  f32x4 kk[4], qk[4];
#pragma unroll
  for (int nn = 0; nn < 4; ++nn) { kk[nn] = (f32x4){0.f, 0.f, 0.f, 0.f}; qk[nn] = (f32x4){0.f, 0.f, 0.f, 0.f}; }
#pragma unroll
  for (int s = 0; s < 4; ++s) {
    const bf16x8 akb = *(const bf16x8*)(KB + (16 * w + fr) * 136 + 32 * s + 8 * fq);
    const bf16x8 aq = *(const bf16x8*)(Qn + (16 * w + fr) * 136 + 32 * s + 8 * fq);
#pragma unroll
    for (int nn = 0; nn < 4; ++nn) {
      const bf16x8 bk = *(const bf16x8*)(Kn + (16 * nn + fr) * 136 + 32 * s + 8 * fq);
      kk[nn] = MFMA16(akb, bk, kk[nn]);
      qk[nn] = MFMA16(aq, bk, qk[nn]);
    }
  }
  __syncthreads();
#pragma unroll
  for (int nn = 0; nn < 4; ++nn)
#pragma unroll
    for (int j = 0; j < 4; ++j) {
      const int i = 16 * w + 4 * fq + j, jj = 16 * nn + fr;
      const float dec = __expf(fminf(gcs[i] - gcs[jj], 0.f));
      Am[i * 64 + jj] = (jj < i) ? kk[nn][j] * dec : 0.f;
      Kn[i * 72 + jj] = f2bf((jj <= i) ? qk[nn][j] * dec : 0.f);
    }
  __syncthreads();
#pragma unroll
  for (int ps = 0; ps < 2; ++ps) {
    const int id = tid + 256 * ps, i = id >> 3, c8 = (id & 7) * 8;
    *(u32x4*)(WSB(p, dAI) + ((size_t)lnd(chunk) * 64 + i) * 64 + c8) = *(const u32x4*)(Kn + i * 72 + c8);
  }
  {
    const int c = tid & 127; const bool isW = tid >= 128;
    const bf16_t* rsrc = isW ? KB : Vs;
    const float* msrc = isW ? egc : betas;
    float x[64];
#pragma unroll
    for (int i = 0; i < 64; ++i) x[i] = 0.f;
#pragma unroll
    for (int i = 0; i < 64; ++i) {
      const float rhs = bf2f(rsrc[i * 136 + c]) * msrc[i];
      float s0 = 0.f, s1 = 0.f, s2 = 0.f, s3 = 0.f;
#pragma unroll
      for (int j4 = 0; j4 < (i + 3) / 4; ++j4) {
        const f32x4 a = *(const f32x4*)(Am + i * 64 + 4 * j4);
        s0 += a[0] * x[4 * j4]; s1 += a[1] * x[4 * j4 + 1]; s2 += a[2] * x[4 * j4 + 2]; s3 += a[3] * x[4 * j4 + 3];
      }
      x[i] = rhs - ((s0 + s1) + (s2 + s3));
    }
    if (!isW) {
      u32x4* dst = (u32x4*)(WSB(p, dUT) + ((size_t)lnd(chunk) * 128 + c) * 64);
#pragma unroll
      for (int q = 0; q < 8; ++q) {
        u32x4 o; o[0] = pk2(x[8 * q], x[8 * q + 1]); o[1] = pk2(x[8 * q + 2], x[8 * q + 3]); o[2] = pk2(x[8 * q + 4], x[8 * q + 5]); o[3] = pk2(x[8 * q + 6], x[8 * q + 7]);
        dst[q] = o;
      }
    }
    __syncthreads();
    if (isW) {
#pragma unroll
      for (int i = 0; i < 64; ++i) Kn[i * 136 + c] = f2bf(x[i]);
    }
  }
  __syncthreads();
#pragma unroll
  for (int ps = 0; ps < 4; ++ps) {
    const int id = tid + 256 * ps, i = id >> 4, c8 = (id & 15) * 8;
    *(u32x4*)(WSB(p, dW) + ((size_t)lnd(chunk) * 64 + i) * 128 + c8) = *(const u32x4*)(Kn + i * 136 + c8);
  }
  __syncthreads();
}

#define LDS_BARRIER() do { asm volatile("s_waitcnt lgkmcnt(0)" ::: "memory"); __builtin_amdgcn_s_barrier(); asm volatile("" ::: "memory"); } while (0)
DI void dn_f2_item(const Params& p, int item, char* lds) {
  const int tid = opaque_tid(), lane = tid & 63, w = tid >> 6, fr = lane & 15, fq = lane >> 4;
  const int vs = item & 3, bh = item >> 2, h = bh & 7, b = bh >> 3;
  bf16_t* ST = (bf16_t*)lds;
  bf16_t* VT = (bf16_t*)(lds + 32 * 272);
  bf16_t* OT = (bf16_t*)(lds + 32 * 272 + 32 * 144);
  for (int i = tid; i < 32 * 136; i += 256) ST[i] = 0;
  f32x4 accS[2][2];
#pragma unroll
  for (int nn = 0; nn < 2; ++nn)
#pragma unroll
    for (int m = 0; m < 2; ++m) accS[nn][m] = (f32x4){0.f, 0.f, 0.f, 0.f};
  __syncthreads();
  bf16x8 naw[4], naq[4], naa[2], nak[2][2]; u32x2 nuu[2]; float ngl;
#define F2_LOAD(n_)                                                                                                     \
  {                                                                                                                     \
    const size_t chunk_ = (size_t)bh * 32 + (n_);                                                                       \
    const bf16_t* Wc = WSB(p, dW) + chunk_ * 8192; const bf16_t* QDc = WSB(p, dQD) + chunk_ * 8192;                     \
    const bf16_t* AIc = WSB(p, dAI) + chunk_ * 4096; const bf16_t* KDTc = WSB(p, dKDT) + chunk_ * 8192;                 \
    const bf16_t* UTc = WSB(p, dUT) + chunk_ * 8192;                                                                    \
    _Pragma("unroll") for (int s = 0; s < 4; ++s) {                                                                     \
      naw[s] = *(const bf16x8*)(Wc + (16 * w + fr) * 128 + 32 * s + 8 * fq);                                            \
      naq[s] = *(const bf16x8*)(QDc + (16 * w + fr) * 128 + 32 * s + 8 * fq);                                           \
    }                                                                                                                   \
    _Pragma("unroll") for (int s = 0; s < 2; ++s) {                                                                     \
      naa[s] = *(const bf16x8*)(AIc + (16 * w + fr) * 64 + 32 * s + 8 * fq);                                            \
      _Pragma("unroll") for (int nn = 0; nn < 2; ++nn) nak[s][nn] = *(const bf16x8*)(KDTc + (32 * w + 16 * nn + fr) * 64 + 32 * s + 8 * fq); \
    }                                                                                                                   \
    _Pragma("unroll") for (int m = 0; m < 2; ++m) nuu[m] = *(const u32x2*)(UTc + (vs * 32 + 16 * m + fr) * 64 + 16 * w + 4 * fq); \
    ngl = WSF(p, dGL)[chunk_];                                                                                          \
  }
  F2_LOAD(0);
  for (int n = 0; n < 32; ++n) {
    bf16x8 aw[4], aq[4], aa[2], ak[2][2]; u32x2 uu[2];
#pragma unroll
    for (int s = 0; s < 4; ++s) { aw[s] = naw[s]; aq[s] = naq[s]; }
#pragma unroll
    for (int s = 0; s < 2; ++s) { aa[s] = naa[s]; ak[s][0] = nak[s][0]; ak[s][1] = nak[s][1]; uu[s] = nuu[s]; }
    const float gl = ngl;
    if (n + 1 < 32) F2_LOAD(n + 1);
    f32x4 ws[2], qs[2];
#pragma unroll
    for (int m = 0; m < 2; ++m) { ws[m] = (f32x4){0.f, 0.f, 0.f, 0.f}; qs[m] = (f32x4){0.f, 0.f, 0.f, 0.f}; }
#pragma unroll
    for (int s = 0; s < 4; ++s) {
#pragma unroll
      for (int m = 0; m < 2; ++m) {
        const bf16x8 bs = *(const bf16x8*)(ST + (16 * m + fr) * 136 + 32 * s + 8 * fq);
        ws[m] = MFMA16(aw[s], bs, ws[m]);
        qs[m] = MFMA16(aq[s], bs, qs[m]);
      }
    }
#pragma unroll
    for (int m = 0; m < 2; ++m) {
      const float v0 = bflo(uu[m][0]) - ws[m][0], v1 = bfhi(uu[m][0]) - ws[m][1], v2 = bflo(uu[m][1]) - ws[m][2], v3 = bfhi(uu[m][1]) - ws[m][3];
      u32x2 o; o[0] = pk2(v0, v1); o[1] = pk2(v2, v3);
      *(u32x2*)(VT + (16 * m + fr) * 72 + 16 * w + 4 * fq) = o;
    }
    LDS_BARRIER();
    bf16x8 bv[2][2];
#pragma unroll
    for (int s = 0; s < 2; ++s)
#pragma unroll
      for (int m = 0; m < 2; ++m) bv[s][m] = *(const bf16x8*)(VT + (16 * m + fr) * 72 + 32 * s + 8 * fq);
#pragma unroll
    for (int s = 0; s < 2; ++s)
#pragma unroll
      for (int m = 0; m < 2; ++m) qs[m] = MFMA16(aa[s], bv[s][m], qs[m]);
#pragma unroll
    for (int m = 0; m < 2; ++m)
#pragma unroll
      for (int j = 0; j < 4; ++j) OT[(16 * w + 4 * fq + j) * 40 + 16 * m + fr] = f2bf(qs[m][j]);
#pragma unroll
    for (int nn = 0; nn < 2; ++nn)
#pragma unroll
      for (int m = 0; m < 2; ++m) accS[nn][m] = accS[nn][m] * gl;
#pragma unroll
    for (int s = 0; s < 2; ++s)
#pragma unroll
      for (int nn = 0; nn < 2; ++nn)
#pragma unroll
        for (int m = 0; m < 2; ++m) accS[nn][m] = MFMA16(ak[s][nn], bv[s][m], accS[nn][m]);
#pragma unroll
    for (int nn = 0; nn < 2; ++nn)
#pragma unroll
      for (int m = 0; m < 2; ++m) {
        u32x2 o; o[0] = pk2(accS[nn][m][0], accS[nn][m][1]); o[1] = pk2(accS[nn][m][2], accS[nn][m][3]);
        *(u32x2*)(ST + (16 * m + fr) * 136 + 32 * w + 16 * nn + 4 * fq) = o;
      }
    LDS_BARRIER();
    {
      const int tk = tid >> 2, c8 = (tid & 3) * 8;
      *(u32x4*)(WSB(p, oraw) + ((size_t)b * SEQ + n * 64 + tk) * DM + h * 128 + vs * 32 + c8) = *(const u32x4*)(OT + tk * 40 + c8);
    }
  }
#undef F2_LOAD
}

DI void elem_phase(const Params& p, int l) {
  const int tid = opaque_tid(), lane = tid & 63;
  const size_t stride = (size_t)VGRID * 256;
  for (size_t idx = (size_t)opaque_bid() * 256 + tid; idx < (size_t)MTOK * 32; idx += stride) {
    const size_t tok = idx >> 5; const int ch = (int)(idx & 31), hh = ch >> 3, d0 = (ch & 7) * 8;
    const float l0 = WSF(p, lse)[tok * 12 + hh], l1 = WSF(p, lse)[tok * 12 + 4 + hh], l2 = WSF(p, lse)[tok * 12 + 8 + hh];
    const float mx = fmaxf(l0, fmaxf(l1, l2));
    const float e0 = __expf(l0 - mx), e1 = __expf(l1 - mx), e2 = __expf(l2 - mx);
    const float inv = __builtin_amdgcn_rcpf(e0 + e1 + e2);
    const float wg[3] = {e0 * inv, e1 * inv, e2 * inv};
    float y[8];
#pragma unroll
    for (int e = 0; e < 8; ++e) y[e] = 0.f;
#pragma unroll
    for (int g = 0; g < 3; ++g) {
      const u32x4 raw = *(const u32x4*)(WSB(p, og) + tok * 768 + g * 256 + hh * 64 + d0);
      float v[8]; unpack8(raw, v);
#pragma unroll
      for (int e = 0; e < 8; ++e) y[e] += wg[g] * v[e];
    }
    *(u32x4*)(WSB(p, yatt) + tok * 256 + hh * 64 + d0) = pack8(y);
  }
  for (size_t idx = (size_t)opaque_bid() * 256 + tid; idx < (size_t)MTOK * 128; idx += stride) {
    const size_t tok = idx >> 7; const int col = (int)(idx & 127) * 8;
    const u32x4 raw = *(const u32x4*)(WSB(p, oraw) + tok * DM + col);
    float v[8]; unpack8(raw, v);
    float ss = 0.f;
#pragma unroll
    for (int e = 0; e < 8; ++e) ss += v[e] * v[e];
    ss = sum16(ss);
    const float rstd = __builtin_amdgcn_rsqf(ss * (1.f / 128.f) + EPS);
    const u32x4 graw = *(const u32x4*)(WSB(p, z) + tok * ZLD + Z_DNGATE + col);
    float gz[8]; unpack8(graw, gz);
    const float* gn = p.dn_norm + l * 128 + (col & 127);
    float y[8];
#pragma unroll
    for (int e = 0; e < 8; ++e) y[e] = v[e] * rstd * gn[e] * siluf_(gz[e]);
    *(u32x4*)(WSB(p, odn) + tok * DM + col) = pack8(y);
  }
}


#define XB_TMO      128
#define XB_XCNT(j)  (256  + 64 * (j))
#define XB_XSUB(j)  (1280 + 64 * (j))
#define XB_XGEN(j)  (2304 + 64 * (j))
#define XB_TOP      3328
#define XB_TOPGEN   3392
#define XCD_BAR_WORDS 3456
#define XB_SPIN_CAP (1u << 22)
#define LAS __attribute__((address_space(3)))
DI unsigned xb_ld(unsigned* p)              { return __hip_atomic_load(p, __ATOMIC_RELAXED, __HIP_MEMORY_SCOPE_AGENT); }
DI unsigned xb_add(unsigned* p, unsigned v) { return __hip_atomic_fetch_add(p, v, __ATOMIC_RELAXED, __HIP_MEMORY_SCOPE_AGENT); }
DI unsigned xb_xcc_id() { return (unsigned)__builtin_amdgcn_s_getreg((3 << 11) | 20) & 0xFu; }
#define XB_SPIN(cond, bar) do { unsigned _sp = 0; while (cond) { __builtin_amdgcn_s_sleep(1); \
    if ((++_sp & 255u) == 0u) { if (xb_ld(&(bar)[XB_TMO])) break; if (_sp > XB_SPIN_CAP) { atomicAdd(&(bar)[XB_TMO], 1u); break; } } } } while (0)
struct XcdBarrier { unsigned* bar; unsigned x; volatile LAS unsigned* st; };
DI XcdBarrier xcd_barrier_post(unsigned* bar, volatile LAS unsigned* st) {
  XcdBarrier b; b.bar = bar; b.x = xb_xcc_id(); b.st = st;
  if (threadIdx.x == 0) (void)xb_add(&bar[XB_XCNT(b.x)], 1u);
  return b;
}
DI void xcd_barrier_complete(unsigned* bar, unsigned x, unsigned& nloc, unsigned& nx) {
  const unsigned G = gridDim.x * gridDim.y * gridDim.z;
  unsigned sum, cnt, mine, sp = 0u;
  for (;;) {
    sum = 0u; cnt = 0u; mine = 0u;
#pragma unroll
    for (unsigned j = 0; j < 16; ++j) { const unsigned c = xb_ld(&bar[XB_XCNT(j)]); sum += c; cnt += (c > 0u) ? 1u : 0u; mine = (j == x) ? c : mine; }
    if (sum == G) break;
    __builtin_amdgcn_s_sleep(1);
    if ((++sp & 255u) == 0u) { if (xb_ld(&bar[XB_TMO])) break; if (sp > XB_SPIN_CAP) { atomicAdd(&bar[XB_TMO], 1u); break; } }
  }
  nloc = mine > 0u ? mine : 1u; nx = cnt > 0u ? cnt : 1u;
}
DI void xcd_barrier_impl(const XcdBarrier& b) {
  asm volatile("s_waitcnt vmcnt(0)" ::: "memory");
  __syncthreads();
  if (threadIdx.x == 0) {
    unsigned* bar = b.bar; asm volatile("" : "+s"(bar));
    __builtin_amdgcn_s_waitcnt(0);
    const unsigned nloc = b.st[0], nx = b.st[1];
    const unsigned old = xb_add(&bar[XB_XSUB(b.x)], 1u);
    const unsigned gen = old / nloc;
    if (old + 1u == (gen + 1u) * nloc) {
      __builtin_amdgcn_fence(__ATOMIC_RELEASE, "agent");
      asm volatile("s_waitcnt vmcnt(0)" ::: "memory");
      const unsigned og = xb_add(&bar[XB_TOP], 1u);
      const unsigned tg = og / nx;
      if (og + 1u == (tg + 1u) * nx) xb_add(&bar[XB_TOPGEN], 1u);
      else XB_SPIN(xb_ld(&bar[XB_TOPGEN]) == tg, bar);
      __builtin_amdgcn_fence(__ATOMIC_ACQUIRE, "agent");
      xb_add(&bar[XB_XGEN(b.x)], 1u);
      asm volatile("s_waitcnt vmcnt(0)" ::: "memory");
    } else {
      XB_SPIN(xb_ld(&bar[XB_XGEN(b.x)]) == gen, bar);
      __builtin_amdgcn_fence(__ATOMIC_ACQUIRE, "agent");
      asm volatile("s_waitcnt vmcnt(0)" ::: "memory");
    }
  }
  __syncthreads();
}

DI void xcd_barrier_census(char* ws, char* lds) {
  if (threadIdx.x == 0) {
    unsigned nloc, nx; xcd_barrier_complete((unsigned*)(ws + O_bar), xb_xcc_id(), nloc, nx);
    volatile LAS unsigned* st = (volatile LAS unsigned*)(lds + LDS_BYTES); st[0] = nloc; st[1] = nx;
  }
  __syncthreads();
}
DI void xcd_barrier_ws(char* ws, char* lds) {
  XcdBarrier b; b.bar = (unsigned*)(ws + O_bar); b.x = xb_xcc_id(); b.st = (volatile LAS unsigned*)(lds + LDS_BYTES);
  xcd_barrier_impl(b);
}
__global__ void __launch_bounds__(512, 2) fwd_megakernel(Params p) {
  __shared__ __attribute__((aligned(16))) char lds[LDS_BYTES + 16];
  cg::grid_group grid = cg::this_grid();
  if (threadIdx.x == 0) { *(volatile LAS unsigned*)(lds + LDS_BYTES) = 0u; *(volatile LAS unsigned*)(lds + LDS_BYTES + 4) = 0u; }
  __syncthreads();
  (void)xcd_barrier_post((unsigned*)(p.ws + O_bar), (volatile LAS unsigned*)(lds + LDS_BYTES));
  phase0(p, vlds(lds));
  convert_layer(p, 0, vlds(lds), opaque_bid(), VGRID);
  grid.sync();
  xcd_barrier_census(p.ws, lds);
  for (int l = 0; l < DEPTH; ++l) {
    const float* modl = WSF(p, mod) + (size_t)l * 8 * 9216;
    norm_phase(p, l == 0 ? p.x : p.out, p.norm_ff1 + l * DM, modl + 0 * DM, modl + 1 * DM);
    xcd_barrier_ws(p.ws, lds);
    gemm_up_phase(p, WSW(p, W_up1, l), lds);
    xcd_barrier_ws(p.ws, lds);
    gemm_res_phase(p, l == 0 ? p.x : p.out, WSB(p, hidden), DFF, WSW(p, W_down1, l), modl + 2 * DM, 0.5f, lds);
    xcd_barrier_ws(p.ws, lds);
    norm_phase(p, p.out, p.norm_mix + l * DM, modl + 3 * DM, modl + 4 * DM);
    xcd_barrier_ws(p.ws, lds);
    gemm_in_phase(p, WSW(p, W_in, l), lds);
    xcd_barrier_ws(p.ws, lds);
    {
      char* vl = vlds(lds);
      for (int it = opaque_bid(); it < 2048 + 512; it += VGRID) {
        if (it < 2048) dn_f1_item(p, l, it, vl); else attn_item(p, l, it - 2048, vl);
      }
    }
    xcd_barrier_ws(p.ws, lds);
    {
      char* vl = vlds(lds);
      const int vb = opaque_bid();
      if (vb < 256) dn_f2_item(p, vb, vl);
      else {
        for (int it = 512 + vb - 256; it < 1536; it += VGRID - 256) attn_item(p, l, it, vl);
        if (l + 1 < DEPTH) convert_layer(p, l + 1, vl, vb - 256, VGRID - 256);
      }
    }
    xcd_barrier_ws(p.ws, lds);
    elem_phase(p, l);
    xcd_barrier_ws(p.ws, lds);
    gemm_proj_phase(p, WSW(p, W_pa, l), WSW(p, W_pd, l), lds);
    xcd_barrier_ws(p.ws, lds);
    gemm_res_phase(p, p.out, WSB(p, mrg), DM, WSW(p, W_out, l), modl + 5 * DM, 1.0f, lds);
    xcd_barrier_ws(p.ws, lds);
    norm_phase(p, p.out, p.norm_ff2 + l * DM, modl + 6 * DM, modl + 7 * DM);
    xcd_barrier_ws(p.ws, lds);
    gemm_up_phase(p, WSW(p, W_up2, l), lds);
    xcd_barrier_ws(p.ws, lds);
    gemm_res_phase(p, p.out, WSB(p, hidden), DFF, WSW(p, W_down2, l), modl + 8 * DM, 0.5f, lds);
    xcd_barrier_ws(p.ws, lds);
  }
}

extern "C" void kernel_launch(void* const* d_in, const int* in_sizes, int n_in, void* d_out, int out_size, void* d_ws, size_t ws_size, hipStream_t stream) {
  static int grid_blocks = 0;
  if (!grid_blocks) {
    int dev = 0, cus = 0, per_cu = 0;
    hipGetDevice(&dev);
    hipDeviceGetAttribute(&cus, hipDeviceAttributeMultiprocessorCount, dev);
    hipOccupancyMaxActiveBlocksPerMultiprocessor(&per_cu, fwd_megakernel, 512, 0);
    if (per_cu > 1) per_cu = 1;
    grid_blocks = cus * per_cu;
    if (grid_blocks % 8) grid_blocks -= grid_blocks % 8;
  }
  Params p{};
  const float* const* in = (const float* const*)d_in;
  p.x = in[0]; p.c = in[1]; p.ada_w = in[2]; p.ada_b = in[3]; p.norm_ff1 = in[4]; p.w_up1 = in[5]; p.w_down1 = in[6]; p.norm_mix = in[7];
  p.w_in = in[8]; p.q_norm = in[9]; p.k_norm = in[10]; p.conv_w = in[11]; p.a_log = in[12]; p.dt_bias = in[13]; p.dn_norm = in[14];
  p.w_pa = in[15]; p.w_pd = in[16]; p.w_out = in[17]; p.norm_ff2 = in[18]; p.w_up2 = in[19]; p.w_down2 = in[20];
  p.out = (float*)d_out;
  p.ws = (char*)d_ws;
  if (WS_TOTAL > ws_size) { fprintf(stderr, "kernel_launch: workspace too small (%zu needed, %zu given)\n", (size_t)WS_TOTAL, ws_size); return; }
  if (hipMemsetAsync(p.ws + O_bar, 0, (size_t)3456 * 4, stream) != hipSuccess) fprintf(stderr, "kernel_launch: barrier memset failed\n");
  void* args[] = {&p};
  hipError_t e = hipLaunchCooperativeKernel((void*)fwd_megakernel, dim3(grid_blocks), dim3(512), args, 0, stream);
  if (e != hipSuccess) fprintf(stderr, "cooperative launch failed: %s (grid %d)\n", hipGetErrorString(e), grid_blocks);
}
```
